# Optimizing an MI355X kernel written in HIP

```python
import jax, jax.numpy as jnp
from jax import lax
import numpy as np

D_MODEL = 1024
BATCH = 8
SEQ = 2048
DEPTH = 2

CHUNK = 64
N_LEFT_CHUNKS = 8
BAND_CHUNKS = N_LEFT_CHUNKS + 1
HEAD_DIM = 64
RWKV_WIDTH = D_MODEL // 2
ATTN_WIDTH = D_MODEL - RWKV_WIDTH
RWKV_HEADS = RWKV_WIDTH // HEAD_DIM
ATTN_HEADS = ATTN_WIDTH // HEAD_DIM
DECAY_LORA = 64
AAA_LORA = 64
GATE_LORA = 128
REL_CLIP = 128
D_FF = 2816
N_EXPERTS = 8
TOP_K = 2
D_FF_EXPERT = D_FF // 2
N_DENSE = (DEPTH + 1) // 2
N_MOE = DEPTH // 2
RMS_EPS = 1e-6
GN_EPS = 64e-5
MASK_VALUE = -1e30
SHIFT_SIZES = (RWKV_WIDTH, RWKV_WIDTH, RWKV_WIDTH, DECAY_LORA, AAA_LORA, GATE_LORA)
ATTN_SIZES = (ATTN_WIDTH, ATTN_WIDTH, ATTN_WIDTH)
SHIFT_COLS = 3 * RWKV_WIDTH + DECAY_LORA + AAA_LORA + GATE_LORA
IN_COLS = SHIFT_COLS + 3 * ATTN_WIDTH

kernel_name = 'hybrid_rwkv7_chunkattn_moe_encoder'


def _split(t, sizes):
    out, start = [], 0
    for s in sizes:
        out.append(t[..., start:start + s])
        start += s
    return out


def _rmsnorm(x, g):
    xf = x.astype(jnp.float32)
    y = xf * lax.rsqrt(jnp.mean(xf * xf, axis=-1, keepdims=True) + RMS_EPS)
    return (y * g.astype(jnp.float32)).astype(x.dtype)


def _token_shift(h, mu):
    prev = jnp.pad(h, ((0, 0), (1, 0), (0, 0)))[:, :-1]
    return h + mu.astype(h.dtype) * (prev - h)


def _rwkv7(r, k, v, wd, ad, gd, w0, w2, a0, a2, g2, k_k, k_a, r_k, ln_w, ln_b):
    B, S, _ = r.shape
    dt = r.dtype
    f = lambda t: t.astype(jnp.float32)
    r, k, v = f(r), f(k), f(v)
    w = f(w0) + jnp.tanh(f(wd)) @ f(w2)
    w = -jax.nn.softplus(-w) - 0.5
    decay = jnp.exp(-jnp.exp(w))
    a = jax.nn.sigmoid(f(a0) + f(ad) @ f(a2))
    g = jax.nn.sigmoid(f(gd)) @ f(g2)
    heads = lambda t: t.reshape(B, S, RWKV_HEADS, HEAD_DIM)
    kk = heads(k * f(k_k))
    kk = kk / jnp.maximum(jnp.linalg.norm(kk, axis=-1, keepdims=True), 1e-12)
    k = k * (1.0 + (a - 1.0) * f(k_a))
    rh, kh, vh, wh, ah = heads(r), heads(k), heads(v), heads(decay), heads(a)

    def step(state, inp):
        r_t, w_t, k_t, v_t, kk_t, a_t = inp
        sa = jnp.einsum('bhvk,bhk->bhv', state, -kk_t)
        state = (state * w_t[:, :, None, :]
                 + sa[..., None] * (kk_t * a_t)[:, :, None, :]
                 + v_t[..., None] * k_t[:, :, None, :])
        y_t = jnp.einsum('bhvk,bhk->bhv', state, r_t)
        return state, y_t

    xs = tuple(jnp.swapaxes(t, 0, 1) for t in (rh, wh, kh, vh, kk, ah))
    s0 = jnp.zeros((B, RWKV_HEADS, HEAD_DIM, HEAD_DIM), jnp.float32)
    _, y = lax.scan(step, s0, xs)
    y = jnp.swapaxes(y, 0, 1)
    mu = jnp.mean(y, axis=-1, keepdims=True)
    var = jnp.mean(jnp.square(y - mu), axis=-1, keepdims=True)
    y = ((y - mu) * lax.rsqrt(var + GN_EPS)).reshape(B, S, RWKV_WIDTH) * f(ln_w) + f(ln_b)
    r_k_h = f(r_k).reshape(RWKV_HEADS, HEAD_DIM)
    bonus = jnp.sum(rh * kh * r_k_h, axis=-1, keepdims=True) * vh
    y = (y + bonus.reshape(B, S, RWKV_WIDTH)) * g
    return y.astype(dt)


def _chunk_attention(q, k, v, rel_bias, norm_g):
    B, S, _ = q.shape
    NC = S // CHUNK
    shp = lambda t: t.reshape(B, NC, CHUNK, ATTN_HEADS, HEAD_DIM)
    q, k, v = shp(q), shp(k), shp(v)
    pad = ((0, 0), (N_LEFT_CHUNKS, 0), (0, 0), (0, 0), (0, 0))
    kp, vp = jnp.pad(k, pad), jnp.pad(v, pad)
    band = jnp.arange(NC)[:, None] + jnp.arange(BAND_CHUNKS)[None, :]
    kb = kp[:, band].reshape(B, NC, BAND_CHUNKS * CHUNK, ATTN_HEADS, HEAD_DIM)
    vb = vp[:, band].reshape(B, NC, BAND_CHUNKS * CHUNK, ATTN_HEADS, HEAD_DIM)
    scores = jnp.einsum('bnqhd,bnkhd->bnhqk', q, kb,
                        preferred_element_type=jnp.float32) * (HEAD_DIM ** -0.5)
    qi = jnp.arange(CHUNK)[:, None]
    kj = jnp.arange(BAND_CHUNKS * CHUNK)[None, :]
    rel = qi - kj + N_LEFT_CHUNKS * CHUNK
    idx = jnp.clip(rel, -REL_CLIP, REL_CLIP) + REL_CLIP
    bias = jnp.transpose(rel_bias.astype(jnp.float32)[idx], (2, 0, 1))
    valid = jnp.repeat(band >= N_LEFT_CHUNKS, CHUNK, axis=1)
    scores = jnp.where(valid[None, :, None, None, :], scores + bias[None, None], MASK_VALUE)
    p = jax.nn.softmax(scores, axis=-1)
    o = jnp.einsum('bnhqk,bnkhd->bnqhd', p.astype(vb.dtype), vb)
    o = o.reshape(B, S, ATTN_WIDTH)
    return _rmsnorm(o, norm_g)


def _swiglu(h, wg, wu, wd):
    return (jax.nn.silu(h @ wg) * (h @ wu)) @ wd


def _moe(h, router, wg, wu, wd):
    logits = (h @ router).astype(jnp.float32)
    top_val, top_idx = lax.top_k(logits, TOP_K)
    gates = jax.nn.softmax(top_val, axis=-1)
    combine = jnp.sum(jax.nn.one_hot(top_idx, N_EXPERTS, dtype=jnp.float32) * gates[..., None], axis=-2)
    combine = combine.astype(h.dtype)
    y = jnp.zeros_like(h)
    for e in range(N_EXPERTS):
        y = y + combine[..., e:e + 1] * _swiglu(h, wg[e], wu[e], wd[e])
    return y


def setup_inputs(seed: int = 0) -> dict:
    key = jax.random.key(seed)
    keys = jax.random.split(key, 40)
    counter = [0]

    def nxt():
        kk = keys[counter[0]]
        counter[0] += 1
        return kk

    nrm = lambda shape, scale: scale * jax.random.normal(nxt(), shape, jnp.float32)
    L = DEPTH
    x = nrm((BATCH, SEQ, D_MODEL), 1.0)
    norm_mix_g = 1.0 + nrm((L, D_MODEL), 0.02)
    w_in = nrm((L, D_MODEL, IN_COLS), D_MODEL ** -0.5)
    shift_mu = jax.random.uniform(nxt(), (L, SHIFT_COLS), jnp.float32, 0.2, 0.8)
    ramp = jnp.linspace(0.0, 1.0, RWKV_WIDTH) ** 0.85
    rwkv_w0 = (-6.5 + 5.0 * ramp)[None, :] + nrm((L, RWKV_WIDTH), 0.1)
    rwkv_w2 = nrm((L, DECAY_LORA, RWKV_WIDTH), 0.1 * DECAY_LORA ** -0.5)
    rwkv_a0 = nrm((L, RWKV_WIDTH), 0.2)
    rwkv_a2 = nrm((L, AAA_LORA, RWKV_WIDTH), 0.5 * AAA_LORA ** -0.5)
    rwkv_g2 = nrm((L, GATE_LORA, RWKV_WIDTH), GATE_LORA ** -0.5)
    rwkv_k_k = 0.85 + nrm((L, RWKV_WIDTH), 0.05)
    rwkv_k_a = 1.0 + nrm((L, RWKV_WIDTH), 0.05)
    rwkv_r_k = nrm((L, RWKV_WIDTH), 0.1)
    rwkv_ln_w = 1.0 + nrm((L, RWKV_WIDTH), 0.02)
    rwkv_ln_b = nrm((L, RWKV_WIDTH), 0.02)
    attn_rel_bias = nrm((L, 2 * REL_CLIP + 1, ATTN_HEADS), 0.5)
    attn_norm_g = 1.0 + nrm((L, ATTN_WIDTH), 0.02)
    w_out = nrm((L, D_MODEL, D_MODEL), D_MODEL ** -0.5)
    norm_ffn_g = 1.0 + nrm((L, D_MODEL), 0.02)
    ffn_w_gate = nrm((N_DENSE, D_MODEL, D_FF), D_MODEL ** -0.5)
    ffn_w_up = nrm((N_DENSE, D_MODEL, D_FF), D_MODEL ** -0.5)
    ffn_w_down = nrm((N_DENSE, D_FF, D_MODEL), D_FF ** -0.5)
    moe_router = nrm((N_MOE, D_MODEL, N_EXPERTS), D_MODEL ** -0.5)
    moe_w_gate = nrm((N_MOE, N_EXPERTS, D_MODEL, D_FF_EXPERT), D_MODEL ** -0.5)
    moe_w_up = nrm((N_MOE, N_EXPERTS, D_MODEL, D_FF_EXPERT), D_MODEL ** -0.5)
    moe_w_down = nrm((N_MOE, N_EXPERTS, D_FF_EXPERT, D_MODEL), D_FF_EXPERT ** -0.5)
    norm_final_g = 1.0 + nrm((D_MODEL,), 0.02)
    return {'x': x, 'norm_mix_g': norm_mix_g, 'w_in': w_in, 'shift_mu': shift_mu,
            'rwkv_w0': rwkv_w0, 'rwkv_w2': rwkv_w2, 'rwkv_a0': rwkv_a0, 'rwkv_a2': rwkv_a2,
            'rwkv_g2': rwkv_g2, 'rwkv_k_k': rwkv_k_k, 'rwkv_k_a': rwkv_k_a, 'rwkv_r_k': rwkv_r_k,
            'rwkv_ln_w': rwkv_ln_w, 'rwkv_ln_b': rwkv_ln_b, 'attn_rel_bias': attn_rel_bias,
            'attn_norm_g': attn_norm_g, 'w_out': w_out, 'norm_ffn_g': norm_ffn_g,
            'ffn_w_gate': ffn_w_gate, 'ffn_w_up': ffn_w_up, 'ffn_w_down': ffn_w_down,
            'moe_router': moe_router, 'moe_w_gate': moe_w_gate, 'moe_w_up': moe_w_up,
            'moe_w_down': moe_w_down, 'norm_final_g': norm_final_g}


def reference(x, norm_mix_g, w_in, shift_mu, rwkv_w0, rwkv_w2, rwkv_a0, rwkv_a2, rwkv_g2,
              rwkv_k_k, rwkv_k_a, rwkv_r_k, rwkv_ln_w, rwkv_ln_b, attn_rel_bias, attn_norm_g,
              w_out, norm_ffn_g, ffn_w_gate, ffn_w_up, ffn_w_down, moe_router, moe_w_gate,
              moe_w_up, moe_w_down, norm_final_g):
    for l in range(DEPTH):
        h = _rmsnorm(x, norm_mix_g[l])
        proj = h @ w_in[l]
        r, k, v, wd, ad, gd = _split(_token_shift(proj[..., :SHIFT_COLS], shift_mu[l]), SHIFT_SIZES)
        qa, ka, va = _split(proj[..., SHIFT_COLS:], ATTN_SIZES)
        y_rwkv = _rwkv7(r, k, v, wd, ad, gd, rwkv_w0[l], rwkv_w2[l], rwkv_a0[l], rwkv_a2[l],
                        rwkv_g2[l], rwkv_k_k[l], rwkv_k_a[l], rwkv_r_k[l], rwkv_ln_w[l], rwkv_ln_b[l])
        y_attn = _chunk_attention(qa, ka, va, attn_rel_bias[l], attn_norm_g[l])
        x = x + jnp.concatenate([y_rwkv, y_attn], axis=-1) @ w_out[l]
        h = _rmsnorm(x, norm_ffn_g[l])
        li = l // 2
        if l % 2 == 0:
            x = x + _swiglu(h, ffn_w_gate[li], ffn_w_up[li], ffn_w_down[li])
        else:
            x = x + _moe(h, moe_router[li], moe_w_gate[li], moe_w_up[li], moe_w_down[li])
    return _rmsnorm(x, norm_final_g)
```

```cpp
#include <hip/hip_runtime.h>
#include <cstdio>
#include <cstdint>

typedef unsigned short bf16_t;

constexpr int D_MODEL = 1024, BATCH = 8, SEQ = 2048, TOK = BATCH * SEQ;
constexpr int CHUNK = 64, NCHUNK = SEQ / CHUNK;
constexpr int RW = 512, AW = 512, HD = 64, NH = 8;
constexpr int IN_COLS = 3328, SHIFT_COLS = 1792;
constexpr int C_R = 0, C_K = 512, C_V = 1024, C_WD = 1536, C_AD = 1600, C_GD = 1664, C_QA = 1792, C_KA = 2304, C_VA = 2816;
constexpr int D_FF = 2816, NE = 8, D_FFE = 1408;
constexpr float RMS_EPS = 1e-6f, GN_EPS = 64e-5f;

__device__ __forceinline__ unsigned f2bf(float f) { unsigned u = __builtin_bit_cast(unsigned, f); return (u + 0x7fffu + ((u >> 16) & 1u)) >> 16; }
__device__ __forceinline__ float bf2f(unsigned short h) { return __builtin_bit_cast(float, (unsigned)h << 16); }
__device__ __forceinline__ float wave_sum(float v) {
#pragma unroll
    for (int o = 1; o < 64; o <<= 1) v += __shfl_xor(v, o);
    return v;
}
__device__ __forceinline__ float sigmoidf_(float x) { return 1.f / (1.f + __expf(-x)); }

template <int MODE>
__global__ void __launch_bounds__(256) k_rmsnorm(const float* x, const float* __restrict__ g, bf16_t* xn, float* outf,
                                                const float* __restrict__ router, float* combine) {
    const int lane = threadIdx.x & 63, wave = threadIdx.x >> 6;
    const int row = blockIdx.x * 4 + wave;
    if (row >= TOK) return;
    const float4* xr = (const float4*)(x + (size_t)row * D_MODEL);
    float4 v[4]; float s = 0.f;
#pragma unroll
    for (int j = 0; j < 4; ++j) { v[j] = xr[lane + 64 * j]; s += v[j].x * v[j].x + v[j].y * v[j].y + v[j].z * v[j].z + v[j].w * v[j].w; }
    s = wave_sum(s);
    const float rstd = rsqrtf(s * (1.f / D_MODEL) + RMS_EPS);
    float lg[8];
#pragma unroll
    for (int e = 0; e < 8; ++e) lg[e] = 0.f;
#pragma unroll
    for (int j = 0; j < 4; ++j) {
        const int c0 = (lane + 64 * j) * 4;
        const float4 gg = *(const float4*)(g + c0);
        float h0 = v[j].x * rstd * gg.x, h1 = v[j].y * rstd * gg.y, h2 = v[j].z * rstd * gg.z, h3 = v[j].w * rstd * gg.w;
        if (MODE == 2) { *(float4*)(outf + (size_t)row * D_MODEL + c0) = make_float4(h0, h1, h2, h3); }
        else { uint2 o; o.x = f2bf(h0) | (f2bf(h1) << 16); o.y = f2bf(h2) | (f2bf(h3) << 16); *(uint2*)(xn + (size_t)row * D_MODEL + c0) = o; }
        if (MODE == 1) {
            const float hh[4] = {h0, h1, h2, h3};
#pragma unroll
            for (int i = 0; i < 4; ++i) {
                const float4 r0 = *(const float4*)(router + (size_t)(c0 + i) * 8), r1 = *(const float4*)(router + (size_t)(c0 + i) * 8 + 4);
                lg[0] += hh[i] * r0.x; lg[1] += hh[i] * r0.y; lg[2] += hh[i] * r0.z; lg[3] += hh[i] * r0.w;
                lg[4] += hh[i] * r1.x; lg[5] += hh[i] * r1.y; lg[6] += hh[i] * r1.z; lg[7] += hh[i] * r1.w;
            }
        }
    }
    if (MODE == 1) {
#pragma unroll
        for (int e = 0; e < 8; ++e) lg[e] = wave_sum(lg[e]);
        if (lane == 0) {
            int i0 = 0; float v0 = lg[0];
#pragma unroll
            for (int e = 1; e < 8; ++e) if (lg[e] > v0) { v0 = lg[e]; i0 = e; }
            int i1 = -1; float v1 = -3.0e38f;
#pragma unroll
            for (int e = 0; e < 8; ++e) if (e != i0 && lg[e] > v1) { v1 = lg[e]; i1 = e; }
            const float e1 = __expf(v1 - v0), inv = 1.f / (1.f + e1);
            float cb[8];
#pragma unroll
            for (int e = 0; e < 8; ++e) cb[e] = (e == i0) ? inv : ((e == i1) ? e1 * inv : 0.f);
            *(float4*)(combine + (size_t)row * 8) = make_float4(cb[0], cb[1], cb[2], cb[3]);
            *(float4*)(combine + (size_t)row * 8 + 4) = make_float4(cb[4], cb[5], cb[6], cb[7]);
        }
    }
}

enum { EPI_BF16 = 0, EPI_RES = 1, EPI_SWIGLU = 2, EPI_ACC_SCALED = 3 };
template <int EPI>
__global__ void __launch_bounds__(256) k_gemm(const bf16_t* __restrict__ A, int lda, const float* __restrict__ W0, const float* __restrict__ W1, int ldw, int K,
                                             bf16_t* outb, float* outf, int ldo, const float* res, const float* scale, int sstride) {
    constexpr bool DUAL = (EPI == EPI_SWIGLU);
    __shared__ float As[16][68];
    __shared__ float Bs[16][64];
    __shared__ float Bs2[DUAL ? 16 : 1][64];
    const int tid = threadIdx.x, tx = tid & 15, ty = tid >> 4;
    const int m0 = blockIdx.y * 64, n0 = blockIdx.x * 64;
    float acc[4][4], acc2[4][4];
#pragma unroll
    for (int i = 0; i < 4; ++i)
#pragma unroll
        for (int j = 0; j < 4; ++j) { acc[i][j] = 0.f; acc2[i][j] = 0.f; }
    const int ar = tid >> 2, ak = (tid & 3) * 4;
    const int bk = tid >> 4, bn = (tid & 15) * 4;
    for (int k0 = 0; k0 < K; k0 += 16) {
        const uint2 av = *(const uint2*)(A + (size_t)(m0 + ar) * lda + k0 + ak);
        As[ak + 0][ar] = bf2f(av.x & 0xffff); As[ak + 1][ar] = bf2f(av.x >> 16); As[ak + 2][ar] = bf2f(av.y & 0xffff); As[ak + 3][ar] = bf2f(av.y >> 16);
        *(float4*)&Bs[bk][bn] = *(const float4*)(W0 + (size_t)(k0 + bk) * ldw + n0 + bn);
        if (DUAL) *(float4*)&Bs2[bk][bn] = *(const float4*)(W1 + (size_t)(k0 + bk) * ldw + n0 + bn);
        __syncthreads();
#pragma unroll
        for (int k = 0; k < 16; ++k) {
            const float4 a = *(const float4*)&As[k][ty * 4];
            const float4 b = *(const float4*)&Bs[k][tx * 4];
            const float aa[4] = {a.x, a.y, a.z, a.w}, bb[4] = {b.x, b.y, b.z, b.w};
#pragma unroll
            for (int i = 0; i < 4; ++i)
#pragma unroll
                for (int j = 0; j < 4; ++j) acc[i][j] += aa[i] * bb[j];
            if (DUAL) {
                const float4 b2 = *(const float4*)&Bs2[k][tx * 4];
                const float cc[4] = {b2.x, b2.y, b2.z, b2.w};
#pragma unroll
                for (int i = 0; i < 4; ++i)
#pragma unroll
                    for (int j = 0; j < 4; ++j) acc2[i][j] += aa[i] * cc[j];
            }
        }
        __syncthreads();
    }
#pragma unroll
    for (int i = 0; i < 4; ++i) {
        const int m = m0 + ty * 4 + i, n = n0 + tx * 4;
        if (EPI == EPI_BF16) {
            uint2 o; o.x = f2bf(acc[i][0]) | (f2bf(acc[i][1]) << 16); o.y = f2bf(acc[i][2]) | (f2bf(acc[i][3]) << 16);
            *(uint2*)(outb + (size_t)m * ldo + n) = o;
        } else if (EPI == EPI_RES) {
            const float4 r = *(const float4*)(res + (size_t)m * ldo + n);
            *(float4*)(outf + (size_t)m * ldo + n) = make_float4(r.x + acc[i][0], r.y + acc[i][1], r.z + acc[i][2], r.w + acc[i][3]);
        } else if (EPI == EPI_SWIGLU) {
            float o[4];
#pragma unroll
            for (int j = 0; j < 4; ++j) { const float gv = acc[i][j]; o[j] = gv * sigmoidf_(gv) * acc2[i][j]; }
            uint2 ov; ov.x = f2bf(o[0]) | (f2bf(o[1]) << 16); ov.y = f2bf(o[2]) | (f2bf(o[3]) << 16);
            *(uint2*)(outb + (size_t)m * ldo + n) = ov;
        } else {
            const float sc = scale[(size_t)m * sstride];
            float4 r = *(const float4*)(outf + (size_t)m * ldo + n);
            r.x += sc * acc[i][0]; r.y += sc * acc[i][1]; r.z += sc * acc[i][2]; r.w += sc * acc[i][3];
            *(float4*)(outf + (size_t)m * ldo + n) = r;
        }
    }
}

struct RwkvParams {
    const float *mu, *w0, *w2, *a0, *a2, *g2, *k_k, *k_a, *r_k, *ln_w, *ln_b;
};
constexpr int RWKV_LDS = (7 * 4096 + 8192 + 64) * 4;
__global__ void __launch_bounds__(512) k_rwkv(const bf16_t* __restrict__ proj, RwkvParams P0, bf16_t* ymix) {
    extern __shared__ __attribute__((aligned(16))) float sm[];
    float* sR = sm; float* sDEC = sm + 4096; float* sKP = sm + 2 * 4096; float* sV = sm + 3 * 4096; float* sKK = sm + 4 * 4096; float* sKKA = sm + 5 * 4096; float* sG = sm + 6 * 4096;
    float* sST = sm + 7 * 4096;
    float* sBON = sST + 8192;
    const int tid = threadIdx.x, b = blockIdx.x >> 3, h = blockIdx.x & 7;
    const int tk = tid >> 3, sub = tid & 7;
    float S[8];
#pragma unroll
    for (int i = 0; i < 8; ++i) S[i] = 0.f;
#pragma unroll 1
    for (int cb = 0; cb < NCHUNK; ++cb) {
        const int t0 = cb * CHUNK;
        RwkvParams P = P0;
        asm volatile("" : "+s"(P.mu), "+s"(P.w0), "+s"(P.w2), "+s"(P.a0), "+s"(P.a2), "+s"(P.g2));
        asm volatile("" : "+s"(P.k_k), "+s"(P.k_a), "+s"(P.r_k), "+s"(P.ln_w), "+s"(P.ln_b));
        const size_t row = (size_t)b * SEQ + t0 + tk;
        const bf16_t* pr = proj + row * IN_COLS;
        const bool has_prev = (t0 + tk) > 0;
        const bf16_t* pp = pr - IN_COLS;
        auto shifted = [&](int col) -> float { const float cur = bf2f(pr[col]); const float prev = has_prev ? bf2f(pp[col]) : 0.f; return cur + P.mu[col] * (prev - cur); };
#pragma unroll
        for (int i = 0; i < 8; ++i) { const int j = sub * 8 + i; sST[tk * 128 + j] = tanhf(shifted(C_WD + j)); }
        __syncthreads();
        float av[8];
        {
            float acc[8];
#pragma unroll
            for (int i = 0; i < 8; ++i) acc[i] = P.w0[h * 64 + sub * 8 + i];
#pragma unroll 2
            for (int j = 0; j < 64; ++j) { const float t = sST[tk * 128 + j]; const float* wr = P.w2 + (size_t)j * RW + h * 64 + sub * 8;
#pragma unroll
                for (int i = 0; i < 8; ++i) acc[i] += t * wr[i]; }
#pragma unroll
            for (int i = 0; i < 8; ++i) { const float xx = -acc[i]; const float sp = (xx > 20.f) ? xx : log1pf(__expf(xx)); const float w = -sp - 0.5f; sDEC[tk * 64 + sub * 8 + i] = __expf(-__expf(w)); }
        }
        __syncthreads();
#pragma unroll
        for (int i = 0; i < 8; ++i) { const int j = sub * 8 + i; sST[tk * 128 + j] = shifted(C_AD + j); }
        __syncthreads();
        {
            float acc[8];
#pragma unroll
            for (int i = 0; i < 8; ++i) acc[i] = P.a0[h * 64 + sub * 8 + i];
#pragma unroll 2
            for (int j = 0; j < 64; ++j) { const float t = sST[tk * 128 + j]; const float* wr = P.a2 + (size_t)j * RW + h * 64 + sub * 8;
#pragma unroll
                for (int i = 0; i < 8; ++i) acc[i] += t * wr[i]; }
#pragma unroll
            for (int i = 0; i < 8; ++i) av[i] = sigmoidf_(acc[i]);
        }
        __syncthreads();
#pragma unroll
        for (int i = 0; i < 16; ++i) { const int j = sub * 16 + i; sST[tk * 128 + j] = sigmoidf_(shifted(C_GD + j)); }
        __syncthreads();
        {
            float acc[8];
#pragma unroll
            for (int i = 0; i < 8; ++i) acc[i] = 0.f;
#pragma unroll 2
            for (int j = 0; j < 128; ++j) { const float t = sST[tk * 128 + j]; const float* wr = P.g2 + (size_t)j * RW + h * 64 + sub * 8;
#pragma unroll
                for (int i = 0; i < 8; ++i) acc[i] += t * wr[i]; }
#pragma unroll
            for (int i = 0; i < 8; ++i) sG[tk * 64 + sub * 8 + i] = acc[i];
        }
        {
            float rr[8], kv[8], vv[8], kk[8], kp[8]; float ss = 0.f, bon = 0.f;
#pragma unroll
            for (int i = 0; i < 8; ++i) {
                const int c = h * 64 + sub * 8 + i;
                rr[i] = shifted(C_R + c); kv[i] = shifted(C_K + c); vv[i] = shifted(C_V + c);
                kk[i] = kv[i] * P.k_k[c]; ss += kk[i] * kk[i];
                kp[i] = kv[i] * (1.f + (av[i] - 1.f) * P.k_a[c]);
                bon += rr[i] * kp[i] * P.r_k[c];
            }
            ss += __shfl_xor(ss, 1); ss += __shfl_xor(ss, 2); ss += __shfl_xor(ss, 4);
            bon += __shfl_xor(bon, 1); bon += __shfl_xor(bon, 2); bon += __shfl_xor(bon, 4);
            const float inv = 1.f / fmaxf(sqrtf(ss), 1e-12f);
#pragma unroll
            for (int i = 0; i < 8; ++i) {
                const int o = tk * 64 + sub * 8 + i; const float kn = kk[i] * inv;
                sR[o] = rr[i]; sKP[o] = kp[i]; sV[o] = vv[i]; sKK[o] = kn; sKKA[o] = kn * av[i];
            }
            if (sub == 0) sBON[tk] = bon;
        }
        __syncthreads();
#pragma unroll 1
        for (int t = 0; t < CHUNK; ++t) {
            const float* dk = sDEC + t * 64 + sub * 8; const float* kkp = sKK + t * 64 + sub * 8; const float* kap = sKKA + t * 64 + sub * 8;
            const float* kpp = sKP + t * 64 + sub * 8; const float* rp = sR + t * 64 + sub * 8;
            float sa = 0.f;
#pragma unroll
            for (int i = 0; i < 8; ++i) sa -= S[i] * kkp[i];
            sa += __shfl_xor(sa, 1); sa += __shfl_xor(sa, 2); sa += __shfl_xor(sa, 4);
            const float vt = sV[t * 64 + tk];
            float y = 0.f;
#pragma unroll
            for (int i = 0; i < 8; ++i) { S[i] = S[i] * dk[i] + sa * kap[i] + vt * kpp[i]; y += S[i] * rp[i]; }
            y += __shfl_xor(y, 1); y += __shfl_xor(y, 2); y += __shfl_xor(y, 4);
            if (sub == 0) sST[t * 64 + tk] = y;
        }
        __syncthreads();
        {
            float yv[8]; float s1 = 0.f;
#pragma unroll
            for (int i = 0; i < 8; ++i) { yv[i] = sST[tk * 64 + sub * 8 + i]; s1 += yv[i]; }
            s1 += __shfl_xor(s1, 1); s1 += __shfl_xor(s1, 2); s1 += __shfl_xor(s1, 4);
            const float mean = s1 * (1.f / 64.f); float s2 = 0.f;
#pragma unroll
            for (int i = 0; i < 8; ++i) { const float d = yv[i] - mean; s2 += d * d; }
            s2 += __shfl_xor(s2, 1); s2 += __shfl_xor(s2, 2); s2 += __shfl_xor(s2, 4);
            const float rstd = rsqrtf(s2 * (1.f / 64.f) + GN_EPS); const float bon = sBON[tk];
            unsigned pk[4];
#pragma unroll
            for (int i = 0; i < 8; i += 2) {
                float o[2];
#pragma unroll
                for (int u = 0; u < 2; ++u) { const int c = h * 64 + sub * 8 + i + u; const int o_ = tk * 64 + sub * 8 + i + u;
                    o[u] = ((yv[i + u] - mean) * rstd * P.ln_w[c] + P.ln_b[c] + bon * sV[o_]) * sG[o_]; }
                pk[i >> 1] = f2bf(o[0]) | (f2bf(o[1]) << 16);
            }
            *(uint4*)(ymix + row * D_MODEL + h * 64 + sub * 8) = make_uint4(pk[0], pk[1], pk[2], pk[3]);
        }
        __syncthreads();
    }
}

__global__ void __launch_bounds__(512) k_attn(const bf16_t* __restrict__ proj, const float* __restrict__ rel_bias  , float* oatt  ) {
    __shared__ float tbl[257];
    const int tid = threadIdx.x, q = tid >> 3, sub = tid & 7;
    const int unit = blockIdx.x, h = unit & 7, n = (unit >> 3) & 31, b = unit >> 8;
    for (int i = tid; i < 257; i += 512) tbl[i] = rel_bias[i * 8 + h];
    __syncthreads();
    const size_t qrow = (size_t)b * SEQ + n * CHUNK + q;
    float qv[64];
    {
        const bf16_t* qp = proj + qrow * IN_COLS + C_QA + h * 64;
#pragma unroll
        for (int d = 0; d < 64; d += 8) { const uint4 u = *(const uint4*)(qp + d); const unsigned w[4] = {u.x, u.y, u.z, u.w};
#pragma unroll
            for (int i = 0; i < 4; ++i) { qv[d + 2 * i] = bf2f(w[i] & 0xffff) * 0.125f; qv[d + 2 * i + 1] = bf2f(w[i] >> 16) * 0.125f; } }
    }
    float m = -3.0e38f, l = 0.f, o[64];
#pragma unroll
    for (int d = 0; d < 64; ++d) o[d] = 0.f;
    const int c_lo = (n >= 8) ? 0 : (8 - n);
    for (int c = c_lo; c <= 8; ++c) {
        const int kc = n + c - 8;
        for (int jj = 0; jj < 8; ++jj) {
            const int jl = jj * 8 + sub;
            const size_t krow = (size_t)b * SEQ + kc * CHUNK + jl;
            const bf16_t* kp = proj + krow * IN_COLS + C_KA + h * 64;
            float s = 0.f;
#pragma unroll
            for (int d = 0; d < 64; d += 8) { const uint4 u = *(const uint4*)(kp + d); const unsigned w[4] = {u.x, u.y, u.z, u.w};
#pragma unroll
                for (int i = 0; i < 4; ++i) { s += qv[d + 2 * i] * bf2f(w[i] & 0xffff); s += qv[d + 2 * i + 1] * bf2f(w[i] >> 16); } }
            int rel = q - (c * 64 + jl) + 512; rel = rel < -128 ? -128 : (rel > 128 ? 128 : rel);
            s += tbl[rel + 128];
            const float mn = fmaxf(m, s), alpha = __expf(m - mn), p = __expf(s - mn);
            l = l * alpha + p; m = mn;
            const bf16_t* vp = proj + krow * IN_COLS + C_VA + h * 64;
#pragma unroll
            for (int d = 0; d < 64; d += 8) { const uint4 u = *(const uint4*)(vp + d); const unsigned w[4] = {u.x, u.y, u.z, u.w};
#pragma unroll
                for (int i = 0; i < 4; ++i) { o[d + 2 * i] = o[d + 2 * i] * alpha + p * bf2f(w[i] & 0xffff); o[d + 2 * i + 1] = o[d + 2 * i + 1] * alpha + p * bf2f(w[i] >> 16); } }
        }
    }
    float mm = m;
    mm = fmaxf(mm, __shfl_xor(mm, 1)); mm = fmaxf(mm, __shfl_xor(mm, 2)); mm = fmaxf(mm, __shfl_xor(mm, 4));
    const float sc = __expf(m - mm);
    l *= sc; l += __shfl_xor(l, 1); l += __shfl_xor(l, 2); l += __shfl_xor(l, 4);
    const float inv = 1.f / l;
    float* op = oatt + qrow * AW + h * 64;
#pragma unroll
    for (int d = 0; d < 64; ++d) {
        float v = o[d] * sc; v += __shfl_xor(v, 1); v += __shfl_xor(v, 2); v += __shfl_xor(v, 4);
        if ((d >> 3) == sub) op[d] = v * inv;
    }
}
__global__ void __launch_bounds__(256) k_attn_norm(const float* __restrict__ oatt, const float* __restrict__ g, bf16_t* ymix) {
    const int lane = threadIdx.x & 63, wave = threadIdx.x >> 6; const int row = blockIdx.x * 4 + wave;
    const float4* xr = (const float4*)(oatt + (size_t)row * AW);
    float4 v[2]; float s = 0.f;
#pragma unroll
    for (int j = 0; j < 2; ++j) { v[j] = xr[lane + 64 * j]; s += v[j].x * v[j].x + v[j].y * v[j].y + v[j].z * v[j].z + v[j].w * v[j].w; }
    s = wave_sum(s); const float rstd = rsqrtf(s * (1.f / AW) + RMS_EPS);
#pragma unroll
    for (int j = 0; j < 2; ++j) { const int c0 = (lane + 64 * j) * 4; const float4 gg = *(const float4*)(g + c0);
        uint2 o; o.x = f2bf(v[j].x * rstd * gg.x) | (f2bf(v[j].y * rstd * gg.y) << 16); o.y = f2bf(v[j].z * rstd * gg.z) | (f2bf(v[j].w * rstd * gg.w) << 16);
        *(uint2*)(ymix + (size_t)row * D_MODEL + RW + c0) = o; }
}

constexpr size_t MiB = 1u << 20;
constexpr size_t WS_XN = 0, WS_PROJ = 32 * MiB, WS_YMIX = 136 * MiB, WS_OATT = 168 * MiB, WS_COMB = 200 * MiB, WS_END = 201 * MiB;

extern "C" void kernel_launch(void* const* d_in, const int* in_sizes, int n_in, void* d_out, int out_size, void* d_ws, size_t ws_size, hipStream_t stream) {
    if (n_in != 26 || out_size != TOK * D_MODEL || ws_size < WS_END) { fprintf(stderr, "kernel_launch: unexpected shapes n_in %d out %d ws %zu\n", n_in, out_size, ws_size); return; }
    const float* x = (const float*)d_in[0];
    const float* norm_mix_g = (const float*)d_in[1]; const float* w_in = (const float*)d_in[2]; const float* shift_mu = (const float*)d_in[3];
    const float* rwkv_w0 = (const float*)d_in[4]; const float* rwkv_w2 = (const float*)d_in[5]; const float* rwkv_a0 = (const float*)d_in[6]; const float* rwkv_a2 = (const float*)d_in[7];
    const float* rwkv_g2 = (const float*)d_in[8]; const float* rwkv_k_k = (const float*)d_in[9]; const float* rwkv_k_a = (const float*)d_in[10]; const float* rwkv_r_k = (const float*)d_in[11];
    const float* rwkv_ln_w = (const float*)d_in[12]; const float* rwkv_ln_b = (const float*)d_in[13]; const float* attn_rel_bias = (const float*)d_in[14]; const float* attn_norm_g = (const float*)d_in[15];
    const float* w_out = (const float*)d_in[16]; const float* norm_ffn_g = (const float*)d_in[17]; const float* ffn_w_gate = (const float*)d_in[18]; const float* ffn_w_up = (const float*)d_in[19];
    const float* ffn_w_down = (const float*)d_in[20]; const float* moe_router = (const float*)d_in[21]; const float* moe_w_gate = (const float*)d_in[22]; const float* moe_w_up = (const float*)d_in[23];
    const float* moe_w_down = (const float*)d_in[24]; const float* norm_final_g = (const float*)d_in[25];
    float* out = (float*)d_out; unsigned char* ws = (unsigned char*)d_ws;
    bf16_t* XN = (bf16_t*)(ws + WS_XN); bf16_t* PROJ = (bf16_t*)(ws + WS_PROJ); bf16_t* YMIX = (bf16_t*)(ws + WS_YMIX); float* OATT = (float*)(ws + WS_OATT); float* COMB = (float*)(ws + WS_COMB);
    bf16_t* ACT = PROJ;
    static bool attr_set = false;
    if (!attr_set) { (void)hipFuncSetAttribute((const void*)k_rwkv, hipFuncAttributeMaxDynamicSharedMemorySize, RWKV_LDS); attr_set = true; }
    for (int l = 0; l < 2; ++l) {
        const float* xres = (l == 0) ? x : out;
        k_rmsnorm<0><<<TOK / 4, 256, 0, stream>>>(xres, norm_mix_g + l * D_MODEL, XN, nullptr, nullptr, nullptr);
        k_gemm<EPI_BF16><<<dim3(IN_COLS / 64, TOK / 64), 256, 0, stream>>>(XN, D_MODEL, w_in + (size_t)l * D_MODEL * IN_COLS, nullptr, IN_COLS, D_MODEL, PROJ, nullptr, IN_COLS, nullptr, nullptr, 0);
        RwkvParams P{shift_mu + l * SHIFT_COLS, rwkv_w0 + l * RW, rwkv_w2 + (size_t)l * 64 * RW, rwkv_a0 + l * RW, rwkv_a2 + (size_t)l * 64 * RW, rwkv_g2 + (size_t)l * 128 * RW,
                     rwkv_k_k + l * RW, rwkv_k_a + l * RW, rwkv_r_k + l * RW, rwkv_ln_w + l * RW, rwkv_ln_b + l * RW};
        k_rwkv<<<BATCH * NH, 512, RWKV_LDS, stream>>>(PROJ, P, YMIX);
        k_attn<<<BATCH * NCHUNK * NH, 512, 0, stream>>>(PROJ, attn_rel_bias + (size_t)l * 257 * 8, OATT);
        k_attn_norm<<<TOK / 4, 256, 0, stream>>>(OATT, attn_norm_g + l * AW, YMIX);
        k_gemm<EPI_RES><<<dim3(D_MODEL / 64, TOK / 64), 256, 0, stream>>>(YMIX, D_MODEL, w_out + (size_t)l * D_MODEL * D_MODEL, nullptr, D_MODEL, D_MODEL, nullptr, out, D_MODEL, xres, nullptr, 0);
        if (l == 0) {
            k_rmsnorm<0><<<TOK / 4, 256, 0, stream>>>(out, norm_ffn_g + l * D_MODEL, XN, nullptr, nullptr, nullptr);
            k_gemm<EPI_SWIGLU><<<dim3(D_FF / 64, TOK / 64), 256, 0, stream>>>(XN, D_MODEL, ffn_w_gate, ffn_w_up, D_FF, D_MODEL, ACT, nullptr, D_FF, nullptr, nullptr, 0);
            k_gemm<EPI_RES><<<dim3(D_MODEL / 64, TOK / 64), 256, 0, stream>>>(ACT, D_FF, ffn_w_down, nullptr, D_MODEL, D_FF, nullptr, out, D_MODEL, out, nullptr, 0);
        } else {
            k_rmsnorm<1><<<TOK / 4, 256, 0, stream>>>(out, norm_ffn_g + l * D_MODEL, XN, nullptr, moe_router, COMB);
            for (int e = 0; e < NE; ++e) {
                k_gemm<EPI_SWIGLU><<<dim3(D_FFE / 64, TOK / 64), 256, 0, stream>>>(XN, D_MODEL, moe_w_gate + (size_t)e * D_MODEL * D_FFE, moe_w_up + (size_t)e * D_MODEL * D_FFE, D_FFE, D_MODEL, ACT, nullptr, D_FFE, nullptr, nullptr, 0);
                k_gemm<EPI_ACC_SCALED><<<dim3(D_MODEL / 64, TOK / 64), 256, 0, stream>>>(ACT, D_FFE, moe_w_down + (size_t)e * D_FFE * D_MODEL, nullptr, D_MODEL, D_FFE, nullptr, out, D_MODEL, nullptr, COMB + e, NE);
            }
        }
    }
    k_rmsnorm<2><<<TOK / 4, 256, 0, stream>>>(out, norm_final_g, nullptr, out, nullptr, nullptr);
}
```

```cpp
#include <hip/hip_runtime.h>
#include <hip/hip_cooperative_groups.h>
#include <cstdio>
#include <cstdint>
namespace cg = cooperative_groups;

namespace pg8 {
#define PG8_LAS __attribute__((address_space(3)))
typedef unsigned short bf16_t;
typedef short bf16x8 __attribute__((ext_vector_type(8)));
typedef float f32x4 __attribute__((ext_vector_type(4)));
typedef unsigned u32x4 __attribute__((ext_vector_type(4)));
constexpr int BM = 256, BK = 64, HALF = 128, HTB = HALF * BK * 2  , STAGE_BYTES = 8 * HTB, NXCD = 8, WGM = 8;

__host__ __device__ __forceinline__ int lds_byte(int r, int c) { const int st = (r >> 4) * 2 + (c >> 5), rr = r & 15, cc = c & 31, ob = rr * 64 + cc * 2; return st * 1024 + (ob ^ (((ob >> 9) & 1) << 5)); }
__host__ __device__ __forceinline__ void stage_rc(int b, int& R, int& C) { const int st = b / 1024, sb = b % 1024, swz = sb ^ (((sb >> 9) & 1) << 5); R = (st >> 1) * 16 + swz / 64; C = (st & 1) * 32 + (swz % 64) / 2; }
__host__ __device__ __forceinline__ int perm32(int rho) { const int n = rho >> 4, i = rho & 15; return 8 * (i >> 2) + 4 * n + (i & 3); }

struct Unit { int pm, pn; };
struct Gemm { const bf16_t* A; const bf16_t* Bt; int M, N, K; };

struct StaticOrder {
    int nM, nN, nwg, G, c;
    __host__ __device__ void init(int M, int N, int G_, int c_) { nM = M / BM; nN = N / BM; nwg = nM * nN; G = G_; c = c_; }
    __host__ __device__ bool next(int i, Unit& u) const {
        const long L = (long)i * G + c; if (L >= nwg) return false;
        int wgid = (int)L; { const int q = nwg / NXCD, r = nwg % NXCD, xcd = wgid % NXCD, off = wgid / NXCD; wgid = (xcd < r ? xcd * (q + 1) : r * (q + 1) + (xcd - r) * q) + off; }
        const int nig = WGM * nN, gid = wgid / nig, fm = gid * WGM, gsz = (nM - fm) < WGM ? (nM - fm) : WGM;
        u.pm = fm + ((wgid % nig) % gsz); u.pn = (wgid % nig) / gsz; return true;
    }
    __device__ __forceinline__ void a_ready(const Unit&) const {}
    __device__ __forceinline__ void done(const Unit&) const {}
};

__device__ __forceinline__ unsigned cvt_pk_bf16(float lo, float hi) { unsigned r; asm volatile("v_cvt_pk_bf16_f32 %0, %1, %2" : "=v"(r) : "v"(lo), "v"(hi)); return r; }
typedef float f32x2 __attribute__((ext_vector_type(2)));
typedef unsigned u32x2 __attribute__((ext_vector_type(2)));
struct EpiBf16 {
    static constexpr bool PERM = true, AFTER_DRAIN = false;
    bf16_t* O; int ldc;
    __device__ __forceinline__ void operator()(const f32x4 (&acc)[2][2][4][2], const Unit& u, int wr, int wc, int fr, int fq) const {
        const int row0 = u.pm * BM + wr * 64 + fr; const int col0 = u.pn * BM + wc * 32 + 8 * fq;
#pragma unroll
        for (int ai = 0; ai < 2; ++ai)
#pragma unroll
            for (int m = 0; m < 4; ++m) { bf16_t* rowp = O + (size_t)(row0 + ai * HALF + m * 16) * ldc + col0;
#pragma unroll
                for (int bj = 0; bj < 2; ++bj) { const f32x4 v0 = acc[ai][bj][m][0], v1 = acc[ai][bj][m][1];
                    u32x4 w; w.x = cvt_pk_bf16(v0[0], v0[1]); w.y = cvt_pk_bf16(v0[2], v0[3]); w.z = cvt_pk_bf16(v1[0], v1[1]); w.w = cvt_pk_bf16(v1[2], v1[3]);
                    *(u32x4*)(rowp + bj * HALF) = w; } }
    }
};
struct EpiSwiglu {
    static constexpr bool PERM = true, AFTER_DRAIN = false;
    bf16_t* O; int ldc;
    __device__ __forceinline__ void operator()(const f32x4 (&acc)[2][2][4][2], const Unit& u, int wr, int wc, int fr, int fq) const {
        const int row0 = u.pm * BM + wr * 64 + fr; const int col0 = (u.pn * BM + wc * 32 + 8 * fq) >> 1;
#pragma unroll
        for (int ai = 0; ai < 2; ++ai)
#pragma unroll
            for (int m = 0; m < 4; ++m) { bf16_t* rowp = O + (size_t)(row0 + ai * HALF + m * 16) * ldc + col0;
#pragma unroll
                for (int bj = 0; bj < 2; ++bj) { const f32x4 v0 = acc[ai][bj][m][0], v1 = acc[ai][bj][m][1];
                    const float g0 = v0[0], g1 = v0[2], g2 = v1[0], g3 = v1[2];
                    const float a0 = g0 * __builtin_amdgcn_rcpf(1.f + __expf(-g0)) * v0[1], a1 = g1 * __builtin_amdgcn_rcpf(1.f + __expf(-g1)) * v0[3];
                    const float a2 = g2 * __builtin_amdgcn_rcpf(1.f + __expf(-g2)) * v1[1], a3 = g3 * __builtin_amdgcn_rcpf(1.f + __expf(-g3)) * v1[3];
                    u32x2 w; w.x = cvt_pk_bf16(a0, a1); w.y = cvt_pk_bf16(a2, a3);
                    *(u32x2*)(rowp + bj * (HALF / 2)) = w; } }
    }
};
struct EpiRes {
    static constexpr bool PERM = false, AFTER_DRAIN = false;
    const float* base; float* out; int ldc; const float* scale; int sstride;
    __device__ __forceinline__ void operator()(const f32x4 (&acc)[2][2][4][2], const Unit& u, int wr, int wc, int fr, int fq) const {
        const int col0 = u.pn * BM + wc * 32 + 4 * fq;
#pragma unroll
        for (int ai = 0; ai < 2; ++ai)
#pragma unroll
            for (int m = 0; m < 4; ++m) { const int r = u.pm * BM + ai * HALF + wr * 64 + m * 16 + fr; const size_t off = (size_t)r * ldc + col0;
                const float sc = scale ? scale[(size_t)r * sstride] : 1.f;
#pragma unroll
                for (int bj = 0; bj < 2; ++bj)
#pragma unroll
                    for (int n = 0; n < 2; ++n) { const f32x4 bs = *(const f32x4*)(base + off + bj * HALF + n * 16); *(f32x4*)(out + off + bj * HALF + n * 16) = bs + acc[ai][bj][m][n] * sc; }
                asm volatile("" ::: "memory"); }
    }
};
template <class Epi, class Sched, bool ALIGN_EPI = false, bool SP2 = false>
__device__ __forceinline__ void gemm_phase(PG8_LAS unsigned char* lds, const Gemm g, const Sched& S, const Epi& E) {
    int tid_ = threadIdx.x; asm volatile("" : "+v"(tid_));
    const int tid = tid_, wid = __builtin_amdgcn_readfirstlane(tid >> 6), lane = tid & 63, wr = wid >> 2, wc = wid & 3, fr = lane & 15, fq = lane >> 4;
    const int K = g.K, nt = K / BK;
    unsigned voffA[2], voffB[2];
#pragma unroll
    for (int i = 0; i < 2; ++i) { int R, C; stage_rc(tid * 16 + i * 8192, R, C); const int Rb = Epi::PERM ? ((R & ~31) + perm32(R & 31)) : R;
        voffA[i] = (unsigned)(R * K + C) * 2u; voffB[i] = (unsigned)(Rb * K + C) * 2u; }
    const size_t kstep = (size_t)(BK * 2);
    const size_t hstep = (size_t)HALF * K * 2;
    const size_t tstep = 2 * hstep;
    const unsigned ldsw = (unsigned)wid * 1024u;
    const int aoff = lds_byte(wr * 64 + fr, fq * 8), boff = lds_byte(wc * 32 + fr, fq * 8);
#define PG8_SA(b, h) (((b) * 2 + (h)) * HTB)
#define PG8_SB(b, h) ((4 + (b) * 2 + (h)) * HTB)
#define PG8_STAGE(bufoff, gbase, voff) do { _Pragma("unroll") for (int _i = 0; _i < 2; ++_i) \
        __builtin_amdgcn_global_load_lds((const unsigned*)((const char*)(gbase) + (voff)[_i]), (PG8_LAS unsigned*)(lds + (bufoff) + ldsw + _i * 8192), 16, 0, 0); } while (0)
#define PG8_LDA(dst, b, h) do { _Pragma("unroll") for (int m = 0; m < 4; ++m) _Pragma("unroll") for (int k = 0; k < 2; ++k) dst[m][k] = *(const PG8_LAS bf16x8*)(lds + PG8_SA(b, h) + aoff + m * 2048 + k * 1024); } while (0)
#define PG8_LDB(dst, b, h) do { _Pragma("unroll") for (int n = 0; n < 2; ++n) _Pragma("unroll") for (int k = 0; k < 2; ++k) dst[n][k] = *(const PG8_LAS bf16x8*)(lds + PG8_SB(b, h) + boff + n * 2048 + k * 1024); } while (0)
#define PG8_MMA(ai, bj, At, Bt) do { __builtin_amdgcn_s_setprio(1); _Pragma("unroll") for (int m = 0; m < 4; ++m) _Pragma("unroll") for (int n = 0; n < 2; ++n) _Pragma("unroll") for (int k = 0; k < 2; ++k) \
        acc[ai][bj][m][n] = __builtin_amdgcn_mfma_f32_16x16x32_bf16(Bt[n][k], At[m][k], acc[ai][bj][m][n], 0, 0, 0); __builtin_amdgcn_s_setprio(0); } while (0)
#define PG8_WAIT_V(n) asm volatile("s_waitcnt vmcnt(" #n ")" ::: "memory")
#define PG8_WAIT_L(n) asm volatile("s_waitcnt lgkmcnt(" #n ")" ::: "memory")
#define PG8_BAR __builtin_amdgcn_s_barrier()
#define PG8_SCHED __builtin_amdgcn_sched_barrier(0)
    Unit cur, nxt; int ui = 0;
    if (!S.next(0, cur)) return;
    f32x4 acc[2][2][4][2];
#pragma unroll
    for (int a = 0; a < 2; ++a)
#pragma unroll
        for (int b = 0; b < 2; ++b)
#pragma unroll
            for (int m = 0; m < 4; ++m)
#pragma unroll
                for (int n = 0; n < 2; ++n) acc[a][b][m][n] = (f32x4){0.f, 0.f, 0.f, 0.f};
    bf16x8 At[4][2], B0[2][2], B1[2][2];
    const char* cA = (const char*)g.A + (size_t)cur.pm * tstep; const char* cB = (const char*)g.Bt + (size_t)cur.pn * tstep;
    S.a_ready(cur);
    if constexpr (SP2) {
        PG8_STAGE(PG8_SB(0, 0), cB, voffB); PG8_STAGE(PG8_SB(0, 1), cB + hstep, voffB); PG8_STAGE(PG8_SA(0, 0), cA, voffA); PG8_STAGE(PG8_SA(0, 1), cA + hstep, voffA);
        if (wr == 1) PG8_BAR;
        PG8_WAIT_V(2); PG8_BAR;
        PG8_STAGE(PG8_SB(1, 0), cB + kstep, voffB); PG8_STAGE(PG8_SA(1, 0), cA + kstep, voffA); PG8_STAGE(PG8_SB(1, 1), cB + hstep + kstep, voffB);
        PG8_WAIT_V(6); PG8_BAR;
    } else {
        PG8_STAGE(PG8_SB(0, 0), cB, voffB); PG8_STAGE(PG8_SA(0, 0), cA, voffA); PG8_STAGE(PG8_SB(0, 1), cB + hstep, voffB); PG8_STAGE(PG8_SA(0, 1), cA + hstep, voffA);
        if (wr == 1) PG8_BAR;
        PG8_WAIT_V(4); PG8_BAR;
        PG8_STAGE(PG8_SB(1, 0), cB + kstep, voffB); PG8_STAGE(PG8_SA(1, 0), cA + kstep, voffA); PG8_STAGE(PG8_SB(1, 1), cB + hstep + kstep, voffB);
        PG8_WAIT_V(6); PG8_BAR;
    }
    for (;;) {
        const bool has_next = S.next(ui + 1, nxt);
        const char* nA = has_next ? (const char*)g.A + (size_t)nxt.pm * tstep : cA; const char* nB = has_next ? (const char*)g.Bt + (size_t)nxt.pn * tstep : cB;
        for (int t = 0; t < nt; t += 2) {
            const bool last = (t == nt - 2);
            const char* a1 = cA + (size_t)(t + 1) * kstep;
            const char* a2 = last ? nA : cA + (size_t)(t + 2) * kstep; const char* b2 = last ? nB : cB + (size_t)(t + 2) * kstep;
            const char* a3 = a2 + kstep; const char* b3 = b2 + kstep;
            if (last && has_next) S.a_ready(nxt);
            if constexpr (SP2) {
            PG8_LDB(B0, 0, 0); PG8_LDB(B1, 0, 1); PG8_SCHED; PG8_LDA(At, 0, 0); PG8_STAGE(PG8_SA(1, 1), a1 + hstep, voffA);
            PG8_WAIT_V(8); PG8_WAIT_L(0); PG8_BAR; PG8_MMA(0, 0, At, B0); PG8_MMA(0, 1, At, B1); PG8_BAR; PG8_SCHED;
            PG8_LDA(At, 0, 1); PG8_STAGE(PG8_SB(0, 0), b2, voffB); PG8_STAGE(PG8_SB(0, 1), b2 + hstep, voffB); PG8_STAGE(PG8_SA(0, 0), a2, voffA);
            PG8_WAIT_V(8); PG8_WAIT_L(0); PG8_BAR; PG8_MMA(1, 0, At, B0); PG8_MMA(1, 1, At, B1); PG8_BAR; PG8_SCHED;
            PG8_LDB(B0, 1, 0); PG8_LDB(B1, 1, 1); PG8_SCHED; PG8_LDA(At, 1, 0); PG8_STAGE(PG8_SA(0, 1), a2 + hstep, voffA);
            PG8_WAIT_V(8); PG8_WAIT_L(0); PG8_BAR; PG8_MMA(0, 0, At, B0); PG8_MMA(0, 1, At, B1); PG8_BAR; PG8_SCHED;
            PG8_LDA(At, 1, 1); PG8_STAGE(PG8_SB(1, 0), b3, voffB); PG8_STAGE(PG8_SB(1, 1), b3 + hstep, voffB); PG8_STAGE(PG8_SA(1, 0), a3, voffA);
            PG8_WAIT_V(8); PG8_WAIT_L(0); PG8_BAR; PG8_MMA(1, 0, At, B0); PG8_MMA(1, 1, At, B1); PG8_BAR; PG8_SCHED;
            } else {
            PG8_LDB(B0, 0, 0); PG8_SCHED; PG8_LDA(At, 0, 0); PG8_STAGE(PG8_SA(1, 1), a1 + hstep, voffA);
            PG8_WAIT_L(8); PG8_BAR; PG8_WAIT_L(0); PG8_MMA(0, 0, At, B0); PG8_BAR; PG8_SCHED;
            PG8_LDB(B1, 0, 1); PG8_STAGE(PG8_SB(0, 0), b2, voffB);
            PG8_BAR; PG8_WAIT_L(0); PG8_MMA(0, 1, At, B1); PG8_BAR;
            PG8_LDA(At, 0, 1); PG8_STAGE(PG8_SA(0, 0), a2, voffA);
            PG8_BAR; PG8_WAIT_L(0); PG8_MMA(1, 0, At, B0); PG8_BAR; PG8_SCHED;
            PG8_STAGE(PG8_SB(0, 1), b2 + hstep, voffB);
            PG8_WAIT_V(6); PG8_BAR; PG8_MMA(1, 1, At, B1); PG8_BAR;
            PG8_LDB(B0, 1, 0); PG8_SCHED; PG8_LDA(At, 1, 0); PG8_STAGE(PG8_SA(0, 1), a2 + hstep, voffA);
            PG8_WAIT_L(8); PG8_BAR; PG8_WAIT_L(0); PG8_MMA(0, 0, At, B0); PG8_BAR; PG8_SCHED;
            PG8_LDB(B1, 1, 1); PG8_STAGE(PG8_SB(1, 0), b3, voffB);
            PG8_BAR; PG8_WAIT_L(0); PG8_MMA(0, 1, At, B1); PG8_BAR;
            PG8_LDA(At, 1, 1); PG8_STAGE(PG8_SA(1, 0), a3, voffA);
            PG8_BAR; PG8_WAIT_L(0); PG8_MMA(1, 0, At, B0); PG8_BAR; PG8_SCHED;
            PG8_STAGE(PG8_SB(1, 1), b3 + hstep, voffB);
            PG8_WAIT_V(6); PG8_BAR; PG8_MMA(1, 1, At, B1); PG8_BAR;
            }
        }
        if constexpr (ALIGN_EPI) { if (wr == 0) PG8_BAR; }
        if constexpr (!Epi::AFTER_DRAIN) { E(acc, cur, wr, wc, fr, fq); S.done(cur); }
        if (!has_next) break;
#pragma unroll
        for (int a = 0; a < 2; ++a)
#pragma unroll
            for (int b = 0; b < 2; ++b)
#pragma unroll
                for (int m = 0; m < 4; ++m)
#pragma unroll
                    for (int n = 0; n < 2; ++n) acc[a][b][m][n] = (f32x4){0.f, 0.f, 0.f, 0.f};
        cur = nxt; cA = nA; cB = nB; ++ui;
        if constexpr (ALIGN_EPI) { if (wr == 1) PG8_BAR; }
    }
    PG8_WAIT_V(0);
    if constexpr (!ALIGN_EPI) { if (wr == 0) PG8_BAR; }
    PG8_BAR;
    if constexpr (Epi::AFTER_DRAIN) { E.fused(acc, cur, wr, wc, fr, fq, lds, wid, lane); S.done(cur); }
#undef PG8_SA
#undef PG8_SB
#undef PG8_STAGE
#undef PG8_LDA
#undef PG8_LDB
#undef PG8_MMA
#undef PG8_WAIT_V
#undef PG8_WAIT_L
#undef PG8_BAR
#undef PG8_SCHED
}
}
typedef unsigned short bf16_t;
constexpr int D_MODEL = 1024, BATCH = 8, SEQ = 2048, TOK = BATCH * SEQ;
constexpr int CHUNK = 64, NCHUNK = SEQ / CHUNK;
constexpr int RW = 512, AW = 512, NH = 8;
constexpr int IN_COLS = 3328, SHIFT_COLS = 1792;
constexpr int C_R = 0, C_K = 512, C_V = 1024, C_WD = 1536, C_AD = 1600, C_GD = 1664, C_QA = 1792, C_KA = 2304, C_VA = 2816;
constexpr int D_FF = 2816, NE = 8, D_FFE = 1408;
constexpr float RMS_EPS = 1e-6f, GN_EPS = 64e-5f;
constexpr int NWAVES = 8, NTHREADS = 512;

constexpr size_t MiB = 1u << 20;
constexpr size_t WS_CTL = 0, CTL_ZERO_BYTES = 64 * 1024;
constexpr size_t SZ_WIN = (size_t)IN_COLS * D_MODEL * 2, SZ_WOUT = (size_t)D_MODEL * D_MODEL * 2, SZ_FGU = (size_t)2 * D_FF * D_MODEL * 2, SZ_FDN = (size_t)D_MODEL * D_FF * 2;
constexpr size_t SZ_MGU = (size_t)2 * D_FFE * D_MODEL * 2, SZ_MDN = (size_t)D_MODEL * D_FFE * 2;
constexpr size_t WS_WIN = 1 * MiB, WS_WOUT = WS_WIN + 2 * SZ_WIN, WS_FGU = WS_WOUT + 2 * SZ_WOUT, WS_FDN = WS_FGU + SZ_FGU, WS_MGU = WS_FDN + SZ_FDN, WS_MDN = WS_MGU + NE * SZ_MGU, WS_WEND = WS_MDN + NE * SZ_MDN;
constexpr size_t WS_XN = 101 * MiB;
constexpr size_t WS_PROJ = 133 * MiB;
constexpr size_t WS_OATT = 237 * MiB;
constexpr size_t WS_COMB = 253 * MiB;
constexpr size_t WS_END = 254 * MiB;
static_assert(WS_WEND <= WS_XN, "weights fit below XN");

#define GAS __attribute__((address_space(1)))
#define LAS __attribute__((address_space(3)))
typedef unsigned short bf16;
typedef unsigned v4u __attribute__((ext_vector_type(4)));
typedef float f32x4 __attribute__((ext_vector_type(4)));
typedef short bf16x8 __attribute__((ext_vector_type(8)));
typedef GAS unsigned gu32;
typedef GAS unsigned long long gu64;
#define RLX_AGENT __ATOMIC_RELAXED, __HIP_MEMORY_SCOPE_AGENT
#define LDS_WAIT() asm volatile("s_waitcnt lgkmcnt(0)" ::: "memory")
#define VM_WAIT() asm volatile("s_waitcnt vmcnt(0)" ::: "memory")
__device__ __forceinline__ unsigned long long rt() { return __builtin_amdgcn_s_memrealtime(); }
__device__ __forceinline__ unsigned f2bf(float f) { unsigned u = __builtin_bit_cast(unsigned, f); return (u + 0x7fffu + ((u >> 16) & 1u)) >> 16; }
__device__ __forceinline__ unsigned pk2(float lo, float hi) { return f2bf(lo) | (f2bf(hi) << 16); }
constexpr int CW_BAR = 1024;
#define XB_TMO      128
#define XB_XCNT(j)  (256  + 64 * (j))
#define XB_XSUB(j)  (1280 + 64 * (j))
#define XB_XGEN(j)  (2304 + 64 * (j))
#define XB_TOP      3328
#define XB_TOPGEN   3392
#define XCD_BAR_WORDS 3456
#define XB_SPIN_CAP (1u << 18)

__device__ __forceinline__ unsigned xb_ld(unsigned* p)              { return __hip_atomic_load(p, __ATOMIC_RELAXED, __HIP_MEMORY_SCOPE_AGENT); }
__device__ __forceinline__ unsigned xb_add(unsigned* p, unsigned v) { return __hip_atomic_fetch_add(p, v, __ATOMIC_RELAXED, __HIP_MEMORY_SCOPE_AGENT); }
__device__ __forceinline__ unsigned xb_xcc_id() { return (unsigned)__builtin_amdgcn_s_getreg((3 << 11) | 20) & 0xFu; }
#define XB_SPIN(cond, bar) do { unsigned _sp = 0; while (cond) { __builtin_amdgcn_s_sleep(1); \
    if ((++_sp & 255u) == 0u) { if (xb_ld(&(bar)[XB_TMO])) break; if (_sp > XB_SPIN_CAP) { atomicAdd(&(bar)[XB_TMO], 1u); break; } } } } while (0)

struct XcdBarrier {
    unsigned* bar; unsigned x;
    volatile LAS unsigned* st;
};

__device__ __forceinline__ XcdBarrier xcd_barrier_post(unsigned* bar, volatile LAS unsigned* st) {
    XcdBarrier b; b.bar = bar; b.x = xb_xcc_id(); b.st = st;
    if (threadIdx.x == 0) (void)xb_add(&bar[XB_XCNT(b.x)], 1u);
    return b;
}
__device__ __forceinline__ void xcd_barrier_complete(unsigned* bar, unsigned x, unsigned& nloc, unsigned& nx) {
    const unsigned G = gridDim.x * gridDim.y * gridDim.z;
    unsigned sum, cnt, mine, sp = 0u;
    for (;;) {
        sum = 0u; cnt = 0u; mine = 0u;
#pragma unroll
        for (unsigned j = 0; j < 16; ++j) { const unsigned c = xb_ld(&bar[XB_XCNT(j)]); sum += c; cnt += (c > 0u) ? 1u : 0u; mine = (j == x) ? c : mine; }
        if (sum == G) break;
        __builtin_amdgcn_s_sleep(1);
        if ((++sp & 255u) == 0u) { if (xb_ld(&bar[XB_TMO])) break; if (sp > XB_SPIN_CAP) { atomicAdd(&bar[XB_TMO], 1u); break; } }
    }
    nloc = mine > 0u ? mine : 1u; nx = cnt > 0u ? cnt : 1u;
}

__device__ __forceinline__ void xcd_barrier(const XcdBarrier& b) {
    asm volatile("s_waitcnt vmcnt(0)" ::: "memory");
    __syncthreads();
    if (threadIdx.x == 0) {
        unsigned* bar = b.bar;
        __builtin_amdgcn_s_waitcnt(0);
        unsigned nloc = b.st[0], nx = b.st[1];
        if (nloc == 0u) { xcd_barrier_complete(bar, b.x, nloc, nx); b.st[0] = nloc; b.st[1] = nx; }
        const unsigned old = xb_add(&bar[XB_XSUB(b.x)], 1u);
        const unsigned gen = old / nloc;
        if (old + 1u == (gen + 1u) * nloc) {
            __builtin_amdgcn_fence(__ATOMIC_RELEASE, "agent");
            asm volatile("s_waitcnt vmcnt(0)" ::: "memory");
            const unsigned og = xb_add(&bar[XB_TOP], 1u);
            const unsigned tg = og / nx;
            if (og + 1u == (tg + 1u) * nx) xb_add(&bar[XB_TOPGEN], 1u);
            else XB_SPIN(xb_ld(&bar[XB_TOPGEN]) == tg, bar);
            __builtin_amdgcn_fence(__ATOMIC_ACQUIRE, "agent");
            xb_add(&bar[XB_XGEN(b.x)], 1u);
            asm volatile("s_waitcnt vmcnt(0)" ::: "memory");
        } else {
            XB_SPIN(xb_ld(&bar[XB_XGEN(b.x)]) == gen, bar);
            __builtin_amdgcn_fence(__ATOMIC_ACQUIRE, "agent");
            asm volatile("s_waitcnt vmcnt(0)" ::: "memory");
        }
    }
    __syncthreads();
}
__device__ __forceinline__ float bf2f(unsigned h) { return __builtin_bit_cast(float, h << 16); }
__device__ __forceinline__ float wave_sum(float v) {
#pragma unroll
    for (int o = 1; o < 64; o <<= 1) v += __shfl_xor(v, o);
    return v;
}
__device__ __forceinline__ float sigmoidf_(float x) { return 1.f / (1.f + __expf(-x)); }

__device__ __forceinline__ void p0_transpose_item(const float* W, int K, int N, bf16_t* WT, int row_off, int rmul, LAS float* scr, int item, int lane) {
    const int nblk = N / 32, kb = item / nblk, nb = item % nblk, k0 = 64 * kb, n0 = 32 * nb;
#pragma unroll 8
    for (int i = 0; i < 32; ++i) { const int kk = 2 * i + (lane >> 5); scr[kk * 33 + (lane & 31)] = W[(size_t)(k0 + kk) * N + n0 + (lane & 31)]; }
    LDS_WAIT(); asm volatile("" ::: "memory");
    const int c = lane & 7;
#pragma unroll
    for (int j = 0; j < 4; ++j) { const int n = (lane >> 3) + 8 * j; const LAS float* s = scr + (8 * c) * 33 + n;
        v4u o; o.x = pk2(s[0 * 33], s[1 * 33]); o.y = pk2(s[2 * 33], s[3 * 33]); o.z = pk2(s[4 * 33], s[5 * 33]); o.w = pk2(s[6 * 33], s[7 * 33]);
        *(GAS v4u*)(WT + (size_t)(row_off + (n0 + n) * rmul) * K + k0 + 8 * c) = o; }
    LDS_WAIT(); asm volatile("" ::: "memory");
}

template <int MODE>
__device__ __forceinline__ void norm_rows(int gw, int ngw, int lane, const float* x, const float* __restrict__ g, bf16_t* xn, float* outf, const float* __restrict__ router, float* combine) {
    for (int row = gw; row < TOK; row += ngw) {
        const float4* xr = (const float4*)(x + (size_t)row * D_MODEL);
        float4 v[4]; float s = 0.f;
#pragma unroll
        for (int j = 0; j < 4; ++j) { v[j] = xr[lane + 64 * j]; s += v[j].x * v[j].x + v[j].y * v[j].y + v[j].z * v[j].z + v[j].w * v[j].w; }
        s = wave_sum(s);
        const float rstd = rsqrtf(s * (1.f / D_MODEL) + RMS_EPS);
        float lg[8];
#pragma unroll
        for (int e = 0; e < 8; ++e) lg[e] = 0.f;
#pragma unroll
        for (int j = 0; j < 4; ++j) {
            const int c0 = (lane + 64 * j) * 4;
            const float4 gg = *(const float4*)(g + c0);
            const float h0 = v[j].x * rstd * gg.x, h1 = v[j].y * rstd * gg.y, h2 = v[j].z * rstd * gg.z, h3 = v[j].w * rstd * gg.w;
            if (MODE == 2) { *(float4*)(outf + (size_t)row * D_MODEL + c0) = make_float4(h0, h1, h2, h3); }
            else { uint2 o; o.x = pk2(h0, h1); o.y = pk2(h2, h3); *(uint2*)(xn + (size_t)row * D_MODEL + c0) = o; }
            if (MODE == 1) {
                const float hh[4] = {h0, h1, h2, h3};
#pragma unroll
                for (int i = 0; i < 4; ++i) {
                    const float4 r0 = *(const float4*)(router + (size_t)(c0 + i) * 8), r1 = *(const float4*)(router + (size_t)(c0 + i) * 8 + 4);
                    lg[0] += hh[i] * r0.x; lg[1] += hh[i] * r0.y; lg[2] += hh[i] * r0.z; lg[3] += hh[i] * r0.w;
                    lg[4] += hh[i] * r1.x; lg[5] += hh[i] * r1.y; lg[6] += hh[i] * r1.z; lg[7] += hh[i] * r1.w;
                }
            }
        }
        if (MODE == 1) {
#pragma unroll
            for (int e = 0; e < 8; ++e) lg[e] = wave_sum(lg[e]);
            if (lane == 0) {
                int i0 = 0; float v0 = lg[0];
#pragma unroll
                for (int e = 1; e < 8; ++e) if (lg[e] > v0) { v0 = lg[e]; i0 = e; }
                int i1 = -1; float v1 = -3.0e38f;
#pragma unroll
                for (int e = 0; e < 8; ++e) if (e != i0 && lg[e] > v1) { v1 = lg[e]; i1 = e; }
                const float e1 = __expf(v1 - v0), inv = 1.f / (1.f + e1);
                float cb[8];
#pragma unroll
                for (int e = 0; e < 8; ++e) cb[e] = (e == i0) ? inv : ((e == i1) ? e1 * inv : 0.f);
                *(float4*)(combine + (size_t)row * 8) = make_float4(cb[0], cb[1], cb[2], cb[3]);
                *(float4*)(combine + (size_t)row * 8 + 4) = make_float4(cb[4], cb[5], cb[6], cb[7]);
            }
        }
    }
}

struct RwkvParams { const float *mu, *w0, *w2, *a0, *a2, *g2, *k_k, *k_a, *r_k, *ln_w, *ln_b; };
constexpr int RWKV_LDS = (7 * 4096 + 8192 + 64) * 4;
__device__ __forceinline__ void rwkv_naive_unit(float* sm, int unit, const bf16_t* __restrict__ proj, const RwkvParams& P0, bf16_t* ymix) {
    float* sR = sm; float* sDEC = sm + 4096; float* sKP = sm + 2 * 4096; float* sV = sm + 3 * 4096; float* sKK = sm + 4 * 4096; float* sKKA = sm + 5 * 4096; float* sG = sm + 6 * 4096;
    float* sST = sm + 7 * 4096;
    float* sBON = sST + 8192;
    int tid_ = threadIdx.x; asm volatile("" : "+v"(tid_));
    const int tid = tid_, b = unit >> 3, h = unit & 7;
    const int tk = tid >> 3, sub = tid & 7;
    float S[8];
#pragma unroll
    for (int i = 0; i < 8; ++i) S[i] = 0.f;
#pragma unroll 1
    for (int cb = 0; cb < NCHUNK; ++cb) {
        const int t0 = cb * CHUNK;
        RwkvParams P = P0;
        asm volatile("" : "+s"(P.mu), "+s"(P.w0), "+s"(P.w2), "+s"(P.a0), "+s"(P.a2), "+s"(P.g2));
        asm volatile("" : "+s"(P.k_k), "+s"(P.k_a), "+s"(P.r_k), "+s"(P.ln_w), "+s"(P.ln_b));
        const size_t row = (size_t)b * SEQ + t0 + tk;
        const bf16_t* pr = proj + row * IN_COLS;
        const bool has_prev = (t0 + tk) > 0;
        const bf16_t* pp = pr - IN_COLS;
        auto shifted = [&](int col) -> float { const float cur = bf2f(pr[col]); const float prev = has_prev ? bf2f(pp[col]) : 0.f; return cur + P.mu[col] * (prev - cur); };
#pragma unroll
        for (int i = 0; i < 8; ++i) { const int j = sub * 8 + i; sST[tk * 128 + j] = tanhf(shifted(C_WD + j)); }
        __syncthreads();
        float av[8];
        {
            float acc[8];
#pragma unroll
            for (int i = 0; i < 8; ++i) acc[i] = P.w0[h * 64 + sub * 8 + i];
#pragma unroll 2
            for (int j = 0; j < 64; ++j) { const float t = sST[tk * 128 + j]; const float* wr = P.w2 + (size_t)j * RW + h * 64 + sub * 8;
#pragma unroll
                for (int i = 0; i < 8; ++i) acc[i] += t * wr[i]; }
#pragma unroll
            for (int i = 0; i < 8; ++i) { const float xx = -acc[i]; const float sp = (xx > 20.f) ? xx : log1pf(__expf(xx)); const float w = -sp - 0.5f; sDEC[tk * 64 + sub * 8 + i] = __expf(-__expf(w)); }
        }
        __syncthreads();
#pragma unroll
        for (int i = 0; i < 8; ++i) { const int j = sub * 8 + i; sST[tk * 128 + j] = shifted(C_AD + j); }
        __syncthreads();
        {
            float acc[8];
#pragma unroll
            for (int i = 0; i < 8; ++i) acc[i] = P.a0[h * 64 + sub * 8 + i];
#pragma unroll 2
            for (int j = 0; j < 64; ++j) { const float t = sST[tk * 128 + j]; const float* wr = P.a2 + (size_t)j * RW + h * 64 + sub * 8;
#pragma unroll
                for (int i = 0; i < 8; ++i) acc[i] += t * wr[i]; }
#pragma unroll
            for (int i = 0; i < 8; ++i) av[i] = sigmoidf_(acc[i]);
        }
        __syncthreads();
#pragma unroll
        for (int i = 0; i < 16; ++i) { const int j = sub * 16 + i; sST[tk * 128 + j] = sigmoidf_(shifted(C_GD + j)); }
        __syncthreads();
        {
            float acc[8];
#pragma unroll
            for (int i = 0; i < 8; ++i) acc[i] = 0.f;
#pragma unroll 2
            for (int j = 0; j < 128; ++j) { const float t = sST[tk * 128 + j]; const float* wr = P.g2 + (size_t)j * RW + h * 64 + sub * 8;
#pragma unroll
                for (int i = 0; i < 8; ++i) acc[i] += t * wr[i]; }
#pragma unroll
            for (int i = 0; i < 8; ++i) sG[tk * 64 + sub * 8 + i] = acc[i];
        }
        {
            float rr[8], kv[8], vv[8], kk[8], kp[8]; float ss = 0.f, bon = 0.f;
#pragma unroll
            for (int i = 0; i < 8; ++i) {
                const int c = h * 64 + sub * 8 + i;
                rr[i] = shifted(C_R + c); kv[i] = shifted(C_K + c); vv[i] = shifted(C_V + c);
                kk[i] = kv[i] * P.k_k[c]; ss += kk[i] * kk[i];
                kp[i] = kv[i] * (1.f + (av[i] - 1.f) * P.k_a[c]);
                bon += rr[i] * kp[i] * P.r_k[c];
            }
            ss += __shfl_xor(ss, 1); ss += __shfl_xor(ss, 2); ss += __shfl_xor(ss, 4);
            bon += __shfl_xor(bon, 1); bon += __shfl_xor(bon, 2); bon += __shfl_xor(bon, 4);
            const float inv = 1.f / fmaxf(sqrtf(ss), 1e-12f);
#pragma unroll
            for (int i = 0; i < 8; ++i) {
                const int o = tk * 64 + sub * 8 + i; const float kn = kk[i] * inv;
                sR[o] = rr[i]; sKP[o] = kp[i]; sV[o] = vv[i]; sKK[o] = kn; sKKA[o] = kn * av[i];
            }
            if (sub == 0) sBON[tk] = bon;
        }
        __syncthreads();
#pragma unroll 1
        for (int t = 0; t < CHUNK; ++t) {
            const float* dk = sDEC + t * 64 + sub * 8; const float* kkp = sKK + t * 64 + sub * 8; const float* kap = sKKA + t * 64 + sub * 8;
            const float* kpp = sKP + t * 64 + sub * 8; const float* rp = sR + t * 64 + sub * 8;
            float sa = 0.f;
#pragma unroll
            for (int i = 0; i < 8; ++i) sa -= S[i] * kkp[i];
            sa += __shfl_xor(sa, 1); sa += __shfl_xor(sa, 2); sa += __shfl_xor(sa, 4);
            const float vt = sV[t * 64 + tk];
            float y = 0.f;
#pragma unroll
            for (int i = 0; i < 8; ++i) { S[i] = S[i] * dk[i] + sa * kap[i] + vt * kpp[i]; y += S[i] * rp[i]; }
            y += __shfl_xor(y, 1); y += __shfl_xor(y, 2); y += __shfl_xor(y, 4);
            if (sub == 0) sST[t * 64 + tk] = y;
        }
        __syncthreads();
        {
            float yv[8]; float s1 = 0.f;
#pragma unroll
            for (int i = 0; i < 8; ++i) { yv[i] = sST[tk * 64 + sub * 8 + i]; s1 += yv[i]; }
            s1 += __shfl_xor(s1, 1); s1 += __shfl_xor(s1, 2); s1 += __shfl_xor(s1, 4);
            const float mean = s1 * (1.f / 64.f); float s2 = 0.f;
#pragma unroll
            for (int i = 0; i < 8; ++i) { const float d = yv[i] - mean; s2 += d * d; }
            s2 += __shfl_xor(s2, 1); s2 += __shfl_xor(s2, 2); s2 += __shfl_xor(s2, 4);
            const float rstd = rsqrtf(s2 * (1.f / 64.f) + GN_EPS); const float bon = sBON[tk];
            unsigned pk[4];
#pragma unroll
            for (int i = 0; i < 8; i += 2) {
                float o[2];
#pragma unroll
                for (int u = 0; u < 2; ++u) { const int c = h * 64 + sub * 8 + i + u; const int o_ = tk * 64 + sub * 8 + i + u;
                    o[u] = ((yv[i + u] - mean) * rstd * P.ln_w[c] + P.ln_b[c] + bon * sV[o_]) * sG[o_]; }
                pk[i >> 1] = pk2(o[0], o[1]);
            }
            *(uint4*)(ymix + row * D_MODEL + h * 64 + sub * 8) = make_uint4(pk[0], pk[1], pk[2], pk[3]);
        }
        __syncthreads();
    }
}

__device__ __forceinline__ void attn_naive_unit(float* tbl, int unit, const bf16_t* __restrict__ proj, const float* __restrict__ rel_bias  , bf16_t* oatt  ) {
    int tid_ = threadIdx.x; asm volatile("" : "+v"(tid_));
    const int tid = tid_, q = tid >> 3, sub = tid & 7;
    const int h = unit & 7, n = (unit >> 3) & 31, b = unit >> 8;
    __syncthreads();
    for (int i = tid; i < 257; i += NTHREADS) tbl[i] = rel_bias[i * 8 + h];
    __syncthreads();
    const size_t qrow = (size_t)b * SEQ + n * CHUNK + q;
    float qv[64];
    {
        const bf16_t* qp = proj + qrow * IN_COLS + C_QA + h * 64;
#pragma unroll
        for (int d = 0; d < 64; d += 8) { const uint4 u = *(const uint4*)(qp + d); const unsigned w[4] = {u.x, u.y, u.z, u.w};
#pragma unroll
            for (int i = 0; i < 4; ++i) { qv[d + 2 * i] = bf2f(w[i] & 0xffff) * 0.125f; qv[d + 2 * i + 1] = bf2f(w[i] >> 16) * 0.125f; } }
    }
    float m = -3.0e38f, l = 0.f, o[64];
#pragma unroll
    for (int d = 0; d < 64; ++d) o[d] = 0.f;
    const int c_lo = (n >= 8) ? 0 : (8 - n);
#pragma unroll 1
    for (int c = c_lo; c <= 8; ++c) {
        const int kc = n + c - 8;
#pragma unroll 1
        for (int jj = 0; jj < 8; ++jj) {
            const int jl = jj * 8 + sub;
            const size_t krow = (size_t)b * SEQ + kc * CHUNK + jl;
            const bf16_t* kp = proj + krow * IN_COLS + C_KA + h * 64;
            float s = 0.f;
#pragma unroll
            for (int d = 0; d < 64; d += 8) { const uint4 u = *(const uint4*)(kp + d); const unsigned w[4] = {u.x, u.y, u.z, u.w};
#pragma unroll
                for (int i = 0; i < 4; ++i) { s += qv[d + 2 * i] * bf2f(w[i] & 0xffff); s += qv[d + 2 * i + 1] * bf2f(w[i] >> 16); } }
            int rel = q - (c * 64 + jl) + 512; rel = rel < -128 ? -128 : (rel > 128 ? 128 : rel);
            s += tbl[rel + 128];
            const float mn = fmaxf(m, s), alpha = __expf(m - mn), p = __expf(s - mn);
            l = l * alpha + p; m = mn;
            const bf16_t* vp = proj + krow * IN_COLS + C_VA + h * 64;
#pragma unroll
            for (int d = 0; d < 64; d += 8) { const uint4 u = *(const uint4*)(vp + d); const unsigned w[4] = {u.x, u.y, u.z, u.w};
#pragma unroll
                for (int i = 0; i < 4; ++i) { o[d + 2 * i] = o[d + 2 * i] * alpha + p * bf2f(w[i] & 0xffff); o[d + 2 * i + 1] = o[d + 2 * i + 1] * alpha + p * bf2f(w[i] >> 16); } }
        }
    }
    float mm = m;
    mm = fmaxf(mm, __shfl_xor(mm, 1)); mm = fmaxf(mm, __shfl_xor(mm, 2)); mm = fmaxf(mm, __shfl_xor(mm, 4));
    const float sc = __expf(m - mm);
    l *= sc; l += __shfl_xor(l, 1); l += __shfl_xor(l, 2); l += __shfl_xor(l, 4);
    const float inv = 1.f / l;
    bf16_t* op = oatt + qrow * AW + h * 64;
#pragma unroll
    for (int d = 0; d < 64; d += 2) {
        float v0 = o[d] * sc; v0 += __shfl_xor(v0, 1); v0 += __shfl_xor(v0, 2); v0 += __shfl_xor(v0, 4);
        float v1 = o[d + 1] * sc; v1 += __shfl_xor(v1, 1); v1 += __shfl_xor(v1, 2); v1 += __shfl_xor(v1, 4);
        if ((d >> 3) == sub) *(unsigned*)(op + d) = pk2(v0 * inv, v1 * inv);
    }
}
__device__ __forceinline__ void attn_norm_rows(int gw, int ngw, int lane, const bf16_t* __restrict__ oatt, const float* __restrict__ g, bf16_t* ymix) {
    for (int row = gw; row < TOK; row += ngw) {
        const uint4 u = *(const uint4*)(oatt + (size_t)row * AW + lane * 8); const unsigned w[4] = {u.x, u.y, u.z, u.w};
        float v[8]; float s = 0.f;
#pragma unroll
        for (int i = 0; i < 4; ++i) { v[2 * i] = bf2f(w[i] & 0xffff); v[2 * i + 1] = bf2f(w[i] >> 16); s += v[2 * i] * v[2 * i] + v[2 * i + 1] * v[2 * i + 1]; }
        s = wave_sum(s); const float rstd = rsqrtf(s * (1.f / AW) + RMS_EPS);
        const float4 g0 = *(const float4*)(g + lane * 8), g1 = *(const float4*)(g + lane * 8 + 4);
        uint4 o; o.x = pk2(v[0] * rstd * g0.x, v[1] * rstd * g0.y); o.y = pk2(v[2] * rstd * g0.z, v[3] * rstd * g0.w);
        o.z = pk2(v[4] * rstd * g1.x, v[5] * rstd * g1.y); o.w = pk2(v[6] * rstd * g1.z, v[7] * rstd * g1.w);
        *(uint4*)(ymix + (size_t)row * D_MODEL + RW + lane * 8) = o;
    }
}
constexpr int LDS_PHASE_BYTES = 150 * 1024;
constexpr int LDSCTL_OFF = LDS_PHASE_BYTES;
constexpr int LDS_BYTES = LDS_PHASE_BYTES + 1024;
static_assert(RWKV_LDS <= LDS_PHASE_BYTES && pg8::STAGE_BYTES <= LDS_PHASE_BYTES, "LDS map");

struct Args {
    const float* in[26]; float* out; unsigned char* ws;
};
static_assert(sizeof(Args) == 28 * 8, "Args has no padding");

__global__ void __launch_bounds__(NTHREADS, 2) mega_fwd(Args args) {
    extern __shared__ __attribute__((aligned(16))) unsigned char lds[];
    LAS unsigned char* ldsp = (LAS unsigned char*)lds;
    const int G = gridDim.x, bid = blockIdx.x;
#define IDS() int tid = threadIdx.x; asm volatile("" : "+v"(tid)); const int lane = tid & 63, wave = __builtin_amdgcn_readfirstlane(tid >> 6), gw = bid * NWAVES + wave, ngw = G * NWAVES; (void)lane; (void)gw; (void)ngw
    typedef const __attribute__((address_space(4))) Args* KArgs;
#define KA() ({ KArgs _p = (KArgs)__builtin_amdgcn_kernarg_segment_ptr(); asm volatile("" : "+s"(_p)); _p; })
#define IN(i) (KA()->in[i])
#define WSP(off) (KA()->ws + (off))
#define OUTP() (KA()->out)
    { IDS(); for (int u = tid; u < (LDS_BYTES - LDSCTL_OFF) / 4; u += NTHREADS) ((LAS unsigned*)(ldsp + LDSCTL_OFF))[u] = 0u; }
    __syncthreads();
    XcdBarrier bar = xcd_barrier_post((unsigned*)((gu32*)WSP(WS_CTL) + CW_BAR), (volatile LAS unsigned*)(ldsp + LDSCTL_OFF));
#define GRID_BAR() xcd_barrier(bar)
    enum { I_X = 0, I_NMG, I_WIN, I_MU, I_W0, I_W2, I_A0, I_A2, I_G2, I_KK, I_KA, I_RK, I_LNW, I_LNB, I_RELB, I_ANG, I_WOUT, I_NFG, I_FWG, I_FWU, I_FWD, I_ROUTER, I_MWG, I_MWU, I_MWD, I_NFINAL };

    {
        IDS();
        LAS float* scr = (LAS float*)(ldsp + wave * 16384);
        constexpr int I_IN = (D_MODEL / 64) * (IN_COLS / 32), I_OUT = (D_MODEL / 64) * (D_MODEL / 32), I_FG = (D_MODEL / 64) * (D_FF / 32), I_FD = (D_FF / 64) * (D_MODEL / 32);
        constexpr int I_MG = (D_MODEL / 64) * (D_FFE / 32), I_MD = (D_FFE / 64) * (D_MODEL / 32);
        constexpr int NITEMS = 2 * I_IN + 2 * I_OUT + 2 * I_FG + I_FD + NE * (2 * I_MG + I_MD);
#pragma unroll 1
        for (int it = gw; it < NITEMS; it += ngw) {
            int r = it;
            if (r < 2 * I_IN) { const int l = r / I_IN; p0_transpose_item(IN(I_WIN) + (size_t)l * D_MODEL * IN_COLS, D_MODEL, IN_COLS, (bf16_t*)WSP(WS_WIN) + (size_t)l * IN_COLS * D_MODEL, 0, 1, scr, r % I_IN, lane); continue; } r -= 2 * I_IN;
            if (r < 2 * I_OUT) { const int l = r / I_OUT; p0_transpose_item(IN(I_WOUT) + (size_t)l * D_MODEL * D_MODEL, D_MODEL, D_MODEL, (bf16_t*)WSP(WS_WOUT) + (size_t)l * D_MODEL * D_MODEL, 0, 1, scr, r % I_OUT, lane); continue; } r -= 2 * I_OUT;
            if (r < I_FG) { p0_transpose_item(IN(I_FWG), D_MODEL, D_FF, (bf16_t*)WSP(WS_FGU), 0, 2, scr, r, lane); continue; } r -= I_FG;
            if (r < I_FG) { p0_transpose_item(IN(I_FWU), D_MODEL, D_FF, (bf16_t*)WSP(WS_FGU), 1, 2, scr, r, lane); continue; } r -= I_FG;
            if (r < I_FD) { p0_transpose_item(IN(I_FWD), D_FF, D_MODEL, (bf16_t*)WSP(WS_FDN), 0, 1, scr, r, lane); continue; } r -= I_FD;
            const int e = r / (2 * I_MG + I_MD); r -= e * (2 * I_MG + I_MD);
            if (r < I_MG) { p0_transpose_item(IN(I_MWG) + (size_t)e * D_MODEL * D_FFE, D_MODEL, D_FFE, (bf16_t*)WSP(WS_MGU) + (size_t)e * 2 * D_FFE * D_MODEL, 0, 2, scr, r, lane); continue; } r -= I_MG;
            if (r < I_MG) { p0_transpose_item(IN(I_MWU) + (size_t)e * D_MODEL * D_FFE, D_MODEL, D_FFE, (bf16_t*)WSP(WS_MGU) + (size_t)e * 2 * D_FFE * D_MODEL, 1, 2, scr, r, lane); continue; } r -= I_MG;
            p0_transpose_item(IN(I_MWD) + (size_t)e * D_FFE * D_MODEL, D_FFE, D_MODEL, (bf16_t*)WSP(WS_MDN) + (size_t)e * D_MODEL * D_FFE, 0, 1, scr, r, lane);
        }
        { IDS(); norm_rows<0>(gw, ngw, lane, IN(I_X), IN(I_NMG), (bf16_t*)WSP(WS_XN), nullptr, nullptr, nullptr); }
    }
    cg::this_grid().sync();

#pragma unroll 1
    for (int l = 0; l < 2; ++l) {
        {
            pg8::Gemm g{(bf16_t*)WSP(WS_XN), (bf16_t*)WSP(WS_WIN) + (size_t)l * IN_COLS * D_MODEL, TOK, IN_COLS, D_MODEL}; pg8::StaticOrder S; S.init(TOK, IN_COLS, G, bid);
            pg8::EpiBf16 E{(bf16_t*)WSP(WS_PROJ), IN_COLS};
            pg8::gemm_phase<pg8::EpiBf16, pg8::StaticOrder, true, true>(ldsp, g, S, E);
        }
        GRID_BAR();
        {
            const bool split = G > 64;
            if (!split || bid < 64) {
                RwkvParams P{IN(I_MU) + l * SHIFT_COLS, IN(I_W0) + l * RW, IN(I_W2) + (size_t)l * 64 * RW, IN(I_A0) + l * RW, IN(I_A2) + (size_t)l * 64 * RW, IN(I_G2) + (size_t)l * 128 * RW,
                             IN(I_KK) + l * RW, IN(I_KA) + l * RW, IN(I_RK) + l * RW, IN(I_LNW) + l * RW, IN(I_LNB) + l * RW};
#pragma unroll 1
                for (int u = bid; u < BATCH * NH; u += G) rwkv_naive_unit((float*)lds, u, (const bf16_t*)WSP(WS_PROJ), P, (bf16_t*)WSP(WS_XN));
            }
            if (!split || bid >= 64) {
                const int a0 = split ? bid - 64 : bid, an = split ? G - 64 : G;
#pragma unroll 1
                for (int u = a0; u < BATCH * NCHUNK * NH; u += an) attn_naive_unit((float*)lds, u, (const bf16_t*)WSP(WS_PROJ), IN(I_RELB) + (size_t)l * 257 * 8, (bf16_t*)WSP(WS_OATT));
            }
        }
        GRID_BAR();
        { IDS(); attn_norm_rows(gw, ngw, lane, (const bf16_t*)WSP(WS_OATT), IN(I_ANG) + l * AW, (bf16_t*)WSP(WS_XN)); }
        GRID_BAR();
        {
            pg8::Gemm g{(bf16_t*)WSP(WS_XN), (bf16_t*)WSP(WS_WOUT) + (size_t)l * D_MODEL * D_MODEL, TOK, D_MODEL, D_MODEL}; pg8::StaticOrder S; S.init(TOK, D_MODEL, G, bid);
            pg8::EpiRes E{(l == 0) ? IN(I_X) : (const float*)OUTP(), OUTP(), D_MODEL, nullptr, 0};
            pg8::gemm_phase<pg8::EpiRes, pg8::StaticOrder, true, true>(ldsp, g, S, E);
        }
        GRID_BAR();
        if (l == 0) {
            { IDS(); norm_rows<0>(gw, ngw, lane, OUTP(), IN(I_NFG), (bf16_t*)WSP(WS_XN), nullptr, nullptr, nullptr); }
            GRID_BAR();
            {
                pg8::Gemm g{(bf16_t*)WSP(WS_XN), (bf16_t*)WSP(WS_FGU), TOK, 2 * D_FF, D_MODEL}; pg8::StaticOrder S; S.init(TOK, 2 * D_FF, G, bid);
                pg8::EpiSwiglu E{(bf16_t*)WSP(WS_PROJ), D_FF};
                pg8::gemm_phase<pg8::EpiSwiglu, pg8::StaticOrder, true, true>(ldsp, g, S, E);
            }
            GRID_BAR();
            {
                pg8::Gemm g{(bf16_t*)WSP(WS_PROJ), (bf16_t*)WSP(WS_FDN), TOK, D_MODEL, D_FF}; pg8::StaticOrder S; S.init(TOK, D_MODEL, G, bid);
                pg8::EpiRes E{OUTP(), OUTP(), D_MODEL, nullptr, 0};
                pg8::gemm_phase<pg8::EpiRes, pg8::StaticOrder, true, true>(ldsp, g, S, E);
            }
            GRID_BAR();
            { IDS(); norm_rows<0>(gw, ngw, lane, OUTP(), IN(I_NMG) + D_MODEL, (bf16_t*)WSP(WS_XN), nullptr, nullptr, nullptr); }
            GRID_BAR();
        } else {
            { IDS(); norm_rows<1>(gw, ngw, lane, OUTP(), IN(I_NFG) + D_MODEL, (bf16_t*)WSP(WS_XN), nullptr, IN(I_ROUTER), (float*)WSP(WS_COMB)); }
            GRID_BAR();
#pragma unroll 1
            for (int e = 0; e < NE; ++e) {
                {
                    pg8::Gemm g{(bf16_t*)WSP(WS_XN), (bf16_t*)WSP(WS_MGU) + (size_t)e * 2 * D_FFE * D_MODEL, TOK, 2 * D_FFE, D_MODEL}; pg8::StaticOrder S; S.init(TOK, 2 * D_FFE, G, bid);
                    pg8::EpiSwiglu E{(bf16_t*)WSP(WS_PROJ), D_FFE};
                    pg8::gemm_phase<pg8::EpiSwiglu, pg8::StaticOrder, true, true>(ldsp, g, S, E);
                }
                GRID_BAR();
                {
                    pg8::Gemm g{(bf16_t*)WSP(WS_PROJ), (bf16_t*)WSP(WS_MDN) + (size_t)e * D_MODEL * D_FFE, TOK, D_MODEL, D_FFE}; pg8::StaticOrder S; S.init(TOK, D_MODEL, G, bid);
                    pg8::EpiRes E{OUTP(), OUTP(), D_MODEL, (const float*)WSP(WS_COMB) + e, NE};
                    pg8::gemm_phase<pg8::EpiRes, pg8::StaticOrder, true, true>(ldsp, g, S, E);
                }
                GRID_BAR();
            }
        }
    }
    { IDS(); norm_rows<2>(gw, ngw, lane, OUTP(), IN(I_NFINAL), nullptr, OUTP(), nullptr, nullptr); }
}

extern "C" void kernel_launch(void* const* d_in, const int* in_sizes, int n_in, void* d_out, int out_size, void* d_ws, size_t ws_size, hipStream_t stream) {
    static int grid = 0;
    if (grid == 0) {
        if (n_in != 26 || in_sizes[0] != TOK * D_MODEL || out_size != TOK * D_MODEL || ws_size < WS_END) {
            fprintf(stderr, "kernel_launch: unexpected problem: n_in %d in0 %d out %d ws %zu (need %zu); nothing launched\n", n_in, n_in > 0 ? in_sizes[0] : -1, out_size, ws_size, (size_t)WS_END); grid = -1; return; }
        int dev = 0, cus = 0, per_cu = 0;
        if (hipGetDevice(&dev) != hipSuccess || hipDeviceGetAttribute(&cus, hipDeviceAttributeMultiprocessorCount, dev) != hipSuccess) { fprintf(stderr, "kernel_launch: device query failed\n"); grid = -1; return; }
        if (hipFuncSetAttribute((const void*)mega_fwd, hipFuncAttributeMaxDynamicSharedMemorySize, LDS_BYTES) != hipSuccess) { fprintf(stderr, "kernel_launch: hipFuncSetAttribute failed\n"); grid = -1; return; }
        if (hipOccupancyMaxActiveBlocksPerMultiprocessor(&per_cu, (const void*)mega_fwd, NTHREADS, LDS_BYTES) != hipSuccess || per_cu < 1) { fprintf(stderr, "kernel_launch: occupancy query says %d blocks per CU; nothing launched\n", per_cu); (void)hipGetLastError(); grid = -1; return; }
        grid = cus;
    }
    if (grid < 0) return;
    if (hipMemsetAsync((char*)d_ws + WS_CTL, 0, CTL_ZERO_BYTES, stream) != hipSuccess) { fprintf(stderr, "kernel_launch: hipMemsetAsync failed\n"); return; }
    Args a{};
    for (int i = 0; i < 26; ++i) a.in[i] = (const float*)d_in[i];
    a.out = (float*)d_out; a.ws = (unsigned char*)d_ws;
    void* kargs[] = {&a};
    const hipError_t le = hipLaunchCooperativeKernel((const void*)mega_fwd, dim3(grid), dim3(NTHREADS), kargs, LDS_BYTES, stream);
    if (le != hipSuccess) fprintf(stderr, "kernel_launch: cooperative launch failed: %s (grid %d x %d threads, %d B LDS)\n", hipGetErrorString(le), grid, NTHREADS, LDS_BYTES);
}
```

```cpp
#include <hip/hip_runtime.h>
#include <hip/hip_cooperative_groups.h>
#include <cstdio>
#include <cstdint>
namespace cg = cooperative_groups;

namespace pg8 {
#define PG8_LAS __attribute__((address_space(3)))
typedef unsigned short bf16_t;
typedef short bf16x8 __attribute__((ext_vector_type(8)));
typedef float f32x4 __attribute__((ext_vector_type(4)));
typedef unsigned u32x4 __attribute__((ext_vector_type(4)));
constexpr int BM = 256, BK = 64, HALF = 128, HTB = HALF * BK * 2  , STAGE_BYTES = 8 * HTB, NXCD = 8, WGM = 8;

__host__ __device__ __forceinline__ int lds_byte(int r, int c) { const int st = (r >> 4) * 2 + (c >> 5), rr = r & 15, cc = c & 31, ob = rr * 64 + cc * 2; return st * 1024 + (ob ^ (((ob >> 9) & 1) << 5)); }
__host__ __device__ __forceinline__ void stage_rc(int b, int& R, int& C) { const int st = b / 1024, sb = b % 1024, swz = sb ^ (((sb >> 9) & 1) << 5); R = (st >> 1) * 16 + swz / 64; C = (st & 1) * 32 + (swz % 64) / 2; }
__host__ __device__ __forceinline__ int perm32(int rho) { const int n = rho >> 4, i = rho & 15; return 8 * (i >> 2) + 4 * n + (i & 3); }

struct Unit { int pm, pn; };
struct Gemm { const bf16_t* A; const bf16_t* Bt; int M, N, K; };

struct StaticOrder {
    int nM, nN, nwg, G, c;
    __host__ __device__ void init(int M, int N, int G_, int c_) { nM = M / BM; nN = N / BM; nwg = nM * nN; G = G_; c = c_; }
    __host__ __device__ bool next(int i, Unit& u) const {
        const long L = (long)i * G + c; if (L >= nwg) return false;
        int wgid = (int)L; { const int q = nwg / NXCD, r = nwg % NXCD, xcd = wgid % NXCD, off = wgid / NXCD; wgid = (xcd < r ? xcd * (q + 1) : r * (q + 1) + (xcd - r) * q) + off; }
        const int nig = WGM * nN, gid = wgid / nig, fm = gid * WGM, gsz = (nM - fm) < WGM ? (nM - fm) : WGM;
        u.pm = fm + ((wgid % nig) % gsz); u.pn = (wgid % nig) / gsz; return true;
    }
    __device__ __forceinline__ void a_ready(const Unit&) const {}
    __device__ __forceinline__ void done(const Unit&) const {}
};

__device__ __forceinline__ unsigned cvt_pk_bf16(float lo, float hi) { unsigned r; asm volatile("v_cvt_pk_bf16_f32 %0, %1, %2" : "=v"(r) : "v"(lo), "v"(hi)); return r; }
typedef float f32x2 __attribute__((ext_vector_type(2)));
typedef unsigned u32x2 __attribute__((ext_vector_type(2)));
struct EpiBf16 {
    static constexpr bool PERM = true, AFTER_DRAIN = false;
    bf16_t* O; int ldc;
    __device__ __forceinline__ void operator()(const f32x4 (&acc)[2][2][4][2], const Unit& u, int wr, int wc, int fr, int fq) const {
        const int row0 = u.pm * BM + wr * 64 + fr; const int col0 = u.pn * BM + wc * 32 + 8 * fq;
#pragma unroll
        for (int ai = 0; ai < 2; ++ai)
#pragma unroll
            for (int m = 0; m < 4; ++m) { bf16_t* rowp = O + (size_t)(row0 + ai * HALF + m * 16) * ldc + col0;
#pragma unroll
                for (int bj = 0; bj < 2; ++bj) { const f32x4 v0 = acc[ai][bj][m][0], v1 = acc[ai][bj][m][1];
                    u32x4 w; w.x = cvt_pk_bf16(v0[0], v0[1]); w.y = cvt_pk_bf16(v0[2], v0[3]); w.z = cvt_pk_bf16(v1[0], v1[1]); w.w = cvt_pk_bf16(v1[2], v1[3]);
                    *(u32x4*)(rowp + bj * HALF) = w; } }
    }
};
struct EpiSwiglu {
    static constexpr bool PERM = true, AFTER_DRAIN = false;
    bf16_t* O; int ldc;
    __device__ __forceinline__ void operator()(const f32x4 (&acc)[2][2][4][2], const Unit& u, int wr, int wc, int fr, int fq) const {
        const int row0 = u.pm * BM + wr * 64 + fr; const int col0 = (u.pn * BM + wc * 32 + 8 * fq) >> 1;
#pragma unroll
        for (int ai = 0; ai < 2; ++ai)
#pragma unroll
            for (int m = 0; m < 4; ++m) { bf16_t* rowp = O + (size_t)(row0 + ai * HALF + m * 16) * ldc + col0;
#pragma unroll
                for (int bj = 0; bj < 2; ++bj) { const f32x4 v0 = acc[ai][bj][m][0], v1 = acc[ai][bj][m][1];
                    const float g0 = v0[0], g1 = v0[2], g2 = v1[0], g3 = v1[2];
                    const float a0 = g0 * __builtin_amdgcn_rcpf(1.f + __expf(-g0)) * v0[1], a1 = g1 * __builtin_amdgcn_rcpf(1.f + __expf(-g1)) * v0[3];
                    const float a2 = g2 * __builtin_amdgcn_rcpf(1.f + __expf(-g2)) * v1[1], a3 = g3 * __builtin_amdgcn_rcpf(1.f + __expf(-g3)) * v1[3];
                    u32x2 w; w.x = cvt_pk_bf16(a0, a1); w.y = cvt_pk_bf16(a2, a3);
                    *(u32x2*)(rowp + bj * (HALF / 2)) = w; } }
    }
};
struct EpiRes {
    static constexpr bool PERM = false, AFTER_DRAIN = false;
    const float* base; float* out; int ldc; const float* scale; int sstride;
    __device__ __forceinline__ void operator()(const f32x4 (&acc)[2][2][4][2], const Unit& u, int wr, int wc, int fr, int fq) const {
        const int col0 = u.pn * BM + wc * 32 + 4 * fq;
#pragma unroll
        for (int ai = 0; ai < 2; ++ai)
#pragma unroll
            for (int m = 0; m < 4; ++m) { const int r = u.pm * BM + ai * HALF + wr * 64 + m * 16 + fr; const size_t off = (size_t)r * ldc + col0;
                const float sc = scale ? scale[(size_t)r * sstride] : 1.f;
#pragma unroll
                for (int bj = 0; bj < 2; ++bj)
#pragma unroll
                    for (int n = 0; n < 2; ++n) { const f32x4 bs = *(const f32x4*)(base + off + bj * HALF + n * 16); *(f32x4*)(out + off + bj * HALF + n * 16) = bs + acc[ai][bj][m][n] * sc; }
                asm volatile("" ::: "memory"); }
    }
};
template <class Epi, class Sched, bool ALIGN_EPI = false, bool SP2 = false>
__device__ __forceinline__ void gemm_phase(PG8_LAS unsigned char* lds, const Gemm g, const Sched& S, const Epi& E) {
    int tid_ = threadIdx.x; asm volatile("" : "+v"(tid_));
    const int tid = tid_, wid = __builtin_amdgcn_readfirstlane(tid >> 6), lane = tid & 63, wr = wid >> 2, wc = wid & 3, fr = lane & 15, fq = lane >> 4;
    const int K = g.K, nt = K / BK;
    unsigned voffA[2], voffB[2];
#pragma unroll
    for (int i = 0; i < 2; ++i) { int R, C; stage_rc(tid * 16 + i * 8192, R, C); const int Rb = Epi::PERM ? ((R & ~31) + perm32(R & 31)) : R;
        voffA[i] = (unsigned)(R * K + C) * 2u; voffB[i] = (unsigned)(Rb * K + C) * 2u; }
    const size_t kstep = (size_t)(BK * 2);
    const size_t hstep = (size_t)HALF * K * 2;
    const size_t tstep = 2 * hstep;
    const unsigned ldsw = (unsigned)wid * 1024u;
    const int aoff = lds_byte(wr * 64 + fr, fq * 8), boff = lds_byte(wc * 32 + fr, fq * 8);
#define PG8_SA(b, h) (((b) * 2 + (h)) * HTB)
#define PG8_SB(b, h) ((4 + (b) * 2 + (h)) * HTB)
#define PG8_STAGE(bufoff, gbase, voff) do { _Pragma("unroll") for (int _i = 0; _i < 2; ++_i) \
        __builtin_amdgcn_global_load_lds((const unsigned*)((const char*)(gbase) + (voff)[_i]), (PG8_LAS unsigned*)(lds + (bufoff) + ldsw + _i * 8192), 16, 0, 0); } while (0)
#define PG8_LDA(dst, b, h) do { _Pragma("unroll") for (int m = 0; m < 4; ++m) _Pragma("unroll") for (int k = 0; k < 2; ++k) dst[m][k] = *(const PG8_LAS bf16x8*)(lds + PG8_SA(b, h) + aoff + m * 2048 + k * 1024); } while (0)
#define PG8_LDB(dst, b, h) do { _Pragma("unroll") for (int n = 0; n < 2; ++n) _Pragma("unroll") for (int k = 0; k < 2; ++k) dst[n][k] = *(const PG8_LAS bf16x8*)(lds + PG8_SB(b, h) + boff + n * 2048 + k * 1024); } while (0)
#define PG8_MMA(ai, bj, At, Bt) do { __builtin_amdgcn_s_setprio(1); _Pragma("unroll") for (int m = 0; m < 4; ++m) _Pragma("unroll") for (int n = 0; n < 2; ++n) _Pragma("unroll") for (int k = 0; k < 2; ++k) \
        acc[ai][bj][m][n] = __builtin_amdgcn_mfma_f32_16x16x32_bf16(Bt[n][k], At[m][k], acc[ai][bj][m][n], 0, 0, 0); __builtin_amdgcn_s_setprio(0); } while (0)
#define PG8_WAIT_V(n) asm volatile("s_waitcnt vmcnt(" #n ")" ::: "memory")
#define PG8_WAIT_L(n) asm volatile("s_waitcnt lgkmcnt(" #n ")" ::: "memory")
#define PG8_BAR __builtin_amdgcn_s_barrier()
#define PG8_SCHED __builtin_amdgcn_sched_barrier(0)
    Unit cur, nxt; int ui = 0;
    if (!S.next(0, cur)) return;
    f32x4 acc[2][2][4][2];
#pragma unroll
    for (int a = 0; a < 2; ++a)
#pragma unroll
        for (int b = 0; b < 2; ++b)
#pragma unroll
            for (int m = 0; m < 4; ++m)
#pragma unroll
                for (int n = 0; n < 2; ++n) acc[a][b][m][n] = (f32x4){0.f, 0.f, 0.f, 0.f};
    bf16x8 At[4][2], B0[2][2], B1[2][2];
    const char* cA = (const char*)g.A + (size_t)cur.pm * tstep; const char* cB = (const char*)g.Bt + (size_t)cur.pn * tstep;
    S.a_ready(cur);
    if constexpr (SP2) {
        PG8_STAGE(PG8_SB(0, 0), cB, voffB); PG8_STAGE(PG8_SB(0, 1), cB + hstep, voffB); PG8_STAGE(PG8_SA(0, 0), cA, voffA); PG8_STAGE(PG8_SA(0, 1), cA + hstep, voffA);
        if (wr == 1) PG8_BAR;
        PG8_WAIT_V(2); PG8_BAR;
        PG8_STAGE(PG8_SB(1, 0), cB + kstep, voffB); PG8_STAGE(PG8_SA(1, 0), cA + kstep, voffA); PG8_STAGE(PG8_SB(1, 1), cB + hstep + kstep, voffB);
        PG8_WAIT_V(6); PG8_BAR;
    } else {
        PG8_STAGE(PG8_SB(0, 0), cB, voffB); PG8_STAGE(PG8_SA(0, 0), cA, voffA); PG8_STAGE(PG8_SB(0, 1), cB + hstep, voffB); PG8_STAGE(PG8_SA(0, 1), cA + hstep, voffA);
        if (wr == 1) PG8_BAR;
        PG8_WAIT_V(4); PG8_BAR;
        PG8_STAGE(PG8_SB(1, 0), cB + kstep, voffB); PG8_STAGE(PG8_SA(1, 0), cA + kstep, voffA); PG8_STAGE(PG8_SB(1, 1), cB + hstep + kstep, voffB);
        PG8_WAIT_V(6); PG8_BAR;
    }
    for (;;) {
        const bool has_next = S.next(ui + 1, nxt);
        const char* nA = has_next ? (const char*)g.A + (size_t)nxt.pm * tstep : cA; const char* nB = has_next ? (const char*)g.Bt + (size_t)nxt.pn * tstep : cB;
        for (int t = 0; t < nt; t += 2) {
            const bool last = (t == nt - 2);
            const char* a1 = cA + (size_t)(t + 1) * kstep;
            const char* a2 = last ? nA : cA + (size_t)(t + 2) * kstep; const char* b2 = last ? nB : cB + (size_t)(t + 2) * kstep;
            const char* a3 = a2 + kstep; const char* b3 = b2 + kstep;
            if (last && has_next) S.a_ready(nxt);
            if constexpr (SP2) {
            PG8_LDB(B0, 0, 0); PG8_LDB(B1, 0, 1); PG8_SCHED; PG8_LDA(At, 0, 0); PG8_STAGE(PG8_SA(1, 1), a1 + hstep, voffA);
            PG8_WAIT_V(8); PG8_WAIT_L(0); PG8_BAR; PG8_MMA(0, 0, At, B0); PG8_MMA(0, 1, At, B1); PG8_BAR; PG8_SCHED;
            PG8_LDA(At, 0, 1); PG8_STAGE(PG8_SB(0, 0), b2, voffB); PG8_STAGE(PG8_SB(0, 1), b2 + hstep, voffB); PG8_STAGE(PG8_SA(0, 0), a2, voffA);
            PG8_WAIT_V(8); PG8_WAIT_L(0); PG8_BAR; PG8_MMA(1, 0, At, B0); PG8_MMA(1, 1, At, B1); PG8_BAR; PG8_SCHED;
            PG8_LDB(B0, 1, 0); PG8_LDB(B1, 1, 1); PG8_SCHED; PG8_LDA(At, 1, 0); PG8_STAGE(PG8_SA(0, 1), a2 + hstep, voffA);
            PG8_WAIT_V(8); PG8_WAIT_L(0); PG8_BAR; PG8_MMA(0, 0, At, B0); PG8_MMA(0, 1, At, B1); PG8_BAR; PG8_SCHED;
            PG8_LDA(At, 1, 1); PG8_STAGE(PG8_SB(1, 0), b3, voffB); PG8_STAGE(PG8_SB(1, 1), b3 + hstep, voffB); PG8_STAGE(PG8_SA(1, 0), a3, voffA);
            PG8_WAIT_V(8); PG8_WAIT_L(0); PG8_BAR; PG8_MMA(1, 0, At, B0); PG8_MMA(1, 1, At, B1); PG8_BAR; PG8_SCHED;
            } else {
            PG8_LDB(B0, 0, 0); PG8_SCHED; PG8_LDA(At, 0, 0); PG8_STAGE(PG8_SA(1, 1), a1 + hstep, voffA);
            PG8_WAIT_L(8); PG8_BAR; PG8_WAIT_L(0); PG8_MMA(0, 0, At, B0); PG8_BAR; PG8_SCHED;
            PG8_LDB(B1, 0, 1); PG8_STAGE(PG8_SB(0, 0), b2, voffB);
            PG8_BAR; PG8_WAIT_L(0); PG8_MMA(0, 1, At, B1); PG8_BAR;
            PG8_LDA(At, 0, 1); PG8_STAGE(PG8_SA(0, 0), a2, voffA);
            PG8_BAR; PG8_WAIT_L(0); PG8_MMA(1, 0, At, B0); PG8_BAR; PG8_SCHED;
            PG8_STAGE(PG8_SB(0, 1), b2 + hstep, voffB);
            PG8_WAIT_V(6); PG8_BAR; PG8_MMA(1, 1, At, B1); PG8_BAR;
            PG8_LDB(B0, 1, 0); PG8_SCHED; PG8_LDA(At, 1, 0); PG8_STAGE(PG8_SA(0, 1), a2 + hstep, voffA);
            PG8_WAIT_L(8); PG8_BAR; PG8_WAIT_L(0); PG8_MMA(0, 0, At, B0); PG8_BAR; PG8_SCHED;
            PG8_LDB(B1, 1, 1); PG8_STAGE(PG8_SB(1, 0), b3, voffB);
            PG8_BAR; PG8_WAIT_L(0); PG8_MMA(0, 1, At, B1); PG8_BAR;
            PG8_LDA(At, 1, 1); PG8_STAGE(PG8_SA(1, 0), a3, voffA);
            PG8_BAR; PG8_WAIT_L(0); PG8_MMA(1, 0, At, B0); PG8_BAR; PG8_SCHED;
            PG8_STAGE(PG8_SB(1, 1), b3 + hstep, voffB);
            PG8_WAIT_V(6); PG8_BAR; PG8_MMA(1, 1, At, B1); PG8_BAR;
            }
        }
        if constexpr (ALIGN_EPI) { if (wr == 0) PG8_BAR; }
        if constexpr (!Epi::AFTER_DRAIN) { E(acc, cur, wr, wc, fr, fq); S.done(cur); }
        if (!has_next) break;
#pragma unroll
        for (int a = 0; a < 2; ++a)
#pragma unroll
            for (int b = 0; b < 2; ++b)
#pragma unroll
                for (int m = 0; m < 4; ++m)
#pragma unroll
                    for (int n = 0; n < 2; ++n) acc[a][b][m][n] = (f32x4){0.f, 0.f, 0.f, 0.f};
        cur = nxt; cA = nA; cB = nB; ++ui;
        if constexpr (ALIGN_EPI) { if (wr == 1) PG8_BAR; }
    }
    PG8_WAIT_V(0);
    if constexpr (!ALIGN_EPI) { if (wr == 0) PG8_BAR; }
    PG8_BAR;
    if constexpr (Epi::AFTER_DRAIN) { E.fused(acc, cur, wr, wc, fr, fq, lds, wid, lane); S.done(cur); }
#undef PG8_SA
#undef PG8_SB
#undef PG8_STAGE
#undef PG8_LDA
#undef PG8_LDB
#undef PG8_MMA
#undef PG8_WAIT_V
#undef PG8_WAIT_L
#undef PG8_BAR
#undef PG8_SCHED
}
}
typedef unsigned short bf16_t;
constexpr int D_MODEL = 1024, BATCH = 8, SEQ = 2048, TOK = BATCH * SEQ;
constexpr int CHUNK = 64, NCHUNK = SEQ / CHUNK;
constexpr int RW = 512, AW = 512, NH = 8;
constexpr int IN_COLS = 3328, SHIFT_COLS = 1792;
constexpr int C_R = 0, C_K = 512, C_V = 1024, C_WD = 1536, C_AD = 1600, C_GD = 1664, C_QA = 1792, C_KA = 2304, C_VA = 2816;
constexpr int D_FF = 2816, NE = 8, D_FFE = 1408;
constexpr float RMS_EPS = 1e-6f, GN_EPS = 64e-5f;
constexpr int NWAVES = 8, NTHREADS = 512;

constexpr size_t MiB = 1u << 20;
constexpr size_t WS_CTL = 0, CTL_ZERO_BYTES = 64 * 1024;
constexpr size_t SZ_WIN = (size_t)IN_COLS * D_MODEL * 2, SZ_WOUT = (size_t)D_MODEL * D_MODEL * 2, SZ_FGU = (size_t)2 * D_FF * D_MODEL * 2, SZ_FDN = (size_t)D_MODEL * D_FF * 2;
constexpr size_t SZ_MGU = (size_t)2 * D_FFE * D_MODEL * 2, SZ_MDN = (size_t)D_MODEL * D_FFE * 2;
constexpr size_t WS_WIN = 1 * MiB, WS_WOUT = WS_WIN + 2 * SZ_WIN, WS_FGU = WS_WOUT + 2 * SZ_WOUT, WS_FDN = WS_FGU + SZ_FGU, WS_LORA = WS_FDN + SZ_FDN, WS_WEND = WS_LORA + 512 * 1024;
constexpr size_t LORA_W2T = 0, LORA_A2T = 2 * 512 * 64 * 2, LORA_G2T = 4 * 512 * 64 * 2;
constexpr size_t WS_XN = 35 * MiB;
constexpr size_t WS_PROJ = 67 * MiB;
constexpr size_t WS_CHUNK = 171 * MiB;
constexpr size_t WS_GP = WS_CHUNK, WS_QP = WS_CHUNK + 16 * MiB, WS_HT = WS_CHUNK + 32 * MiB, WS_ZT = WS_CHUNK + 48 * MiB, WS_GATE = WS_CHUNK + 64 * MiB;
constexpr size_t WS_BONUS = 251 * MiB;
constexpr size_t WS_COMB = 252 * MiB;
constexpr size_t WS_MGU = WS_CHUNK, WS_MDN = WS_MGU + NE * SZ_MGU;
constexpr size_t WS_END = 253 * MiB;
static_assert(WS_MDN + NE * SZ_MDN <= WS_BONUS && WS_GATE + 16 * MiB <= WS_BONUS, "map");
static_assert(WS_WEND <= WS_XN, "weights fit below XN");

#define GAS __attribute__((address_space(1)))
#define LAS __attribute__((address_space(3)))
typedef unsigned short bf16;
typedef unsigned v4u __attribute__((ext_vector_type(4)));
typedef float f32x4 __attribute__((ext_vector_type(4)));
typedef short bf16x8 __attribute__((ext_vector_type(8)));
typedef GAS unsigned gu32;
typedef GAS unsigned long long gu64;
#define RLX_AGENT __ATOMIC_RELAXED, __HIP_MEMORY_SCOPE_AGENT
#define LDS_WAIT() asm volatile("s_waitcnt lgkmcnt(0)" ::: "memory")
#define VM_WAIT() asm volatile("s_waitcnt vmcnt(0)" ::: "memory")
__device__ __forceinline__ unsigned long long rt() { return __builtin_amdgcn_s_memrealtime(); }
__device__ __forceinline__ unsigned f2bf(float f) { unsigned u = __builtin_bit_cast(unsigned, f); return (u + 0x7fffu + ((u >> 16) & 1u)) >> 16; }
__device__ __forceinline__ unsigned pk2(float lo, float hi) { return f2bf(lo) | (f2bf(hi) << 16); }
constexpr int CW_BAR = 1024;
#define XB_TMO      128
#define XB_XCNT(j)  (256  + 64 * (j))
#define XB_XSUB(j)  (1280 + 64 * (j))
#define XB_XGEN(j)  (2304 + 64 * (j))
#define XB_TOP      3328
#define XB_TOPGEN   3392
#define XCD_BAR_WORDS 3456
#define XB_SPIN_CAP (1u << 18)

__device__ __forceinline__ unsigned xb_ld(unsigned* p)              { return __hip_atomic_load(p, __ATOMIC_RELAXED, __HIP_MEMORY_SCOPE_AGENT); }
__device__ __forceinline__ unsigned xb_add(unsigned* p, unsigned v) { return __hip_atomic_fetch_add(p, v, __ATOMIC_RELAXED, __HIP_MEMORY_SCOPE_AGENT); }
__device__ __forceinline__ unsigned xb_xcc_id() { return (unsigned)__builtin_amdgcn_s_getreg((3 << 11) | 20) & 0xFu; }
#define XB_SPIN(cond, bar) do { unsigned _sp = 0; while (cond) { __builtin_amdgcn_s_sleep(1); \
    if ((++_sp & 255u) == 0u) { if (xb_ld(&(bar)[XB_TMO])) break; if (_sp > XB_SPIN_CAP) { atomicAdd(&(bar)[XB_TMO], 1u); break; } } } } while (0)

struct XcdBarrier {
    unsigned* bar; unsigned x;
    volatile LAS unsigned* st;
};

__device__ __forceinline__ XcdBarrier xcd_barrier_post(unsigned* bar, volatile LAS unsigned* st) {
    XcdBarrier b; b.bar = bar; b.x = xb_xcc_id(); b.st = st;
    if (threadIdx.x == 0) (void)xb_add(&bar[XB_XCNT(b.x)], 1u);
    return b;
}
__device__ __forceinline__ void xcd_barrier_complete(unsigned* bar, unsigned x, unsigned& nloc, unsigned& nx) {
    const unsigned G = gridDim.x * gridDim.y * gridDim.z;
    unsigned sum, cnt, mine, sp = 0u;
    for (;;) {
        sum = 0u; cnt = 0u; mine = 0u;
#pragma unroll
        for (unsigned j = 0; j < 16; ++j) { const unsigned c = xb_ld(&bar[XB_XCNT(j)]); sum += c; cnt += (c > 0u) ? 1u : 0u; mine = (j == x) ? c : mine; }
        if (sum == G) break;
        __builtin_amdgcn_s_sleep(1);
        if ((++sp & 255u) == 0u) { if (xb_ld(&bar[XB_TMO])) break; if (sp > XB_SPIN_CAP) { atomicAdd(&bar[XB_TMO], 1u); break; } }
    }
    nloc = mine > 0u ? mine : 1u; nx = cnt > 0u ? cnt : 1u;
}

__device__ __forceinline__ void xcd_barrier(const XcdBarrier& b) {
    asm volatile("s_waitcnt vmcnt(0)" ::: "memory");
    __syncthreads();
    if (threadIdx.x == 0) {
        unsigned* bar = b.bar;
        __builtin_amdgcn_s_waitcnt(0);
        unsigned nloc = b.st[0], nx = b.st[1];
        if (nloc == 0u) { xcd_barrier_complete(bar, b.x, nloc, nx); b.st[0] = nloc; b.st[1] = nx; }
        const unsigned old = xb_add(&bar[XB_XSUB(b.x)], 1u);
        const unsigned gen = old / nloc;
        if (old + 1u == (gen + 1u) * nloc) {
            __builtin_amdgcn_fence(__ATOMIC_RELEASE, "agent");
            asm volatile("s_waitcnt vmcnt(0)" ::: "memory");
            const unsigned og = xb_add(&bar[XB_TOP], 1u);
            const unsigned tg = og / nx;
            if (og + 1u == (tg + 1u) * nx) xb_add(&bar[XB_TOPGEN], 1u);
            else XB_SPIN(xb_ld(&bar[XB_TOPGEN]) == tg, bar);
            __builtin_amdgcn_fence(__ATOMIC_ACQUIRE, "agent");
            xb_add(&bar[XB_XGEN(b.x)], 1u);
            asm volatile("s_waitcnt vmcnt(0)" ::: "memory");
        } else {
            XB_SPIN(xb_ld(&bar[XB_XGEN(b.x)]) == gen, bar);
            __builtin_amdgcn_fence(__ATOMIC_ACQUIRE, "agent");
            asm volatile("s_waitcnt vmcnt(0)" ::: "memory");
        }
    }
    __syncthreads();
}
__device__ __forceinline__ float bf2f(unsigned h) { return __builtin_bit_cast(float, h << 16); }
__device__ __forceinline__ float wave_sum(float v) {
#pragma unroll
    for (int o = 1; o < 64; o <<= 1) v += __shfl_xor(v, o);
    return v;
}
typedef float f32x2_t __attribute__((ext_vector_type(2))); typedef __bf16 bf16x2_t __attribute__((ext_vector_type(2)));
__device__ __forceinline__ unsigned cvtpk(float lo, float hi) { const f32x2_t v = {lo, hi}; const bf16x2_t b = __builtin_convertvector(v, bf16x2_t); return __builtin_bit_cast(unsigned, b); }
__device__ __forceinline__ float sigmoidf_(float x) { return 1.f / (1.f + __expf(-x)); }

__device__ __forceinline__ void p0_transpose_item(const float* W, int K, int N, bf16_t* WT, int row_off, int rmul, LAS float* scr, int item, int lane) {
    const int nblk = N / 32, kb = item / nblk, nb = item % nblk, k0 = 64 * kb, n0 = 32 * nb;
#pragma unroll 8
    for (int i = 0; i < 32; ++i) { const int kk = 2 * i + (lane >> 5); scr[kk * 33 + (lane & 31)] = W[(size_t)(k0 + kk) * N + n0 + (lane & 31)]; }
    LDS_WAIT(); asm volatile("" ::: "memory");
    const int c = lane & 7;
#pragma unroll
    for (int j = 0; j < 4; ++j) { const int n = (lane >> 3) + 8 * j; const LAS float* s = scr + (8 * c) * 33 + n;
        v4u o; o.x = pk2(s[0 * 33], s[1 * 33]); o.y = pk2(s[2 * 33], s[3 * 33]); o.z = pk2(s[4 * 33], s[5 * 33]); o.w = pk2(s[6 * 33], s[7 * 33]);
        *(GAS v4u*)(WT + (size_t)(row_off + (n0 + n) * rmul) * K + k0 + 8 * c) = o; }
    LDS_WAIT(); asm volatile("" ::: "memory");
}

template <int MODE>
__device__ __forceinline__ void norm_rows(int gw, int ngw, int lane, const float* x, const float* __restrict__ g, bf16_t* xn, float* outf, const float* __restrict__ router, float* combine) {
    for (int row = gw; row < TOK; row += ngw) {
        const float4* xr = (const float4*)(x + (size_t)row * D_MODEL);
        float4 v[4]; float s = 0.f;
#pragma unroll
        for (int j = 0; j < 4; ++j) { v[j] = xr[lane + 64 * j];
#ifdef DBG_SANITIZE
            if (MODE == 2) { if (!(fabsf(v[j].x) < 1e30f)) v[j].x = 0.f; if (!(fabsf(v[j].y) < 1e30f)) v[j].y = 0.f; if (!(fabsf(v[j].z) < 1e30f)) v[j].z = 0.f; if (!(fabsf(v[j].w) < 1e30f)) v[j].w = 0.f; }
#endif
            s += v[j].x * v[j].x + v[j].y * v[j].y + v[j].z * v[j].z + v[j].w * v[j].w; }
        s = wave_sum(s);
        const float rstd = rsqrtf(s * (1.f / D_MODEL) + RMS_EPS);
        float lg[8];
#pragma unroll
        for (int e = 0; e < 8; ++e) lg[e] = 0.f;
#pragma unroll
        for (int j = 0; j < 4; ++j) {
            const int c0 = (lane + 64 * j) * 4;
            const float4 gg = *(const float4*)(g + c0);
            const float h0 = v[j].x * rstd * gg.x, h1 = v[j].y * rstd * gg.y, h2 = v[j].z * rstd * gg.z, h3 = v[j].w * rstd * gg.w;
            if (MODE == 2) { *(float4*)(outf + (size_t)row * D_MODEL + c0) = make_float4(h0, h1, h2, h3); }
            else { uint2 o; o.x = pk2(h0, h1); o.y = pk2(h2, h3); *(uint2*)(xn + (size_t)row * D_MODEL + c0) = o; }
            if (MODE == 1) {
                const float hh[4] = {h0, h1, h2, h3};
#pragma unroll
                for (int i = 0; i < 4; ++i) {
                    const float4 r0 = *(const float4*)(router + (size_t)(c0 + i) * 8), r1 = *(const float4*)(router + (size_t)(c0 + i) * 8 + 4);
                    lg[0] += hh[i] * r0.x; lg[1] += hh[i] * r0.y; lg[2] += hh[i] * r0.z; lg[3] += hh[i] * r0.w;
                    lg[4] += hh[i] * r1.x; lg[5] += hh[i] * r1.y; lg[6] += hh[i] * r1.z; lg[7] += hh[i] * r1.w;
                }
            }
        }
        if (MODE == 1) {
#pragma unroll
            for (int e = 0; e < 8; ++e) lg[e] = wave_sum(lg[e]);
            if (lane == 0) {
                int i0 = 0; float v0 = lg[0];
#pragma unroll
                for (int e = 1; e < 8; ++e) if (lg[e] > v0) { v0 = lg[e]; i0 = e; }
                int i1 = -1; float v1 = -3.0e38f;
#pragma unroll
                for (int e = 0; e < 8; ++e) if (e != i0 && lg[e] > v1) { v1 = lg[e]; i1 = e; }
                const float e1 = __expf(v1 - v0), inv = 1.f / (1.f + e1);
                float cb[8];
#pragma unroll
                for (int e = 0; e < 8; ++e) cb[e] = (e == i0) ? inv : ((e == i1) ? e1 * inv : 0.f);
                *(float4*)(combine + (size_t)row * 8) = make_float4(cb[0], cb[1], cb[2], cb[3]);
                *(float4*)(combine + (size_t)row * 8 + 4) = make_float4(cb[4], cb[5], cb[6], cb[7]);
            }
        }
    }
}

typedef float f32x16 __attribute__((ext_vector_type(16)));
typedef short s16x4 __attribute__((ext_vector_type(4)));
constexpr int ATT_WAVE_BYTES = 16384, ATT_TBL = 8 * ATT_WAVE_BYTES, ATT_SCR = ATT_TBL + 8 * 260 * 4, ATT_SSQ = ATT_SCR + 8 * 64 * 4, ATT_LDS = ATT_SSQ + 8 * 64 * 4;
constexpr float LOG2E = 1.4426950408889634f;
__device__ __forceinline__ int crow(int r, int hi) { return (r & 3) + 8 * (r >> 2) + 4 * hi; }
__device__ __forceinline__ s16x4 vtr(const LAS unsigned char* p) { return __builtin_bit_cast(s16x4, __builtin_amdgcn_ds_read_tr16_b64_v4i16((LAS s16x4*)p)); }
__device__ __forceinline__ bf16x8 scale_q(uint4 u) {
    const unsigned w[4] = {u.x, u.y, u.z, u.w}; unsigned o[4];
#pragma unroll
    for (int i = 0; i < 4; ++i) o[i] = pk2(bf2f(w[i] & 0xffffu) * 0.125f, bf2f(w[i] >> 16) * 0.125f);
    return __builtin_bit_cast(bf16x8, make_uint4(o[0], o[1], o[2], o[3]));
}
__device__ __forceinline__ void attn_qblock(f32x16& o0, f32x16& o1, float& l_out, int qb, int b, int n, int h, int lane, LAS unsigned char* vt, LAS float* scr, const LAS float* mytbl, const bf16_t* __restrict__ proj) {
    const int r32 = lane & 31, hi = lane >> 5;
    const size_t row0 = (size_t)b * SEQ + n * CHUNK;
    bf16x8 qr[4];
    {
        const bf16_t* qp = proj + (row0 + qb * 32 + r32) * IN_COLS + C_QA + h * 64 + 8 * hi;
#pragma unroll
        for (int ds = 0; ds < 4; ++ds) qr[ds] = scale_q(*(const uint4*)(qp + 16 * ds));
    }
    float m = -1.0e30f, l = 0.f;
#pragma unroll
    for (int r = 0; r < 16; ++r) { o0[r] = 0.f; o1[r] = 0.f; }
    const int iq = qb * 32 + r32;
    const int c_lo = (n >= 8) ? 0 : (8 - n);
    const int trow = (4 * hi + ((lane & 15) >> 2)) * 128 + ((lane >> 4) & 1) * 32 + (lane & 3) * 8;
#pragma unroll 1
    for (int c = c_lo; c <= 8; ++c) {
        const size_t krow0 = (size_t)b * SEQ + (size_t)(n + c - 8) * CHUNK;
        uint4 vv[8];
        {
            const bf16_t* vp = proj + (krow0 + lane) * IN_COLS + C_VA + h * 64;
#pragma unroll
            for (int i = 0; i < 8; ++i) vv[i] = *(const uint4*)(vp + 8 * i);
        }
        bf16x8 kf[4][2];
        {
            const bf16_t* kp = proj + (krow0 + r32) * IN_COLS + C_KA + h * 64 + 8 * hi;
#pragma unroll
            for (int ds = 0; ds < 4; ++ds) { kf[ds][0] = *(const bf16x8*)(kp + 16 * ds); kf[ds][1] = *(const bf16x8*)(kp + (size_t)32 * IN_COLS + 16 * ds); }
        }
#pragma unroll
        for (int i = 0; i < 8; ++i) *(LAS v4u*)(vt + lane * 128 + i * 16) = (v4u){vv[i].x, vv[i].y, vv[i].z, vv[i].w};
        f32x16 p0, p1;
#pragma unroll
        for (int r = 0; r < 16; ++r) { p0[r] = 0.f; p1[r] = 0.f; }
#pragma unroll
        for (int ds = 0; ds < 4; ++ds) { p0 = __builtin_amdgcn_mfma_f32_32x32x16_bf16(kf[ds][0], qr[ds], p0, 0, 0, 0); p1 = __builtin_amdgcn_mfma_f32_32x32x16_bf16(kf[ds][1], qr[ds], p1, 0, 0, 0); }
        if (c <= 5) {
            const float bc = mytbl[256];
#pragma unroll
            for (int r = 0; r < 16; ++r) { p0[r] = p0[r] * LOG2E + bc; p1[r] = p1[r] * LOG2E + bc; }
        } else {
            const int base = iq + 64 * (8 - c);
#pragma unroll
            for (int r = 0; r < 16; ++r) {
                const int k0 = crow(r, hi); int i0 = base - k0, i1 = base - k0 - 32;
                i0 = (i0 > 128 ? 128 : i0) + 128; i1 = (i1 > 128 ? 128 : i1) + 128;
                p0[r] = p0[r] * LOG2E + mytbl[i0]; p1[r] = p1[r] * LOG2E + mytbl[i1];
            }
        }
        float mt = fmaxf(p0[0], p1[0]);
#pragma unroll
        for (int r = 1; r < 16; ++r) mt = fmaxf(mt, fmaxf(p0[r], p1[r]));
        mt = fmaxf(mt, __shfl_xor(mt, 32));
        const float mn = fmaxf(m, mt), alpha = __builtin_amdgcn_exp2f(m - mn);
        m = mn;
        float rs = 0.f;
#pragma unroll
        for (int r = 0; r < 16; ++r) { p0[r] = __builtin_amdgcn_exp2f(p0[r] - mn); p1[r] = __builtin_amdgcn_exp2f(p1[r] - mn); rs += p0[r] + p1[r]; }
        rs += __shfl_xor(rs, 32);
        l = l * alpha + rs;
        if (hi == 0) scr[r32] = alpha;
#pragma unroll
        for (int r = 0; r < 16; ++r) { const float a = scr[crow(r, hi)]; o0[r] *= a; o1[r] *= a; }
        bf16x8 pa[4];
#pragma unroll
        for (int s = 0; s < 2; ++s) {
            pa[s] = __builtin_bit_cast(bf16x8, make_uint4(cvtpk(p0[8 * s + 0], p0[8 * s + 1]), cvtpk(p0[8 * s + 2], p0[8 * s + 3]), cvtpk(p0[8 * s + 4], p0[8 * s + 5]), cvtpk(p0[8 * s + 6], p0[8 * s + 7])));
            pa[2 + s] = __builtin_bit_cast(bf16x8, make_uint4(cvtpk(p1[8 * s + 0], p1[8 * s + 1]), cvtpk(p1[8 * s + 2], p1[8 * s + 3]), cvtpk(p1[8 * s + 4], p1[8 * s + 5]), cvtpk(p1[8 * s + 6], p1[8 * s + 7])));
        }
#pragma unroll
        for (int ks = 0; ks < 4; ++ks) {
            const LAS unsigned char* vb = vt + ks * 16 * 128 + trow;
            const s16x4 a0 = vtr(vb), a1 = vtr(vb + 8 * 128), b0 = vtr(vb + 64), b1 = vtr(vb + 8 * 128 + 64);
            const bf16x8 v0 = (bf16x8){a0[0], a0[1], a0[2], a0[3], a1[0], a1[1], a1[2], a1[3]}, v1 = (bf16x8){b0[0], b0[1], b0[2], b0[3], b1[0], b1[1], b1[2], b1[3]};
            o0 = __builtin_amdgcn_mfma_f32_32x32x16_bf16(pa[ks], v0, o0, 0, 0, 0);
            o1 = __builtin_amdgcn_mfma_f32_32x32x16_bf16(pa[ks], v1, o1, 0, 0, 0);
        }
    }
    l_out = l;
}
__device__ __forceinline__ void attn_unit(LAS unsigned char* ldsp, int unit, const bf16_t* __restrict__ proj, const float* __restrict__ rel_bias, const float* __restrict__ gnorm, bf16_t* ymix) {
    int tid_ = threadIdx.x; asm volatile("" : "+v"(tid_));
    const int tid = tid_, lane = tid & 63, h = __builtin_amdgcn_readfirstlane(tid >> 6), r32 = lane & 31, hi = lane >> 5;
    const int b = unit >> 5, n = unit & 31;
    LAS float* tbl = (LAS float*)(ldsp + ATT_TBL);
    __syncthreads();
    for (int i = tid; i < 8 * 257; i += NTHREADS) { const int e = i / 257, k = i - e * 257; tbl[e * 260 + k] = rel_bias[k * 8 + e] * LOG2E; }
    __syncthreads();
    LAS unsigned char* vt = ldsp + h * ATT_WAVE_BYTES;
    LAS float* scr = (LAS float*)(ldsp + ATT_SCR) + h * 64;
    LAS float* ssq = (LAS float*)(ldsp + ATT_SSQ);
    f32x16 oA0, oA1, oB0, oB1; float lA, lB;
    attn_qblock(oA0, oA1, lA, 0, b, n, h, lane, vt, scr, tbl + h * 260, proj);
    attn_qblock(oB0, oB1, lB, 1, b, n, h, lane, vt, scr, tbl + h * 260, proj);
    LAS float* ost = (LAS float*)vt;
    if (hi == 0) { scr[r32] = 1.f / lA; scr[32 + r32] = 1.f / lB; }
#pragma unroll
    for (int r = 0; r < 16; ++r) {
        const int qa = crow(r, hi), qbq = 32 + qa; const float ia = scr[qa], ib = scr[qbq];
        ost[qa * 64 + (r32 ^ qa)] = oA0[r] * ia; ost[qa * 64 + ((32 + r32) ^ qa)] = oA1[r] * ia;
        ost[qbq * 64 + (r32 ^ qbq)] = oB0[r] * ib; ost[qbq * 64 + ((32 + r32) ^ qbq)] = oB1[r] * ib;
    }
    float v[64]; float s = 0.f;
#pragma unroll
    for (int d = 0; d < 64; ++d) { v[d] = ost[lane * 64 + (d ^ lane)]; s += v[d] * v[d]; }
    ssq[h * 64 + lane] = s;
    __syncthreads();
    float tot = 0.f;
#pragma unroll
    for (int e = 0; e < 8; ++e) tot += ssq[e * 64 + lane];
    const float rstd = rsqrtf(tot * (1.f / AW) + RMS_EPS);
    const float* gp = gnorm + h * 64;
    bf16_t* op = ymix + ((size_t)b * SEQ + n * CHUNK + lane) * D_MODEL + RW + h * 64;
#pragma unroll
    for (int d = 0; d < 64; d += 8) {
        const float4 g0 = *(const float4*)(gp + d), g1 = *(const float4*)(gp + d + 4);
        uint4 o; o.x = pk2(v[d] * rstd * g0.x, v[d + 1] * rstd * g0.y); o.y = pk2(v[d + 2] * rstd * g0.z, v[d + 3] * rstd * g0.w);
        o.z = pk2(v[d + 4] * rstd * g1.x, v[d + 5] * rstd * g1.y); o.w = pk2(v[d + 6] * rstd * g1.z, v[d + 7] * rstd * g1.w);
        *(uint4*)(op + d) = o;
    }
}
constexpr int R1_RS = 72, R1_RSB = R1_RS * 2;
constexpr int R1_MAT = 64 * R1_RSB;
constexpr int R1_SGRSB = 136 * 2;
constexpr int R1_X = 0;
constexpr int R1_TW = R1_X, R1_AD = R1_X + R1_MAT, R1_SG = R1_X + 2 * R1_MAT;
constexpr int R1_MAB = R1_X, R1_MAK = R1_X + R1_MAT, R1_NRB = R1_X + 2 * R1_MAT, R1_NRK = R1_X + 3 * R1_MAT;
constexpr int R1_Y = R1_X + 4 * R1_MAT;
constexpr int R1_FRS = 68;
constexpr int R1_WL = R1_Y, R1_AL = R1_Y + 64 * R1_FRS * 4;
constexpr int R1_Z = R1_Y + 2 * 64 * R1_FRS * 4;
constexpr int R1_AH = R1_Z, R1_BH = R1_Z + R1_MAT, R1_KH = R1_Z + 2 * R1_MAT, R1_RH = R1_Z + 3 * R1_MAT, R1_BTT = R1_Z + 4 * R1_MAT, R1_KTT = R1_Z + 5 * R1_MAT, R1_VT = R1_Z + 6 * R1_MAT;
constexpr int R1_TII = R1_Z + 7 * R1_MAT;
constexpr int R1_TIIRSB = 48;
constexpr int R1_MD = R1_TII + 4 * 16 * R1_TIIRSB;
constexpr int R1_TOT = R1_MD + 4 * 16 * 17 * 4;
constexpr int R1_GC = R1_TOT + 8 * 64 * 4;
constexpr int R1_LDS = R1_GC + 256;
struct RwkvW { const float *mu, *w0, *a0, *k_k, *k_a, *r_k; const bf16_t *w2T, *a2T, *g2T; };
struct RwkvChunkOut { bf16_t *Gp, *Qp, *HT, *ZT, *gate; float* bonus; unsigned* dbg; };
typedef unsigned u2v __attribute__((ext_vector_type(2)));
__device__ __forceinline__ bf16x8 mk8(u2v a, u2v b) { return __builtin_bit_cast(bf16x8, (v4u){a.x, a.y, b.x, b.y}); }
__device__ __forceinline__ bf16x8 packx(const f32x4& a, const f32x4& b) { return __builtin_bit_cast(bf16x8, (v4u){cvtpk(a[0], a[1]), cvtpk(a[2], a[3]), cvtpk(b[0], b[1]), cvtpk(b[2], b[3])}); }
#define MFMA16(a, b, c) __builtin_amdgcn_mfma_f32_16x16x32_bf16((a), (b), (c), 0, 0, 0)
__device__ __forceinline__ void rwkv_chunk_unit(LAS unsigned char* lds, int unit, const bf16_t* __restrict__ proj, const RwkvW& W0, const RwkvChunkOut& O) {
    int tid_ = threadIdx.x; asm volatile("" : "+v"(tid_));
    const int tid = tid_, lane = tid & 63, w = __builtin_amdgcn_readfirstlane(tid >> 6), li = lane & 15, g = lane >> 4;
    const int c = unit & 31, h = (unit >> 5) & 7, b = unit >> 8;
    const int tk = tid >> 3, sub = tid & 7;
    RwkvW W = W0;
    asm volatile("" : "+s"(W.mu), "+s"(W.w0), "+s"(W.a0), "+s"(W.k_k), "+s"(W.k_a), "+s"(W.r_k), "+s"(W.w2T), "+s"(W.a2T), "+s"(W.g2T));
    const size_t row = (size_t)b * SEQ + c * CHUNK + tk;
    const f32x4 z4 = {0.f, 0.f, 0.f, 0.f};
#define LDF(base, rsb, row0, k0) (*(const LAS bf16x8*)(lds + (base) + ((row0) + li) * (rsb) + ((k0) + 8 * g) * 2))
#define LDP(base, row0, pair) mk8(*(const LAS u2v*)(lds + (base) + ((row0) + li) * R1_RSB + (32 * (pair) + 4 * g) * 2), *(const LAS u2v*)(lds + (base) + ((row0) + li) * R1_RSB + (32 * (pair) + 16 + 4 * g) * 2))
    __syncthreads();
    float rr[8], kv[8], vv[8];
    {
        const bf16_t* pr = proj + row * IN_COLS; const bool has_prev = (c * CHUNK + tk) > 0; const bf16_t* pp = pr - IN_COLS;
        auto ld8 = [&](int col, float (&o)[8]) {
            const uint4 cu = *(const uint4*)(pr + col); uint4 pu = make_uint4(0, 0, 0, 0); if (has_prev) pu = *(const uint4*)(pp + col);
            const float4 m0 = *(const float4*)(W.mu + col), m1 = *(const float4*)(W.mu + col + 4);
            const unsigned cw[4] = {cu.x, cu.y, cu.z, cu.w}, pw[4] = {pu.x, pu.y, pu.z, pu.w}; const float mm[8] = {m0.x, m0.y, m0.z, m0.w, m1.x, m1.y, m1.z, m1.w};
#pragma unroll
            for (int i = 0; i < 4; ++i) { const float c0 = bf2f(cw[i] & 0xffffu), c1 = bf2f(cw[i] >> 16), p0 = bf2f(pw[i] & 0xffffu), p1 = bf2f(pw[i] >> 16);
                o[2 * i] = c0 + mm[2 * i] * (p0 - c0); o[2 * i + 1] = c1 + mm[2 * i + 1] * (p1 - c1); }
        };
        float t8[8];
        ld8(C_WD + sub * 8, t8);
        *(LAS v4u*)(lds + R1_TW + tk * R1_RSB + sub * 16) = (v4u){pk2(tanhf(t8[0]), tanhf(t8[1])), pk2(tanhf(t8[2]), tanhf(t8[3])), pk2(tanhf(t8[4]), tanhf(t8[5])), pk2(tanhf(t8[6]), tanhf(t8[7]))};
        ld8(C_AD + sub * 8, t8);
        *(LAS v4u*)(lds + R1_AD + tk * R1_RSB + sub * 16) = (v4u){pk2(t8[0], t8[1]), pk2(t8[2], t8[3]), pk2(t8[4], t8[5]), pk2(t8[6], t8[7])};
#pragma unroll
        for (int q = 0; q < 2; ++q) {
            ld8(C_GD + sub * 16 + q * 8, t8);
            *(LAS v4u*)(lds + R1_SG + tk * R1_SGRSB + sub * 32 + q * 16) = (v4u){pk2(sigmoidf_(t8[0]), sigmoidf_(t8[1])), pk2(sigmoidf_(t8[2]), sigmoidf_(t8[3])), pk2(sigmoidf_(t8[4]), sigmoidf_(t8[5])), pk2(sigmoidf_(t8[6]), sigmoidf_(t8[7]))};
        }
        ld8(C_R + h * 64 + sub * 8, rr); ld8(C_K + h * 64 + sub * 8, kv); ld8(C_V + h * 64 + sub * 8, vv);
#if defined(DBG_RWKV) && DBG_RWKV == 14
        {
            float n0 = 0.f, n1 = 0.f;
            for (int q = 0; q < 2; ++q) { ld8(C_GD + sub * 16 + q * 8, t8); for (int i = 0; i < 8; ++i) { if (!(fabsf(t8[i]) < 1e30f)) n0 += 1.f; else if (!(fabsf(sigmoidf_(t8[i])) < 1e30f)) n1 += 1.f; } }
            n0 = wave_sum(n0); n1 = wave_sum(n1);
            if (lane == 0 && h == 0) { atomicAdd((float*)(O.dbg + 528), n0); atomicAdd((float*)(O.dbg + 529), n1); }
        }
#endif
    }
    __syncthreads();
#if defined(DBG_RWKV) && DBG_RWKV == 14
    {
        float n2 = 0.f;
        for (int q = 0; q < 2; ++q) { const v4u u = *(const LAS v4u*)(lds + R1_SG + tk * R1_SGRSB + sub * 32 + q * 16); const unsigned w_[4] = {u.x, u.y, u.z, u.w};
            for (int i = 0; i < 4; ++i) { if ((w_[i] & 0x7f80u) == 0x7f80u) n2 += 1.f; if ((w_[i] & 0x7f800000u) == 0x7f800000u) n2 += 1.f; } }
        n2 = wave_sum(n2);
        if (lane == 0 && h == 0) atomicAdd((float*)(O.dbg + 530), n2);
    }
#endif
    {
        const int mb = w >> 1, nb0 = 2 * (w & 1);
        const bf16_t* w2r = W.w2T + (size_t)(h * 64 + 16 * mb + li) * 64 + 8 * g; const bf16_t* a2r = W.a2T + (size_t)(h * 64 + 16 * mb + li) * 64 + 8 * g;
        const bf16_t* g2r = W.g2T + (size_t)(h * 64 + 16 * mb + li) * 128 + 8 * g;
        bf16x8 wa[2], aa[2], ga[4];
#pragma unroll
        for (int ks = 0; ks < 2; ++ks) { wa[ks] = *(const bf16x8*)(w2r + 32 * ks); aa[ks] = *(const bf16x8*)(a2r + 32 * ks); }
#pragma unroll
        for (int ks = 0; ks < 4; ++ks) ga[ks] = *(const bf16x8*)(g2r + 32 * ks);
#pragma unroll
        for (int q = 0; q < 2; ++q) {
            const int nb = nb0 + q;
            f32x4 aw = z4, a_ = z4, ag = z4;
#pragma unroll
            for (int ks = 0; ks < 2; ++ks) { aw = MFMA16(wa[ks], LDF(R1_TW, R1_RSB, 16 * nb, 32 * ks), aw); a_ = MFMA16(aa[ks], LDF(R1_AD, R1_RSB, 16 * nb, 32 * ks), a_); }
#pragma unroll
            for (int ks = 0; ks < 4; ++ks) ag = MFMA16(ga[ks], LDF(R1_SG, R1_SGRSB, 16 * nb, 32 * ks), ag);
            const int t = 16 * nb + li, ch = 16 * mb + 4 * g;
            *(LAS f32x4*)(lds + R1_WL + (t * R1_FRS + ch) * 4) = aw;
            *(LAS f32x4*)(lds + R1_AL + (t * R1_FRS + ch) * 4) = a_;
            *(uint2*)(O.gate + ((size_t)b * SEQ + c * CHUNK + t) * RW + h * 64 + ch) = make_uint2(cvtpk(ag[0], ag[1]), cvtpk(ag[2], ag[3]));
#if defined(DBG_RWKV) && (DBG_RWKV == 12 || DBG_RWKV == 13)
            {
                const bf16x8 ones = __builtin_bit_cast(bf16x8, (v4u){0x3f803f80u, 0x3f803f80u, 0x3f803f80u, 0x3f803f80u});
                f32x4 t1 = z4, t2 = z4;
                for (int ks = 0; ks < 4; ++ks) { t1 = MFMA16(ones, LDF(R1_SG, R1_SGRSB, 16 * nb, 32 * ks), t1); t2 = MFMA16(ga[ks], ones, t2); }
                const size_t eo = ((size_t)b * SEQ + c * CHUNK + t) * RW + h * 64 + ch;
                *(uint2*)(O.Gp + eo) = make_uint2(cvtpk(t1[0], t1[1]), cvtpk(t1[2], t1[3]));
                *(uint2*)(O.Qp + eo) = make_uint2(cvtpk(t2[0], t2[1]), cvtpk(t2[2], t2[3]));
                *(uint2*)(O.HT + eo) = make_uint2(cvtpk(aw[0], aw[1]), cvtpk(aw[2], aw[3]));
            }
#endif
        }
    }
    __syncthreads();
    float ld_[8], av[8], kk[8], kp[8], Lc[8];
    {
        const int c0 = h * 64 + sub * 8;
        const f32x4 wl0 = *(const LAS f32x4*)(lds + R1_WL + (tk * R1_FRS + sub * 8) * 4), wl1 = *(const LAS f32x4*)(lds + R1_WL + (tk * R1_FRS + sub * 8 + 4) * 4);
        const f32x4 al0 = *(const LAS f32x4*)(lds + R1_AL + (tk * R1_FRS + sub * 8) * 4), al1 = *(const LAS f32x4*)(lds + R1_AL + (tk * R1_FRS + sub * 8 + 4) * 4);
        const float wl[8] = {wl0[0], wl0[1], wl0[2], wl0[3], wl1[0], wl1[1], wl1[2], wl1[3]}, al[8] = {al0[0], al0[1], al0[2], al0[3], al1[0], al1[1], al1[2], al1[3]};
        float ss = 0.f, bon = 0.f;
#pragma unroll
        for (int i = 0; i < 8; ++i) {
            const float xx = -(wl[i] + W.w0[c0 + i]); const float sp = (xx > 20.f) ? xx : __logf(1.f + __expf(xx));
            ld_[i] = -__expf(-sp - 0.5f);
            av[i] = sigmoidf_(al[i] + W.a0[c0 + i]);
            kk[i] = kv[i] * W.k_k[c0 + i]; ss += kk[i] * kk[i];
            kp[i] = kv[i] * (1.f + (av[i] - 1.f) * W.k_a[c0 + i]);
            bon += rr[i] * kp[i] * W.r_k[c0 + i];
        }
        ss += __shfl_xor(ss, 1); ss += __shfl_xor(ss, 2); ss += __shfl_xor(ss, 4);
        bon += __shfl_xor(bon, 1); bon += __shfl_xor(bon, 2); bon += __shfl_xor(bon, 4);
        const float inv = 1.f / fmaxf(sqrtf(ss), 1e-12f);
#pragma unroll
        for (int i = 0; i < 8; ++i) kk[i] *= inv;
        if (sub == 0) O.bonus[row * NH + h] = bon;
        const int tl = lane >> 3;
#pragma unroll
        for (int i = 0; i < 8; ++i) {
            float x = ld_[i];
            float y = __shfl_up(x, 8); if (tl >= 1) x += y;
            y = __shfl_up(x, 16); if (tl >= 2) x += y;
            y = __shfl_up(x, 32); if (tl >= 4) x += y;
            Lc[i] = x;
        }
        if (tl == 7) { *(LAS f32x4*)(lds + R1_TOT + (w * 64 + sub * 8) * 4) = (f32x4){Lc[0], Lc[1], Lc[2], Lc[3]}; *(LAS f32x4*)(lds + R1_TOT + (w * 64 + sub * 8 + 4) * 4) = (f32x4){Lc[4], Lc[5], Lc[6], Lc[7]}; }
    }
    __syncthreads();
    {
        float off[8], tot[8];
#pragma unroll
        for (int i = 0; i < 8; ++i) { off[i] = 0.f; tot[i] = 0.f; }
#pragma unroll
        for (int ww = 0; ww < 8; ++ww) {
            const f32x4 t0 = *(const LAS f32x4*)(lds + R1_TOT + (ww * 64 + sub * 8) * 4), t1 = *(const LAS f32x4*)(lds + R1_TOT + (ww * 64 + sub * 8 + 4) * 4);
            const float tt[8] = {t0[0], t0[1], t0[2], t0[3], t1[0], t1[1], t1[2], t1[3]};
#pragma unroll
            for (int i = 0; i < 8; ++i) { tot[i] += tt[i]; if (ww < w) off[i] += tt[i]; }
        }
        float ah[8], bh[8], kh[8], rh[8], bt[8], kt[8];
#pragma unroll
        for (int i = 0; i < 8; ++i) {
            const float L = Lc[i] + off[i];
            const float eL = __expf(L), eLx = __expf(L - ld_[i]), enL = __expf(-L), eCL = __expf(tot[i] - L);
            const float bb = kk[i] * av[i];
            ah[i] = -kk[i] * eLx; bh[i] = bb * enL; kh[i] = kp[i] * enL; rh[i] = rr[i] * eL; bt[i] = bb * eCL; kt[i] = kp[i] * eCL;
        }
        *(LAS v4u*)(lds + R1_AH + tk * R1_RSB + sub * 16) = (v4u){pk2(ah[0], ah[1]), pk2(ah[2], ah[3]), pk2(ah[4], ah[5]), pk2(ah[6], ah[7])};
        *(LAS v4u*)(lds + R1_BH + tk * R1_RSB + sub * 16) = (v4u){pk2(bh[0], bh[1]), pk2(bh[2], bh[3]), pk2(bh[4], bh[5]), pk2(bh[6], bh[7])};
        *(LAS v4u*)(lds + R1_KH + tk * R1_RSB + sub * 16) = (v4u){pk2(kh[0], kh[1]), pk2(kh[2], kh[3]), pk2(kh[4], kh[5]), pk2(kh[6], kh[7])};
        *(LAS v4u*)(lds + R1_RH + tk * R1_RSB + sub * 16) = (v4u){pk2(rh[0], rh[1]), pk2(rh[2], rh[3]), pk2(rh[4], rh[5]), pk2(rh[6], rh[7])};
#pragma unroll
        for (int i = 0; i < 8; ++i) {
            const int chn = sub * 8 + i;
            *(LAS unsigned short*)(lds + R1_BTT + chn * R1_RSB + tk * 2) = (unsigned short)f2bf(bt[i]);
            *(LAS unsigned short*)(lds + R1_KTT + chn * R1_RSB + tk * 2) = (unsigned short)f2bf(kt[i]);
            *(LAS unsigned short*)(lds + R1_VT + chn * R1_RSB + tk * 2) = (unsigned short)f2bf(vv[i]);
        }
        if (tk == 63) {
#pragma unroll
            for (int i = 0; i < 8; ++i) *(LAS float*)(lds + R1_GC + (sub * 8 + i) * 4) = __expf(tot[i]);
        }
    }
    __syncthreads();
    {
        const int mb = w >> 1, nb0 = 2 * (w & 1);
        const bf16x8 fa0 = LDF(R1_AH, R1_RSB, 16 * mb, 0), fa1 = LDF(R1_AH, R1_RSB, 16 * mb, 32), fr0 = LDF(R1_RH, R1_RSB, 16 * mb, 0), fr1 = LDF(R1_RH, R1_RSB, 16 * mb, 32);
#pragma unroll
        for (int q = 0; q < 2; ++q) {
            const int nb = nb0 + q;
            f32x4 mab = z4, mak = z4, nrb = z4, nrk = z4;
            if (nb <= mb) {
                const bf16x8 fb0 = LDF(R1_BH, R1_RSB, 16 * nb, 0), fb1 = LDF(R1_BH, R1_RSB, 16 * nb, 32), fk0 = LDF(R1_KH, R1_RSB, 16 * nb, 0), fk1 = LDF(R1_KH, R1_RSB, 16 * nb, 32);
                mab = MFMA16(fa0, fb0, mab); mab = MFMA16(fa1, fb1, mab); mak = MFMA16(fa0, fk0, mak); mak = MFMA16(fa1, fk1, mak);
                nrb = MFMA16(fr0, fb0, nrb); nrb = MFMA16(fr1, fb1, nrb); nrk = MFMA16(fr0, fk0, nrk); nrk = MFMA16(fr1, fk1, nrk);
            }
            const int s = 16 * nb + li;
#pragma unroll
            for (int r = 0; r < 4; ++r) {
                const int t = 16 * mb + 4 * g + r; const bool lo = s < t, le = s <= t;
                const float m1 = lo ? mab[r] : 0.f, m2 = lo ? mak[r] : 0.f, n1 = le ? nrb[r] : 0.f, n2 = le ? nrk[r] : 0.f;
                *(LAS unsigned short*)(lds + R1_MAB + t * R1_RSB + s * 2) = (unsigned short)f2bf(m1);
                *(LAS unsigned short*)(lds + R1_MAK + t * R1_RSB + s * 2) = (unsigned short)f2bf(m2);
                *(LAS unsigned short*)(lds + R1_NRB + t * R1_RSB + s * 2) = (unsigned short)f2bf(n1);
                *(LAS unsigned short*)(lds + R1_NRK + t * R1_RSB + s * 2) = (unsigned short)f2bf(n2);
                if (nb == mb) *(LAS float*)(lds + R1_MD + ((mb * 16 + 4 * g + r) * 17 + li) * 4) = m1;
            }
        }
    }
    __syncthreads();
    f32x4 acc[4];
    if (w == 0) {
        float T[16];
        const LAS float* md = (const LAS float*)(lds + R1_MD) + g * 16 * 17;
#pragma unroll
        for (int r = 0; r < 16; ++r) {
            float a = (r == li) ? 1.f : 0.f;
#pragma unroll
            for (int s = 0; s < r; ++s) a += md[r * 17 + s] * T[s];
            T[r] = a;
            *(LAS unsigned short*)(lds + R1_TII + (g * 16 + r) * R1_TIIRSB + li * 2) = (unsigned short)f2bf(a);
        }
    }
    if (w >= 4) {
        const int vb = w - 4;
#pragma unroll
        for (int mb = 0; mb < 4; ++mb) { acc[mb] = z4;
#pragma unroll
            for (int ks = 0; ks < 2; ++ks) acc[mb] = MFMA16(LDF(R1_MAK, R1_RSB, 16 * mb, 32 * ks), LDF(R1_VT, R1_RSB, 16 * vb, 32 * ks), acc[mb]); }
    } else {
#pragma unroll
        for (int mb = 0; mb < 4; ++mb)
#pragma unroll
            for (int r = 0; r < 4; ++r) acc[mb][r] = bf2f(*(const LAS unsigned short*)(lds + R1_AH + (16 * mb + 4 * g + r) * R1_RSB + (16 * w + li) * 2));
    }
    __syncthreads();
    f32x4 X0, X1, X2, X3;
    {
#define LDT(i) mk8(*(const LAS u2v*)(lds + R1_TII + ((i) * 16 + li) * R1_TIIRSB + 8 * g), (u2v){0u, 0u})
#define LDM1(i, j) mk8(*(const LAS u2v*)(lds + R1_MAB + (16 * (i) + li) * R1_RSB + (16 * (j) + 4 * g) * 2), (u2v){0u, 0u})
        X0 = MFMA16(LDT(0), packx(acc[0], z4), z4);
        f32x4 a1 = MFMA16(LDM1(1, 0), packx(X0, z4), acc[1]);
        X1 = MFMA16(LDT(1), packx(a1, z4), z4);
        f32x4 a2 = MFMA16(LDP(R1_MAB, 32, 0), packx(X0, X1), acc[2]);
        X2 = MFMA16(LDT(2), packx(a2, z4), z4);
        f32x4 a3 = MFMA16(LDP(R1_MAB, 48, 0), packx(X0, X1), acc[3]);
        a3 = MFMA16(LDM1(3, 2), packx(X2, z4), a3);
        X3 = MFMA16(LDT(3), packx(a3, z4), z4);
    }
    const bf16x8 x01 = packx(X0, X1), x23 = packx(X2, X3);
#if defined(DBG_RWKV) && (DBG_RWKV == 12 || DBG_RWKV == 13)
    return;
#endif
    const size_t ub = (size_t)unit * 4096;
    if (w < 4) {
        const int kb = w, pos = 32 * (kb >> 1) + 8 * g + 4 * (kb & 1);
#pragma unroll
        for (int nb = 0; nb < 4; ++nb) {
            f32x4 ag = z4;
            if (nb == kb) {
#pragma unroll
                for (int r = 0; r < 4; ++r) if (li == 4 * g + r) ag[r] = *(const LAS float*)(lds + R1_GC + (16 * kb + 4 * g + r) * 4);
            }
            ag = MFMA16(x01, LDP(R1_BTT, 16 * nb, 0), ag); ag = MFMA16(x23, LDP(R1_BTT, 16 * nb, 1), ag);
            *(uint2*)(O.Gp + ub + (size_t)(16 * nb + li) * 64 + pos) = make_uint2(cvtpk(ag[0], ag[1]), cvtpk(ag[2], ag[3]));
            const u2v rq = *(const LAS u2v*)(lds + R1_RH + (16 * nb + li) * R1_RSB + (16 * kb + 4 * g) * 2);
            f32x4 aq = {bf2f(rq.x & 0xffffu), bf2f(rq.x >> 16), bf2f(rq.y & 0xffffu), bf2f(rq.y >> 16)};
            aq = MFMA16(x01, LDP(R1_NRB, 16 * nb, 0), aq); aq = MFMA16(x23, LDP(R1_NRB, 16 * nb, 1), aq);
            *(uint2*)(O.Qp + ub + (size_t)(16 * nb + li) * 64 + pos) = make_uint2(cvtpk(aq[0], aq[1]), cvtpk(aq[2], aq[3]));
        }
    } else {
        const int vb = w - 4;
        const bf16x8 fv0 = LDF(R1_VT, R1_RSB, 16 * vb, 0), fv1 = LDF(R1_VT, R1_RSB, 16 * vb, 32);
#pragma unroll
        for (int mb = 0; mb < 4; ++mb) {
            f32x4 az = z4;
            az = MFMA16(LDP(R1_NRB, 16 * mb, 0), x01, az); az = MFMA16(LDP(R1_NRB, 16 * mb, 1), x23, az);
            az = MFMA16(LDF(R1_NRK, R1_RSB, 16 * mb, 0), fv0, az); az = MFMA16(LDF(R1_NRK, R1_RSB, 16 * mb, 32), fv1, az);
            *(uint2*)(O.ZT + ub + (size_t)(16 * vb + li) * 64 + 16 * mb + 4 * g) = make_uint2(cvtpk(az[0], az[1]), cvtpk(az[2], az[3]));
            f32x4 ah_ = z4;
            ah_ = MFMA16(LDP(R1_BTT, 16 * mb, 0), x01, ah_); ah_ = MFMA16(LDP(R1_BTT, 16 * mb, 1), x23, ah_);
            ah_ = MFMA16(LDF(R1_KTT, R1_RSB, 16 * mb, 0), fv0, ah_); ah_ = MFMA16(LDF(R1_KTT, R1_RSB, 16 * mb, 32), fv1, ah_);
            *(uint2*)(O.HT + ub + (size_t)(16 * vb + li) * 64 + 16 * mb + 4 * g) = make_uint2(cvtpk(ah_[0], ah_[1]), cvtpk(ah_[2], ah_[3]));
        }
    }
#undef LDT
#undef LDM1
#undef LDF
#undef LDP
}
constexpr int R2_YRS = 65;
constexpr int R2_LDS = 2 * 64 * R2_YRS * 4;
struct RwkvScanIn { const bf16_t *Gp, *Qp, *HT, *ZT, *gate; const float* bonus; const float *mu, *ln_w, *ln_b; };
struct ChunkFrags { bf16x8 G[4][2], Q[4][2]; uint2 H[4], Z[4]; };
__device__ __forceinline__ void r2_load(ChunkFrags& F, const RwkvScanIn& I, size_t ub, int vb, int li, int g) {
#pragma unroll
    for (int mb = 0; mb < 4; ++mb) {
#pragma unroll
        for (int p = 0; p < 2; ++p) { F.G[mb][p] = *(const bf16x8*)(I.Gp + ub + (size_t)(16 * mb + li) * 64 + 32 * p + 8 * g); F.Q[mb][p] = *(const bf16x8*)(I.Qp + ub + (size_t)(16 * mb + li) * 64 + 32 * p + 8 * g); }
        F.H[mb] = *(const uint2*)(I.HT + ub + (size_t)(16 * vb + li) * 64 + 16 * mb + 4 * g);
        F.Z[mb] = *(const uint2*)(I.ZT + ub + (size_t)(16 * vb + li) * 64 + 16 * mb + 4 * g);
    }
}
__device__ __forceinline__ f32x4 bf4(uint2 u) { return (f32x4){bf2f(u.x & 0xffffu), bf2f(u.x >> 16), bf2f(u.y & 0xffffu), bf2f(u.y >> 16)}; }
__device__ __forceinline__ void r2_step(const ChunkFrags& F, f32x4 (&S)[4], bf16x8& s01, bf16x8& s23, LAS float* ybuf, int vb, int li, int g) {
    f32x4 Sn[4];
#pragma unroll
    for (int mb = 0; mb < 4; ++mb) {
        f32x4 y = bf4(F.Z[mb]);
        y = MFMA16(F.Q[mb][0], s01, y); y = MFMA16(F.Q[mb][1], s23, y);
#pragma unroll
        for (int r = 0; r < 4; ++r) ybuf[(16 * mb + 4 * g + r) * R2_YRS + 16 * vb + li] = y[r];
        f32x4 s = bf4(F.H[mb]);
        s = MFMA16(F.G[mb][0], s01, s); s = MFMA16(F.G[mb][1], s23, s);
        Sn[mb] = s;
    }
#pragma unroll
    for (int mb = 0; mb < 4; ++mb) S[mb] = Sn[mb];
    s01 = packx(S[0], S[1]); s23 = packx(S[2], S[3]);
}
__device__ __forceinline__ void r2_epilogue(const LAS float* ybuf, int et, size_t row, int h, bool has_prev, const bf16_t* __restrict__ proj, const RwkvScanIn& I, bf16_t* ymix) {
    const int t = et >> 2, q4 = et & 3, c0 = h * 64 + q4 * 16;
    const bf16_t* pr = proj + row * IN_COLS + C_V + c0;
    uint4 cu[2], pu[2], gu[2];
#pragma unroll
    for (int i = 0; i < 2; ++i) { cu[i] = *(const uint4*)(pr + 8 * i); pu[i] = make_uint4(0, 0, 0, 0); if (has_prev) pu[i] = *(const uint4*)(pr - IN_COLS + 8 * i); gu[i] = *(const uint4*)(I.gate + row * RW + c0 + 8 * i); }
    const float bon = I.bonus[row * NH + h];
    float y[16]; float s1 = 0.f;
#pragma unroll
    for (int i = 0; i < 16; ++i) { y[i] = ybuf[t * R2_YRS + q4 * 16 + i]; s1 += y[i]; }
    s1 += __shfl_xor(s1, 1); s1 += __shfl_xor(s1, 2);
    const float mean = s1 * (1.f / 64.f); float s2 = 0.f;
#pragma unroll
    for (int i = 0; i < 16; ++i) { const float d = y[i] - mean; s2 += d * d; }
    s2 += __shfl_xor(s2, 1); s2 += __shfl_xor(s2, 2);
    const float rstd = rsqrtf(s2 * (1.f / 64.f) + GN_EPS);
    unsigned ow[8];
#pragma unroll
    for (int i = 0; i < 2; ++i) {
        const unsigned cw[4] = {cu[i].x, cu[i].y, cu[i].z, cu[i].w}, pw[4] = {pu[i].x, pu[i].y, pu[i].z, pu[i].w}, gw_[4] = {gu[i].x, gu[i].y, gu[i].z, gu[i].w};
#pragma unroll
        for (int j = 0; j < 4; ++j) {
            float o2[2];
#pragma unroll
            for (int u = 0; u < 2; ++u) {
                const int ci = c0 + 8 * i + 2 * j + u, yi = 8 * i + 2 * j + u;
                const float cur = bf2f(u ? (cw[j] >> 16) : (cw[j] & 0xffffu)), prev = bf2f(u ? (pw[j] >> 16) : (pw[j] & 0xffffu)), gt = bf2f(u ? (gw_[j] >> 16) : (gw_[j] & 0xffffu));
                const float vsh = cur + I.mu[C_V + ci] * (prev - cur);
                o2[u] = ((y[yi] - mean) * rstd * I.ln_w[ci] + I.ln_b[ci] + bon * vsh) * gt;
            }
            ow[4 * i + j] = pk2(o2[0], o2[1]);
        }
    }
    *(uint4*)(ymix + row * D_MODEL + c0) = make_uint4(ow[0], ow[1], ow[2], ow[3]);
    *(uint4*)(ymix + row * D_MODEL + c0 + 8) = make_uint4(ow[4], ow[5], ow[6], ow[7]);
}
__device__ __forceinline__ void rwkv_scan_unit(LAS unsigned char* lds, int unit  , const bf16_t* __restrict__ proj, const RwkvScanIn& I0, bf16_t* ymix) {
    int tid_ = threadIdx.x; asm volatile("" : "+v"(tid_));
    const int tid = tid_, lane = tid & 63, w = __builtin_amdgcn_readfirstlane(tid >> 6), li = lane & 15, g = lane >> 4;
    const int b = unit >> 3, h = unit & 7;
    RwkvScanIn I = I0;
    asm volatile("" : "+s"(I.Gp), "+s"(I.Qp), "+s"(I.HT), "+s"(I.ZT), "+s"(I.gate), "+s"(I.bonus), "+s"(I.mu), "+s"(I.ln_w), "+s"(I.ln_b));
    LAS float* ybase = (LAS float*)lds;
    __syncthreads();
    if (w < 4) {
        const int vb = w;
        f32x4 S[4];
#pragma unroll
        for (int mb = 0; mb < 4; ++mb) S[mb] = (f32x4){0.f, 0.f, 0.f, 0.f};
        bf16x8 s01 = packx(S[0], S[1]), s23 = s01;
        const size_t ub0 = (size_t)unit * NCHUNK * 4096;
        ChunkFrags FA, FB;
        r2_load(FA, I, ub0, vb, li, g);
#pragma unroll 1
        for (int c = 0; c < NCHUNK; c += 2) {
            r2_load(FB, I, ub0 + (size_t)(c + 1) * 4096, vb, li, g);
            r2_step(FA, S, s01, s23, ybase, vb, li, g);
            __syncthreads();
            if (c + 2 < NCHUNK) r2_load(FA, I, ub0 + (size_t)(c + 2) * 4096, vb, li, g);
            r2_step(FB, S, s01, s23, ybase + 64 * R2_YRS, vb, li, g);
            __syncthreads();
        }
    } else {
        const int et = tid - 256;
#pragma unroll 1
        for (int c = 0; c < NCHUNK; ++c) {
            __syncthreads();
            const int tl = c * CHUNK + (et >> 2);
            r2_epilogue(ybase + (c & 1) * 64 * R2_YRS, et, (size_t)b * SEQ + tl, h, tl > 0, proj, I, ymix);
        }
    }
}
#ifdef DBG_RWKV
struct RwkvParams { const float *mu, *w0, *w2, *a0, *a2, *g2, *k_k, *k_a, *r_k, *ln_w, *ln_b; };
constexpr int RWKV_LDS = (7 * 4096 + 8192 + 64) * 4;
__device__ __forceinline__ void rwkv_naive_unit(float* sm, int unit, const bf16_t* __restrict__ proj, const RwkvParams& P0, bf16_t* ymix) {
    float* sR = sm; float* sDEC = sm + 4096; float* sKP = sm + 2 * 4096; float* sV = sm + 3 * 4096; float* sKK = sm + 4 * 4096; float* sKKA = sm + 5 * 4096; float* sG = sm + 6 * 4096;
    float* sST = sm + 7 * 4096;
    float* sBON = sST + 8192;
    int tid_ = threadIdx.x; asm volatile("" : "+v"(tid_));
    const int tid = tid_, b = unit >> 3, h = unit & 7;
    const int tk = tid >> 3, sub = tid & 7;
    float S[8];
#pragma unroll
    for (int i = 0; i < 8; ++i) S[i] = 0.f;
#pragma unroll 1
    for (int cb = 0; cb < NCHUNK; ++cb) {
        const int t0 = cb * CHUNK;
        RwkvParams P = P0;
        asm volatile("" : "+s"(P.mu), "+s"(P.w0), "+s"(P.w2), "+s"(P.a0), "+s"(P.a2), "+s"(P.g2));
        asm volatile("" : "+s"(P.k_k), "+s"(P.k_a), "+s"(P.r_k), "+s"(P.ln_w), "+s"(P.ln_b));
        const size_t row = (size_t)b * SEQ + t0 + tk;
        const bf16_t* pr = proj + row * IN_COLS;
        const bool has_prev = (t0 + tk) > 0;
        const bf16_t* pp = pr - IN_COLS;
        auto shifted = [&](int col) -> float { const float cur = bf2f(pr[col]); const float prev = has_prev ? bf2f(pp[col]) : 0.f; return cur + P.mu[col] * (prev - cur); };
#pragma unroll
        for (int i = 0; i < 8; ++i) { const int j = sub * 8 + i; sST[tk * 128 + j] = tanhf(shifted(C_WD + j)); }
        __syncthreads();
        float av[8];
        {
            float acc[8];
#pragma unroll
            for (int i = 0; i < 8; ++i) acc[i] = P.w0[h * 64 + sub * 8 + i];
#pragma unroll 2
            for (int j = 0; j < 64; ++j) { const float t = sST[tk * 128 + j]; const float* wr = P.w2 + (size_t)j * RW + h * 64 + sub * 8;
#pragma unroll
                for (int i = 0; i < 8; ++i) acc[i] += t * wr[i]; }
#pragma unroll
            for (int i = 0; i < 8; ++i) { const float xx = -acc[i]; const float sp = (xx > 20.f) ? xx : log1pf(__expf(xx)); const float w = -sp - 0.5f; sDEC[tk * 64 + sub * 8 + i] = __expf(-__expf(w)); }
        }
        __syncthreads();
#pragma unroll
        for (int i = 0; i < 8; ++i) { const int j = sub * 8 + i; sST[tk * 128 + j] = shifted(C_AD + j); }
        __syncthreads();
        {
            float acc[8];
#pragma unroll
            for (int i = 0; i < 8; ++i) acc[i] = P.a0[h * 64 + sub * 8 + i];
#pragma unroll 2
            for (int j = 0; j < 64; ++j) { const float t = sST[tk * 128 + j]; const float* wr = P.a2 + (size_t)j * RW + h * 64 + sub * 8;
#pragma unroll
                for (int i = 0; i < 8; ++i) acc[i] += t * wr[i]; }
#pragma unroll
            for (int i = 0; i < 8; ++i) av[i] = sigmoidf_(acc[i]);
        }
        __syncthreads();
#pragma unroll
        for (int i = 0; i < 16; ++i) { const int j = sub * 16 + i; sST[tk * 128 + j] = sigmoidf_(shifted(C_GD + j)); }
        __syncthreads();
        {
            float acc[8];
#pragma unroll
            for (int i = 0; i < 8; ++i) acc[i] = 0.f;
#pragma unroll 2
            for (int j = 0; j < 128; ++j) { const float t = sST[tk * 128 + j]; const float* wr = P.g2 + (size_t)j * RW + h * 64 + sub * 8;
#pragma unroll
                for (int i = 0; i < 8; ++i) acc[i] += t * wr[i]; }
#pragma unroll
            for (int i = 0; i < 8; ++i) sG[tk * 64 + sub * 8 + i] = acc[i];
        }
        {
            float rr[8], kv[8], vv[8], kk[8], kp[8]; float ss = 0.f, bon = 0.f;
#pragma unroll
            for (int i = 0; i < 8; ++i) {
                const int c = h * 64 + sub * 8 + i;
                rr[i] = shifted(C_R + c); kv[i] = shifted(C_K + c); vv[i] = shifted(C_V + c);
                kk[i] = kv[i] * P.k_k[c]; ss += kk[i] * kk[i];
                kp[i] = kv[i] * (1.f + (av[i] - 1.f) * P.k_a[c]);
                bon += rr[i] * kp[i] * P.r_k[c];
            }
            ss += __shfl_xor(ss, 1); ss += __shfl_xor(ss, 2); ss += __shfl_xor(ss, 4);
            bon += __shfl_xor(bon, 1); bon += __shfl_xor(bon, 2); bon += __shfl_xor(bon, 4);
            const float inv = 1.f / fmaxf(sqrtf(ss), 1e-12f);
#pragma unroll
            for (int i = 0; i < 8; ++i) {
                const int o = tk * 64 + sub * 8 + i; const float kn = kk[i] * inv;
                sR[o] = rr[i]; sKP[o] = kp[i]; sV[o] = vv[i]; sKK[o] = kn; sKKA[o] = kn * av[i];
            }
            if (sub == 0) sBON[tk] = bon;
        }
        __syncthreads();
#pragma unroll 1
        for (int t = 0; t < CHUNK; ++t) {
            const float* dk = sDEC + t * 64 + sub * 8; const float* kkp = sKK + t * 64 + sub * 8; const float* kap = sKKA + t * 64 + sub * 8;
            const float* kpp = sKP + t * 64 + sub * 8; const float* rp = sR + t * 64 + sub * 8;
            float sa = 0.f;
#pragma unroll
            for (int i = 0; i < 8; ++i) sa -= S[i] * kkp[i];
            sa += __shfl_xor(sa, 1); sa += __shfl_xor(sa, 2); sa += __shfl_xor(sa, 4);
            const float vt = sV[t * 64 + tk];
            float y = 0.f;
#pragma unroll
            for (int i = 0; i < 8; ++i) { S[i] = S[i] * dk[i] + sa * kap[i] + vt * kpp[i]; y += S[i] * rp[i]; }
            y += __shfl_xor(y, 1); y += __shfl_xor(y, 2); y += __shfl_xor(y, 4);
            if (sub == 0) sST[t * 64 + tk] = y;
        }
        __syncthreads();
        {
            float yv[8]; float s1 = 0.f;
#pragma unroll
            for (int i = 0; i < 8; ++i) { yv[i] = sST[tk * 64 + sub * 8 + i]; s1 += yv[i]; }
            s1 += __shfl_xor(s1, 1); s1 += __shfl_xor(s1, 2); s1 += __shfl_xor(s1, 4);
            const float mean = s1 * (1.f / 64.f); float s2 = 0.f;
#pragma unroll
            for (int i = 0; i < 8; ++i) { const float d = yv[i] - mean; s2 += d * d; }
            s2 += __shfl_xor(s2, 1); s2 += __shfl_xor(s2, 2); s2 += __shfl_xor(s2, 4);
            const float rstd = rsqrtf(s2 * (1.f / 64.f) + GN_EPS); const float bon = sBON[tk];
            unsigned pk[4];
#pragma unroll
            for (int i = 0; i < 8; i += 2) {
                float o[2];
#pragma unroll
                for (int u = 0; u < 2; ++u) { const int c = h * 64 + sub * 8 + i + u; const int o_ = tk * 64 + sub * 8 + i + u;
                    o[u] = ((yv[i + u] - mean) * rstd * P.ln_w[c] + P.ln_b[c] + bon * sV[o_]) * sG[o_]; }
                pk[i >> 1] = pk2(o[0], o[1]);
            }
            *(uint4*)(ymix + row * D_MODEL + h * 64 + sub * 8) = make_uint4(pk[0], pk[1], pk[2], pk[3]);
        }
        __syncthreads();
    }
}

#endif
constexpr int LDS_PHASE_BYTES = 150 * 1024;
constexpr int LDSCTL_OFF = LDS_PHASE_BYTES;
constexpr int LDS_BYTES = LDS_PHASE_BYTES + 1024;
#ifdef DBG_RWKV
static_assert(RWKV_LDS <= LDS_PHASE_BYTES, "dbg");
#endif
static_assert(R1_LDS <= LDS_PHASE_BYTES && R2_LDS <= LDS_PHASE_BYTES && pg8::STAGE_BYTES <= LDS_PHASE_BYTES && ATT_LDS <= LDS_PHASE_BYTES, "LDS map");

struct Args {
    const float* in[26]; float* out; unsigned char* ws;
};
static_assert(sizeof(Args) == 28 * 8, "Args has no padding");

__global__ void __launch_bounds__(NTHREADS, 2) mega_fwd(Args args) {
    extern __shared__ __attribute__((aligned(16))) unsigned char lds[];
    LAS unsigned char* ldsp = (LAS unsigned char*)lds;
    const int G = gridDim.x, bid = blockIdx.x;
#define IDS() int tid = threadIdx.x; asm volatile("" : "+v"(tid)); const int lane = tid & 63, wave = __builtin_amdgcn_readfirstlane(tid >> 6), gw = bid * NWAVES + wave, ngw = G * NWAVES; (void)lane; (void)gw; (void)ngw
    typedef const __attribute__((address_space(4))) Args* KArgs;
#define KA() ({ KArgs _p = (KArgs)__builtin_amdgcn_kernarg_segment_ptr(); asm volatile("" : "+s"(_p)); _p; })
#define IN(i) (KA()->in[i])
#define WSP(off) (KA()->ws + (off))
#define OUTP() (KA()->out)
    { IDS(); for (int u = tid; u < (LDS_BYTES - LDSCTL_OFF) / 4; u += NTHREADS) ((LAS unsigned*)(ldsp + LDSCTL_OFF))[u] = 0u; }
    __syncthreads();
    XcdBarrier bar = xcd_barrier_post((unsigned*)((gu32*)WSP(WS_CTL) + CW_BAR), (volatile LAS unsigned*)(ldsp + LDSCTL_OFF));
#define GRID_BAR() xcd_barrier(bar)
    enum { I_X = 0, I_NMG, I_WIN, I_MU, I_W0, I_W2, I_A0, I_A2, I_G2, I_KK, I_KA, I_RK, I_LNW, I_LNB, I_RELB, I_ANG, I_WOUT, I_NFG, I_FWG, I_FWU, I_FWD, I_ROUTER, I_MWG, I_MWU, I_MWD, I_NFINAL };

    {
        IDS();
        LAS float* scr = (LAS float*)(ldsp + wave * 16384);
        constexpr int I_IN = (D_MODEL / 64) * (IN_COLS / 32), I_OUT = (D_MODEL / 64) * (D_MODEL / 32), I_FG = (D_MODEL / 64) * (D_FF / 32), I_FD = (D_FF / 64) * (D_MODEL / 32);
        constexpr int I_MG = (D_MODEL / 64) * (D_FFE / 32), I_MD = (D_FFE / 64) * (D_MODEL / 32);
        constexpr int NITEMS = 2 * I_IN + 2 * I_OUT + 2 * I_FG + I_FD;
#pragma unroll 1
        for (int it = gw; it < NITEMS; it += ngw) {
            int r = it;
            if (r < 2 * I_IN) { const int l = r / I_IN; p0_transpose_item(IN(I_WIN) + (size_t)l * D_MODEL * IN_COLS, D_MODEL, IN_COLS, (bf16_t*)WSP(WS_WIN) + (size_t)l * IN_COLS * D_MODEL, 0, 1, scr, r % I_IN, lane); continue; } r -= 2 * I_IN;
            if (r < 2 * I_OUT) { const int l = r / I_OUT; p0_transpose_item(IN(I_WOUT) + (size_t)l * D_MODEL * D_MODEL, D_MODEL, D_MODEL, (bf16_t*)WSP(WS_WOUT) + (size_t)l * D_MODEL * D_MODEL, 0, 1, scr, r % I_OUT, lane); continue; } r -= 2 * I_OUT;
            if (r < I_FG) { p0_transpose_item(IN(I_FWG), D_MODEL, D_FF, (bf16_t*)WSP(WS_FGU), 0, 2, scr, r, lane); continue; } r -= I_FG;
            if (r < I_FG) { p0_transpose_item(IN(I_FWU), D_MODEL, D_FF, (bf16_t*)WSP(WS_FGU), 1, 2, scr, r, lane); continue; } r -= I_FG;
            p0_transpose_item(IN(I_FWD), D_FF, D_MODEL, (bf16_t*)WSP(WS_FDN), 0, 1, scr, r, lane);
        }
        {
            const int gt = bid * NTHREADS + tid, ngt = G * NTHREADS;
            const float* w2 = IN(I_W2); const float* a2 = IN(I_A2); const float* g2 = IN(I_G2);
            bf16_t* w2T = (bf16_t*)WSP(WS_LORA + LORA_W2T); bf16_t* a2T = (bf16_t*)WSP(WS_LORA + LORA_A2T); bf16_t* g2T = (bf16_t*)WSP(WS_LORA + LORA_G2T);
            for (int i = gt; i < 2 * 512 * 64; i += ngt) { const int l = i >> 15, r = i & 32767, ch = r >> 6, j = r & 63; w2T[i] = (bf16_t)f2bf(w2[l * 32768 + j * 512 + ch]); a2T[i] = (bf16_t)f2bf(a2[l * 32768 + j * 512 + ch]); }
            for (int i = gt; i < 2 * 512 * 128; i += ngt) { const int l = i >> 16, r = i & 65535, ch = r >> 7, j = r & 127; g2T[i] = (bf16_t)f2bf(g2[l * 65536 + j * 512 + ch]); }
        }
        { IDS(); norm_rows<0>(gw, ngw, lane, IN(I_X), IN(I_NMG), (bf16_t*)WSP(WS_XN), nullptr, nullptr, nullptr); }
    }
    cg::this_grid().sync();

#pragma unroll 1
    for (int l = 0; l < 2; ++l) {
        {
            pg8::Gemm g{(bf16_t*)WSP(WS_XN), (bf16_t*)WSP(WS_WIN) + (size_t)l * IN_COLS * D_MODEL, TOK, IN_COLS, D_MODEL}; pg8::StaticOrder S; S.init(TOK, IN_COLS, G, bid);
            pg8::EpiBf16 E{(bf16_t*)WSP(WS_PROJ), IN_COLS};
            pg8::gemm_phase<pg8::EpiBf16, pg8::StaticOrder, true, true>(ldsp, g, S, E);
        }
        GRID_BAR();
        {
            RwkvW Wt{IN(I_MU) + l * SHIFT_COLS, IN(I_W0) + l * RW, IN(I_A0) + l * RW, IN(I_KK) + l * RW, IN(I_KA) + l * RW, IN(I_RK) + l * RW,
                     (const bf16_t*)WSP(WS_LORA + LORA_W2T) + (size_t)l * 512 * 64, (const bf16_t*)WSP(WS_LORA + LORA_A2T) + (size_t)l * 512 * 64, (const bf16_t*)WSP(WS_LORA + LORA_G2T) + (size_t)l * 512 * 128};
            RwkvChunkOut Oc{(bf16_t*)WSP(WS_GP), (bf16_t*)WSP(WS_QP), (bf16_t*)WSP(WS_HT), (bf16_t*)WSP(WS_ZT), (bf16_t*)WSP(WS_GATE), (float*)WSP(WS_BONUS), (unsigned*)WSP(WS_CTL)};
#pragma unroll 1
            for (int u = bid; u < BATCH * NH * NCHUNK; u += G) rwkv_chunk_unit(ldsp, u, (const bf16_t*)WSP(WS_PROJ), Wt, Oc);
        }
        GRID_BAR();
#if defined(DBG_RWKV) && DBG_RWKV >= 10 && DBG_RWKV != 14
        if (l == 0) {
            IDS();
            gu32* cw = (gu32*)WSP(WS_CTL);
#if DBG_RWKV == 10 || DBG_RWKV == 12 || DBG_RWKV == 13
            const bf16_t* arr[3] = {(const bf16_t*)WSP(WS_GP), (const bf16_t*)WSP(WS_QP), (const bf16_t*)WSP(WS_HT)};
#else
            const bf16_t* arr[3] = {(const bf16_t*)WSP(WS_ZT), (const bf16_t*)WSP(WS_GATE), (const bf16_t*)WSP(WS_GATE)};
#endif
            for (int k = 0; k < 3; ++k) {
                float n_ = 0.f;
#if DBG_RWKV == 13
                const int k2 = k; const int kk_ = 0;
#define k kk_
#endif
                for (size_t i = (size_t)(bid * NTHREADS + tid) * 8; i < (size_t)2048 * 4096; i += (size_t)G * NTHREADS * 8) {
                    const uint4 u = *(const uint4*)(arr[k] + i); const unsigned w_[4] = {u.x, u.y, u.z, u.w};
#if DBG_RWKV == 13
                    { const int tokrow = (int)(i / 512), tseq = tokrow & (SEQ - 1); const int cat = (tseq == 0) ? 0 : ((tseq & 63) == 0 ? 1 : 2);
                      for (int q = 0; q < 4; ++q) { if (k == 0 && cat == (int)k2) { if ((w_[q] & 0x7f80u) == 0x7f80u) n_ += 1.f; if ((w_[q] & 0x7f800000u) == 0x7f800000u) n_ += 1.f; } } }
#else
                    for (int q = 0; q < 4; ++q) { if ((w_[q] & 0x7f80u) == 0x7f80u) n_ += 1.f; if ((w_[q] & 0x7f800000u) == 0x7f800000u) n_ += 1.f; }
#endif
                }
#if DBG_RWKV == 11
                if (k == 2) { n_ = 0.f; const float* bo = (const float*)WSP(WS_BONUS); for (int i = bid * NTHREADS + tid; i < TOK * NH; i += G * NTHREADS) if (!(fabsf(bo[i]) < 1e30f)) n_ += 1.f; }
#endif
#if DBG_RWKV == 13
#undef k
#endif
                n_ = wave_sum(n_);
                if (lane == 0) atomicAdd((float*)(cw + 528 + k), n_);
            }
        }
#endif
        {
#pragma unroll 1
            for (int i = bid; i < BATCH * NCHUNK; i += G) {
                int au;
                if (i < BATCH * NH) {
                    RwkvScanIn Si{(const bf16_t*)WSP(WS_GP), (const bf16_t*)WSP(WS_QP), (const bf16_t*)WSP(WS_HT), (const bf16_t*)WSP(WS_ZT), (const bf16_t*)WSP(WS_GATE), (const float*)WSP(WS_BONUS),
                                  IN(I_MU) + l * SHIFT_COLS, IN(I_LNW) + l * RW, IN(I_LNB) + l * RW};
#ifdef DBG_RWKV
                    if (l == 0) {
                        RwkvParams Pn{IN(I_MU) + l * SHIFT_COLS, IN(I_W0) + l * RW, IN(I_W2) + (size_t)l * 64 * RW, IN(I_A0) + l * RW, IN(I_A2) + (size_t)l * 64 * RW, IN(I_G2) + (size_t)l * 128 * RW,
                                      IN(I_KK) + l * RW, IN(I_KA) + l * RW, IN(I_RK) + l * RW, IN(I_LNW) + l * RW, IN(I_LNB) + l * RW};
                        rwkv_scan_unit(ldsp, i, (const bf16_t*)WSP(WS_PROJ), Si, (bf16_t*)OUTP());
                        rwkv_naive_unit((float*)lds, i, (const bf16_t*)WSP(WS_PROJ), Pn, (bf16_t*)WSP(WS_XN));
                    } else {
                        RwkvParams Pn{IN(I_MU) + l * SHIFT_COLS, IN(I_W0) + l * RW, IN(I_W2) + (size_t)l * 64 * RW, IN(I_A0) + l * RW, IN(I_A2) + (size_t)l * 64 * RW, IN(I_G2) + (size_t)l * 128 * RW,
                                      IN(I_KK) + l * RW, IN(I_KA) + l * RW, IN(I_RK) + l * RW, IN(I_LNW) + l * RW, IN(I_LNB) + l * RW};
                        rwkv_naive_unit((float*)lds, i, (const bf16_t*)WSP(WS_PROJ), Pn, (bf16_t*)WSP(WS_XN));
                    }
#else
                    rwkv_scan_unit(ldsp, i, (const bf16_t*)WSP(WS_PROJ), Si, (bf16_t*)WSP(WS_XN));
#endif
                    au = (i >> 3) * NCHUNK + (i & 7);
                } else { const int j = i - BATCH * NH; au = (j / 24) * NCHUNK + 8 + (j % 24); }
                attn_unit(ldsp, au, (const bf16_t*)WSP(WS_PROJ), IN(I_RELB) + (size_t)l * 257 * 8, IN(I_ANG) + l * AW, (bf16_t*)WSP(WS_XN));
            }
        }
        GRID_BAR();
#ifdef DBG_RWKV
        if (l == 0) {
            IDS();
            const bf16_t* ya = (const bf16_t*)WSP(WS_XN); const bf16_t* yb = (const bf16_t*)OUTP();
            float se[3] = {0.f, 0.f, 0.f}, sy[3] = {0.f, 0.f, 0.f}, nf[3] = {0.f, 0.f, 0.f};
            for (int row = gw; row < TOK; row += ngw) {
                const int t = row & (SEQ - 1); const int rg = t < 64 ? 0 : (t < 128 ? 1 : 2);
                const uint4 ua = *(const uint4*)(ya + (size_t)row * D_MODEL + lane * 8), ub_ = *(const uint4*)(yb + (size_t)row * D_MODEL + lane * 8);
                const unsigned wa_[4] = {ua.x, ua.y, ua.z, ua.w}, wb_[4] = {ub_.x, ub_.y, ub_.z, ub_.w};
                float e = 0.f, y2 = 0.f, n_ = 0.f;
                for (int q = 0; q < 4; ++q) for (int u = 0; u < 2; ++u) {
                    const float a_ = bf2f(u ? wa_[q] >> 16 : wa_[q] & 0xffffu), b_ = bf2f(u ? wb_[q] >> 16 : wb_[q] & 0xffffu);
                    if (!(fabsf(b_) < 1e30f)) n_ += 1.f; else e += (a_ - b_) * (a_ - b_);
                    y2 += a_ * a_;
                }
                for (int k = 0; k < 3; ++k) if (k == rg) { se[k] += e; sy[k] += y2; nf[k] += n_; }
            }
            gu32* cw = (gu32*)WSP(WS_CTL);
            for (int k = 0; k < 3; ++k) { const float a_ = wave_sum(se[k]), b_ = wave_sum(sy[k]), c_ = wave_sum(nf[k]);
                if (lane == 0) { atomicAdd((float*)(cw + 512 + k), a_); atomicAdd((float*)(cw + 520 + k), b_); if (DBG_RWKV < 10) atomicAdd((float*)(cw + 528 + k), c_); } }
            GRID_BAR();
        }
#endif
        {
            pg8::Gemm g{(bf16_t*)WSP(WS_XN), (bf16_t*)WSP(WS_WOUT) + (size_t)l * D_MODEL * D_MODEL, TOK, D_MODEL, D_MODEL}; pg8::StaticOrder S; S.init(TOK, D_MODEL, G, bid);
            pg8::EpiRes E{(l == 0) ? IN(I_X) : (const float*)OUTP(), OUTP(), D_MODEL, nullptr, 0};
            pg8::gemm_phase<pg8::EpiRes, pg8::StaticOrder, true, true>(ldsp, g, S, E);
        }
        GRID_BAR();
        if (l == 0) {
            { IDS(); norm_rows<0>(gw, ngw, lane, OUTP(), IN(I_NFG), (bf16_t*)WSP(WS_XN), nullptr, nullptr, nullptr); }
            GRID_BAR();
            {
                pg8::Gemm g{(bf16_t*)WSP(WS_XN), (bf16_t*)WSP(WS_FGU), TOK, 2 * D_FF, D_MODEL}; pg8::StaticOrder S; S.init(TOK, 2 * D_FF, G, bid);
                pg8::EpiSwiglu E{(bf16_t*)WSP(WS_PROJ), D_FF};
                pg8::gemm_phase<pg8::EpiSwiglu, pg8::StaticOrder, true, true>(ldsp, g, S, E);
            }
            GRID_BAR();
            {
                pg8::Gemm g{(bf16_t*)WSP(WS_PROJ), (bf16_t*)WSP(WS_FDN), TOK, D_MODEL, D_FF}; pg8::StaticOrder S; S.init(TOK, D_MODEL, G, bid);
                pg8::EpiRes E{OUTP(), OUTP(), D_MODEL, nullptr, 0};
                pg8::gemm_phase<pg8::EpiRes, pg8::StaticOrder, true, true>(ldsp, g, S, E);
            }
            GRID_BAR();
            { IDS(); norm_rows<0>(gw, ngw, lane, OUTP(), IN(I_NMG) + D_MODEL, (bf16_t*)WSP(WS_XN), nullptr, nullptr, nullptr); }
            GRID_BAR();
        } else {
            { IDS(); norm_rows<1>(gw, ngw, lane, OUTP(), IN(I_NFG) + D_MODEL, (bf16_t*)WSP(WS_XN), nullptr, IN(I_ROUTER), (float*)WSP(WS_COMB)); }
            {
                IDS();
                LAS float* scr = (LAS float*)(ldsp + wave * 16384);
                constexpr int I_MG = (D_MODEL / 64) * (D_FFE / 32), I_MD = (D_FFE / 64) * (D_MODEL / 32);
#pragma unroll 1
                for (int it = gw; it < NE * (2 * I_MG + I_MD); it += ngw) {
                    const int e = it / (2 * I_MG + I_MD); int r = it - e * (2 * I_MG + I_MD);
                    if (r < I_MG) { p0_transpose_item(IN(I_MWG) + (size_t)e * D_MODEL * D_FFE, D_MODEL, D_FFE, (bf16_t*)WSP(WS_MGU) + (size_t)e * 2 * D_FFE * D_MODEL, 0, 2, scr, r, lane); continue; } r -= I_MG;
                    if (r < I_MG) { p0_transpose_item(IN(I_MWU) + (size_t)e * D_MODEL * D_FFE, D_MODEL, D_FFE, (bf16_t*)WSP(WS_MGU) + (size_t)e * 2 * D_FFE * D_MODEL, 1, 2, scr, r, lane); continue; } r -= I_MG;
                    p0_transpose_item(IN(I_MWD) + (size_t)e * D_FFE * D_MODEL, D_FFE, D_MODEL, (bf16_t*)WSP(WS_MDN) + (size_t)e * D_MODEL * D_FFE, 0, 1, scr, r, lane);
                }
            }
            GRID_BAR();
#pragma unroll 1
            for (int e = 0; e < NE; ++e) {
                {
                    pg8::Gemm g{(bf16_t*)WSP(WS_XN), (bf16_t*)WSP(WS_MGU) + (size_t)e * 2 * D_FFE * D_MODEL, TOK, 2 * D_FFE, D_MODEL}; pg8::StaticOrder S; S.init(TOK, 2 * D_FFE, G, bid);
                    pg8::EpiSwiglu E{(bf16_t*)WSP(WS_PROJ), D_FFE};
                    pg8::gemm_phase<pg8::EpiSwiglu, pg8::StaticOrder, true, true>(ldsp, g, S, E);
                }
                GRID_BAR();
                {
                    pg8::Gemm g{(bf16_t*)WSP(WS_PROJ), (bf16_t*)WSP(WS_MDN) + (size_t)e * D_MODEL * D_FFE, TOK, D_MODEL, D_FFE}; pg8::StaticOrder S; S.init(TOK, D_MODEL, G, bid);
                    pg8::EpiRes E{OUTP(), OUTP(), D_MODEL, (const float*)WSP(WS_COMB) + e, NE};
                    pg8::gemm_phase<pg8::EpiRes, pg8::StaticOrder, true, true>(ldsp, g, S, E);
                }
                GRID_BAR();
            }
        }
    }
    { IDS(); norm_rows<2>(gw, ngw, lane, OUTP(), IN(I_NFINAL), nullptr, OUTP(), nullptr, nullptr); }
#ifdef DBG_RWKV
    {
        IDS();
        const float* cw = (const float*)WSP(WS_CTL);
        const float wts[3] = {0.1f, 0.3f, 0.9f}; float diag = 0.f;
        for (int k = 0; k < 3; ++k) { const float se = __hip_atomic_load(cw + 512 + k, RLX_AGENT), sy = __hip_atomic_load(cw + 520 + k, RLX_AGENT), nf = __hip_atomic_load(cw + 528 + k, RLX_AGENT);
#if DBG_RWKV == 1
            if (nf > 0.f || se > 0.01f * sy) diag += wts[k];
#elif DBG_RWKV == 12
            if (k == 0) diag = sqrtf(nf / (2048.f * 4096.f));
#elif DBG_RWKV == 13 || DBG_RWKV == 14
            if (nf > 0.f) diag += wts[k];
#elif DBG_RWKV >= 10
            if (nf > 0.f) diag += wts[k];
#else
            if (k == DBG_RWKV - 2) diag = (nf > 0.f) ? 7.f : fminf(sqrtf(se / sy), 5.f);
#endif
        }
        __syncthreads();
        float* o = OUTP();
        for (int row = gw; row < TOK; row += ngw) for (int j = 0; j < 4; ++j) { float4 v = *(float4*)(o + (size_t)row * D_MODEL + (lane + 64 * j) * 4); const float sc = 1.f + diag; v.x *= sc; v.y *= sc; v.z *= sc; v.w *= sc; *(float4*)(o + (size_t)row * D_MODEL + (lane + 64 * j) * 4) = v; }
    }
#endif
}

extern "C" void kernel_launch(void* const* d_in, const int* in_sizes, int n_in, void* d_out, int out_size, void* d_ws, size_t ws_size, hipStream_t stream) {
    static int grid = 0;
    if (grid == 0) {
        if (n_in != 26 || in_sizes[0] != TOK * D_MODEL || out_size != TOK * D_MODEL || ws_size < WS_END) {
            fprintf(stderr, "kernel_launch: unexpected problem: n_in %d in0 %d out %d ws %zu (need %zu); nothing launched\n", n_in, n_in > 0 ? in_sizes[0] : -1, out_size, ws_size, (size_t)WS_END); grid = -1; return; }
        int dev = 0, cus = 0, per_cu = 0;
        if (hipGetDevice(&dev) != hipSuccess || hipDeviceGetAttribute(&cus, hipDeviceAttributeMultiprocessorCount, dev) != hipSuccess) { fprintf(stderr, "kernel_launch: device query failed\n"); grid = -1; return; }
        if (hipFuncSetAttribute((const void*)mega_fwd, hipFuncAttributeMaxDynamicSharedMemorySize, LDS_BYTES) != hipSuccess) { fprintf(stderr, "kernel_launch: hipFuncSetAttribute failed\n"); grid = -1; return; }
        if (hipOccupancyMaxActiveBlocksPerMultiprocessor(&per_cu, (const void*)mega_fwd, NTHREADS, LDS_BYTES) != hipSuccess || per_cu < 1) { fprintf(stderr, "kernel_launch: occupancy query says %d blocks per CU; nothing launched\n", per_cu); (void)hipGetLastError(); grid = -1; return; }
        grid = cus;
    }
    if (grid < 0) return;
    if (hipMemsetAsync((char*)d_ws + WS_CTL, 0, CTL_ZERO_BYTES, stream) != hipSuccess) { fprintf(stderr, "kernel_launch: hipMemsetAsync failed\n"); return; }
    Args a{};
    for (int i = 0; i < 26; ++i) a.in[i] = (const float*)d_in[i];
    a.out = (float*)d_out; a.ws = (unsigned char*)d_ws;
    void* kargs[] = {&a};
    const hipError_t le = hipLaunchCooperativeKernel((const void*)mega_fwd, dim3(grid), dim3(NTHREADS), kargs, LDS_BYTES, stream);
    if (le != hipSuccess) fprintf(stderr, "kernel_launch: cooperative launch failed: %s (grid %d x %d threads, %d B LDS)\n", hipGetErrorString(le), grid, NTHREADS, LDS_BYTES);
}
```

```cpp
#include <hip/hip_runtime.h>
#include <hip/hip_cooperative_groups.h>
#include <cstdio>
#include <cstdint>
namespace cg = cooperative_groups;

namespace pg8 {
#define PG8_LAS __attribute__((address_space(3)))
typedef unsigned short bf16_t;
typedef short bf16x8 __attribute__((ext_vector_type(8)));
typedef float f32x4 __attribute__((ext_vector_type(4)));
typedef unsigned u32x4 __attribute__((ext_vector_type(4)));
constexpr int BM = 256, BK = 64, HALF = 128, HTB = HALF * BK * 2  , STAGE_BYTES = 8 * HTB, NXCD = 8, WGM = 8;

__host__ __device__ __forceinline__ int lds_byte(int r, int c) { const int st = (r >> 4) * 2 + (c >> 5), rr = r & 15, cc = c & 31, ob = rr * 64 + cc * 2; return st * 1024 + (ob ^ (((ob >> 9) & 1) << 5)); }
__host__ __device__ __forceinline__ void stage_rc(int b, int& R, int& C) { const int st = b / 1024, sb = b % 1024, swz = sb ^ (((sb >> 9) & 1) << 5); R = (st >> 1) * 16 + swz / 64; C = (st & 1) * 32 + (swz % 64) / 2; }
__host__ __device__ __forceinline__ int perm32(int rho) { const int n = rho >> 4, i = rho & 15; return 8 * (i >> 2) + 4 * n + (i & 3); }

struct Unit { int pm, pn; size_t boff; };
struct Gemm { const bf16_t* A; const bf16_t* Bt; int M, N, K; };

struct StaticOrder {
    int nM, nN, nwg, G, c;
    __host__ __device__ void init(int M, int N, int G_, int c_) { nM = M / BM; nN = N / BM; nwg = nM * nN; G = G_; c = c_; }
    __host__ __device__ bool next(int i, Unit& u) const {
        const long L = (long)i * G + c; if (L >= nwg) return false;
        int wgid = (int)L; { const int q = nwg / NXCD, r = nwg % NXCD, xcd = wgid % NXCD, off = wgid / NXCD; wgid = (xcd < r ? xcd * (q + 1) : r * (q + 1) + (xcd - r) * q) + off; }
        const int nig = WGM * nN, gid = wgid / nig, fm = gid * WGM, gsz = (nM - fm) < WGM ? (nM - fm) : WGM;
        u.pm = fm + ((wgid % nig) % gsz); u.pn = (wgid % nig) / gsz; u.boff = 0; return true;
    }
    __device__ __forceinline__ void a_ready(const Unit&) const {}
    __device__ __forceinline__ void done(const Unit&) const {}
};

__device__ __forceinline__ unsigned cvt_pk_bf16(float lo, float hi) { unsigned r; asm volatile("v_cvt_pk_bf16_f32 %0, %1, %2" : "=v"(r) : "v"(lo), "v"(hi)); return r; }
typedef float f32x2 __attribute__((ext_vector_type(2)));
typedef unsigned u32x2 __attribute__((ext_vector_type(2)));
struct EpiBf16 {
    static constexpr bool PERM = true, AFTER_DRAIN = false;
    bf16_t* O; int ldc;
    __device__ __forceinline__ void operator()(const f32x4 (&acc)[2][2][4][2], const Unit& u, int wr, int wc, int fr, int fq) const {
        const int row0 = u.pm * BM + wr * 64 + fr; const int col0 = u.pn * BM + wc * 32 + 8 * fq;
#pragma unroll
        for (int ai = 0; ai < 2; ++ai)
#pragma unroll
            for (int m = 0; m < 4; ++m) { bf16_t* rowp = O + (size_t)(row0 + ai * HALF + m * 16) * ldc + col0;
#pragma unroll
                for (int bj = 0; bj < 2; ++bj) { const f32x4 v0 = acc[ai][bj][m][0], v1 = acc[ai][bj][m][1];
                    u32x4 w; w.x = cvt_pk_bf16(v0[0], v0[1]); w.y = cvt_pk_bf16(v0[2], v0[3]); w.z = cvt_pk_bf16(v1[0], v1[1]); w.w = cvt_pk_bf16(v1[2], v1[3]);
                    *(u32x4*)(rowp + bj * HALF) = w; } }
    }
};
struct EpiSwiglu {
    static constexpr bool PERM = true, AFTER_DRAIN = false;
    bf16_t* O; int ldc;
    __device__ __forceinline__ void operator()(const f32x4 (&acc)[2][2][4][2], const Unit& u, int wr, int wc, int fr, int fq) const {
        const int row0 = u.pm * BM + wr * 64 + fr; const int col0 = (u.pn * BM + wc * 32 + 8 * fq) >> 1;
#pragma unroll
        for (int ai = 0; ai < 2; ++ai)
#pragma unroll
            for (int m = 0; m < 4; ++m) { bf16_t* rowp = O + (size_t)(row0 + ai * HALF + m * 16) * ldc + col0;
#pragma unroll
                for (int bj = 0; bj < 2; ++bj) { const f32x4 v0 = acc[ai][bj][m][0], v1 = acc[ai][bj][m][1];
                    const float g0 = v0[0], g1 = v0[2], g2 = v1[0], g3 = v1[2];
                    const float a0 = g0 * __builtin_amdgcn_rcpf(1.f + __expf(-g0)) * v0[1], a1 = g1 * __builtin_amdgcn_rcpf(1.f + __expf(-g1)) * v0[3];
                    const float a2 = g2 * __builtin_amdgcn_rcpf(1.f + __expf(-g2)) * v1[1], a3 = g3 * __builtin_amdgcn_rcpf(1.f + __expf(-g3)) * v1[3];
                    u32x2 w; w.x = cvt_pk_bf16(a0, a1); w.y = cvt_pk_bf16(a2, a3);
                    *(u32x2*)(rowp + bj * (HALF / 2)) = w; } }
    }
};
struct EpiRes {
    static constexpr bool PERM = false, AFTER_DRAIN = false;
    const float* base; float* out; int ldc; const float* scale; int sstride;
    __device__ __forceinline__ void operator()(const f32x4 (&acc)[2][2][4][2], const Unit& u, int wr, int wc, int fr, int fq) const {
        const int col0 = u.pn * BM + wc * 32 + 4 * fq;
#pragma unroll
        for (int ai = 0; ai < 2; ++ai)
#pragma unroll
            for (int m = 0; m < 4; ++m) { const int r = u.pm * BM + ai * HALF + wr * 64 + m * 16 + fr; const size_t off = (size_t)r * ldc + col0;
                const float sc = scale ? scale[(size_t)r * sstride] : 1.f;
#pragma unroll
                for (int bj = 0; bj < 2; ++bj)
#pragma unroll
                    for (int n = 0; n < 2; ++n) { const f32x4 bs = *(const f32x4*)(base + off + bj * HALF + n * 16); *(f32x4*)(out + off + bj * HALF + n * 16) = bs + acc[ai][bj][m][n] * sc; }
                asm volatile("" ::: "memory"); }
    }
};
struct EpiSlot {
    static constexpr bool PERM = true, AFTER_DRAIN = false;
    bf16_t* O; int ldc; const float* rscale;
    __device__ __forceinline__ void operator()(const f32x4 (&acc)[2][2][4][2], const Unit& u, int wr, int wc, int fr, int fq) const {
        const int row0 = u.pm * BM + wr * 64 + fr; const int col0 = u.pn * BM + wc * 32 + 8 * fq;
#pragma unroll
        for (int ai = 0; ai < 2; ++ai)
#pragma unroll
            for (int m = 0; m < 4; ++m) { const int r = row0 + ai * HALF + m * 16; const float sc = rscale[r]; bf16_t* rowp = O + (size_t)r * ldc + col0;
#pragma unroll
                for (int bj = 0; bj < 2; ++bj) { const f32x4 v0 = acc[ai][bj][m][0] * sc, v1 = acc[ai][bj][m][1] * sc;
                    u32x4 w; w.x = cvt_pk_bf16(v0[0], v0[1]); w.y = cvt_pk_bf16(v0[2], v0[3]); w.z = cvt_pk_bf16(v1[0], v1[1]); w.w = cvt_pk_bf16(v1[2], v1[3]);
                    *(u32x4*)(rowp + bj * HALF) = w; } }
    }
};
struct MoeOrder {
    const int* segt; int NT, G, c; size_t estride;
    __device__ __forceinline__ bool next(int i, Unit& u) const {
        const int Mt = segt[8]; const long L = (long)i * G + c; if (L >= (long)Mt * NT) return false;
        u.pm = (int)(L / NT); u.pn = (int)(L % NT); int e = 0;
#pragma unroll
        for (int k = 1; k < 8; ++k) if (u.pm >= segt[k]) e = k;
        u.boff = (size_t)e * estride; return true;
    }
    __device__ __forceinline__ void a_ready(const Unit&) const {}
    __device__ __forceinline__ void done(const Unit&) const {}
};
template <class Epi, class Sched, bool ALIGN_EPI = false, bool SP2 = false, bool GATHER = false>
__device__ __forceinline__ void gemm_phase(PG8_LAS unsigned char* lds, const Gemm g, const Sched& S, const Epi& E, const int* ridx = nullptr) {
    static_assert(!GATHER || SP2, "row gather is wired into the SP2 loop only");
    int tid_ = threadIdx.x; asm volatile("" : "+v"(tid_));
    const int tid = tid_, wid = __builtin_amdgcn_readfirstlane(tid >> 6), lane = tid & 63, wr = wid >> 2, wc = wid & 3, fr = lane & 15, fq = lane >> 4;
    const int K = g.K, nt = K / BK;
    unsigned voffA[2], voffB[2];
#pragma unroll
    for (int i = 0; i < 2; ++i) { int R, C; stage_rc(tid * 16 + i * 8192, R, C); const int Rb = Epi::PERM ? ((R & ~31) + perm32(R & 31)) : R;
        voffA[i] = (unsigned)(R * K + C) * 2u; voffB[i] = (unsigned)(Rb * K + C) * 2u; }
    unsigned vA0[2] = {0u, 0u}, vA1[2] = {0u, 0u}; int rn[4] = {0, 0, 0, 0};
    auto rows_load = [&](int pm) { _Pragma("unroll") for (int i = 0; i < 2; ++i) { int R, C; stage_rc(tid * 16 + i * 8192, R, C); rn[i] = ridx[pm * BM + R]; rn[2 + i] = ridx[pm * BM + HALF + R]; } };
    auto rows_set = [&]() { _Pragma("unroll") for (int i = 0; i < 2; ++i) { int R, C; stage_rc(tid * 16 + i * 8192, R, C); vA0[i] = (unsigned)(rn[i] * K + C) * 2u; vA1[i] = (unsigned)(rn[2 + i] * K + C) * 2u; } };
    const size_t kstep = (size_t)(BK * 2);
    const size_t hstep = (size_t)HALF * K * 2;
    const size_t tstep = 2 * hstep;
    const unsigned ldsw = (unsigned)wid * 1024u;
    const int aoff = lds_byte(wr * 64 + fr, fq * 8), boff = lds_byte(wc * 32 + fr, fq * 8);
#define PG8_SA(b, h) (((b) * 2 + (h)) * HTB)
#define PG8_SB(b, h) ((4 + (b) * 2 + (h)) * HTB)
#define PG8_STAGE(bufoff, gbase, voff) do { _Pragma("unroll") for (int _i = 0; _i < 2; ++_i) \
        __builtin_amdgcn_global_load_lds((const unsigned*)((const char*)(gbase) + (voff)[_i]), (PG8_LAS unsigned*)(lds + (bufoff) + ldsw + _i * 8192), 16, 0, 0); } while (0)
#define PG8_STAGE_A(bufoff, gptr, half) do { if constexpr (GATHER) { if ((half) == 0) PG8_STAGE(bufoff, gptr, vA0); else PG8_STAGE(bufoff, gptr, vA1); } else { PG8_STAGE(bufoff, (gptr) + (half) * hstep, voffA); } } while (0)
#define PG8_LDA(dst, b, h) do { _Pragma("unroll") for (int m = 0; m < 4; ++m) _Pragma("unroll") for (int k = 0; k < 2; ++k) dst[m][k] = *(const PG8_LAS bf16x8*)(lds + PG8_SA(b, h) + aoff + m * 2048 + k * 1024); } while (0)
#define PG8_LDB(dst, b, h) do { _Pragma("unroll") for (int n = 0; n < 2; ++n) _Pragma("unroll") for (int k = 0; k < 2; ++k) dst[n][k] = *(const PG8_LAS bf16x8*)(lds + PG8_SB(b, h) + boff + n * 2048 + k * 1024); } while (0)
#define PG8_MMA(ai, bj, At, Bt) do { __builtin_amdgcn_s_setprio(1); _Pragma("unroll") for (int m = 0; m < 4; ++m) _Pragma("unroll") for (int n = 0; n < 2; ++n) _Pragma("unroll") for (int k = 0; k < 2; ++k) \
        acc[ai][bj][m][n] = __builtin_amdgcn_mfma_f32_16x16x32_bf16(Bt[n][k], At[m][k], acc[ai][bj][m][n], 0, 0, 0); __builtin_amdgcn_s_setprio(0); } while (0)
#define PG8_WAIT_V(n) asm volatile("s_waitcnt vmcnt(" #n ")" ::: "memory")
#define PG8_WAIT_L(n) asm volatile("s_waitcnt lgkmcnt(" #n ")" ::: "memory")
#define PG8_BAR __builtin_amdgcn_s_barrier()
#define PG8_SCHED __builtin_amdgcn_sched_barrier(0)
    Unit cur, nxt; int ui = 0;
    if (!S.next(0, cur)) return;
    f32x4 acc[2][2][4][2];
#pragma unroll
    for (int a = 0; a < 2; ++a)
#pragma unroll
        for (int b = 0; b < 2; ++b)
#pragma unroll
            for (int m = 0; m < 4; ++m)
#pragma unroll
                for (int n = 0; n < 2; ++n) acc[a][b][m][n] = (f32x4){0.f, 0.f, 0.f, 0.f};
    bf16x8 At[4][2], B0[2][2], B1[2][2];
    const char* cA = (const char*)g.A + (GATHER ? (size_t)0 : (size_t)cur.pm * tstep); const char* cB = (const char*)g.Bt + cur.boff + (size_t)cur.pn * tstep;
    if constexpr (GATHER) { rows_load(cur.pm); rows_set(); }
    S.a_ready(cur);
    if constexpr (SP2) {
        PG8_STAGE(PG8_SB(0, 0), cB, voffB); PG8_STAGE(PG8_SB(0, 1), cB + hstep, voffB); PG8_STAGE_A(PG8_SA(0, 0), cA, 0); PG8_STAGE_A(PG8_SA(0, 1), cA, 1);
        if (wr == 1) PG8_BAR;
        PG8_WAIT_V(2); PG8_BAR;
        PG8_STAGE(PG8_SB(1, 0), cB + kstep, voffB); PG8_STAGE_A(PG8_SA(1, 0), cA + kstep, 0); PG8_STAGE(PG8_SB(1, 1), cB + hstep + kstep, voffB);
        PG8_WAIT_V(6); PG8_BAR;
    } else {
        PG8_STAGE(PG8_SB(0, 0), cB, voffB); PG8_STAGE(PG8_SA(0, 0), cA, voffA); PG8_STAGE(PG8_SB(0, 1), cB + hstep, voffB); PG8_STAGE(PG8_SA(0, 1), cA + hstep, voffA);
        if (wr == 1) PG8_BAR;
        PG8_WAIT_V(4); PG8_BAR;
        PG8_STAGE(PG8_SB(1, 0), cB + kstep, voffB); PG8_STAGE(PG8_SA(1, 0), cA + kstep, voffA); PG8_STAGE(PG8_SB(1, 1), cB + hstep + kstep, voffB);
        PG8_WAIT_V(6); PG8_BAR;
    }
    for (;;) {
        const bool has_next = S.next(ui + 1, nxt);
        const char* nA = (has_next && !GATHER) ? (const char*)g.A + (size_t)nxt.pm * tstep : cA; const char* nB = has_next ? (const char*)g.Bt + nxt.boff + (size_t)nxt.pn * tstep : cB;
        for (int t = 0; t < nt; t += 2) {
            const bool last = (t == nt - 2);
            const char* a1 = cA + (size_t)(t + 1) * kstep;
            const char* a2 = last ? nA : cA + (size_t)(t + 2) * kstep; const char* b2 = last ? nB : cB + (size_t)(t + 2) * kstep;
            const char* a3 = a2 + kstep; const char* b3 = b2 + kstep;
            if (last && has_next) S.a_ready(nxt);
            if constexpr (SP2) {
            if constexpr (GATHER) { if (last && has_next) rows_load(nxt.pm); }
            PG8_LDB(B0, 0, 0); PG8_LDB(B1, 0, 1); PG8_SCHED; PG8_LDA(At, 0, 0); PG8_STAGE_A(PG8_SA(1, 1), a1, 1);
            PG8_WAIT_V(8); PG8_WAIT_L(0); PG8_BAR; PG8_MMA(0, 0, At, B0); PG8_MMA(0, 1, At, B1); PG8_BAR; PG8_SCHED;
            if constexpr (GATHER) { if (last && has_next) rows_set(); }
            PG8_LDA(At, 0, 1); PG8_STAGE(PG8_SB(0, 0), b2, voffB); PG8_STAGE(PG8_SB(0, 1), b2 + hstep, voffB); PG8_STAGE_A(PG8_SA(0, 0), a2, 0);
            PG8_WAIT_V(8); PG8_WAIT_L(0); PG8_BAR; PG8_MMA(1, 0, At, B0); PG8_MMA(1, 1, At, B1); PG8_BAR; PG8_SCHED;
            PG8_LDB(B0, 1, 0); PG8_LDB(B1, 1, 1); PG8_SCHED; PG8_LDA(At, 1, 0); PG8_STAGE_A(PG8_SA(0, 1), a2, 1);
            PG8_WAIT_V(8); PG8_WAIT_L(0); PG8_BAR; PG8_MMA(0, 0, At, B0); PG8_MMA(0, 1, At, B1); PG8_BAR; PG8_SCHED;
            PG8_LDA(At, 1, 1); PG8_STAGE(PG8_SB(1, 0), b3, voffB); PG8_STAGE(PG8_SB(1, 1), b3 + hstep, voffB); PG8_STAGE_A(PG8_SA(1, 0), a3, 0);
            PG8_WAIT_V(8); PG8_WAIT_L(0); PG8_BAR; PG8_MMA(1, 0, At, B0); PG8_MMA(1, 1, At, B1); PG8_BAR; PG8_SCHED;
            } else {
            PG8_LDB(B0, 0, 0); PG8_SCHED; PG8_LDA(At, 0, 0); PG8_STAGE(PG8_SA(1, 1), a1 + hstep, voffA);
            PG8_WAIT_L(8); PG8_BAR; PG8_WAIT_L(0); PG8_MMA(0, 0, At, B0); PG8_BAR; PG8_SCHED;
            PG8_LDB(B1, 0, 1); PG8_STAGE(PG8_SB(0, 0), b2, voffB);
            PG8_BAR; PG8_WAIT_L(0); PG8_MMA(0, 1, At, B1); PG8_BAR;
            PG8_LDA(At, 0, 1); PG8_STAGE(PG8_SA(0, 0), a2, voffA);
            PG8_BAR; PG8_WAIT_L(0); PG8_MMA(1, 0, At, B0); PG8_BAR; PG8_SCHED;
            PG8_STAGE(PG8_SB(0, 1), b2 + hstep, voffB);
            PG8_WAIT_V(6); PG8_BAR; PG8_MMA(1, 1, At, B1); PG8_BAR;
            PG8_LDB(B0, 1, 0); PG8_SCHED; PG8_LDA(At, 1, 0); PG8_STAGE(PG8_SA(0, 1), a2 + hstep, voffA);
            PG8_WAIT_L(8); PG8_BAR; PG8_WAIT_L(0); PG8_MMA(0, 0, At, B0); PG8_BAR; PG8_SCHED;
            PG8_LDB(B1, 1, 1); PG8_STAGE(PG8_SB(1, 0), b3, voffB);
            PG8_BAR; PG8_WAIT_L(0); PG8_MMA(0, 1, At, B1); PG8_BAR;
            PG8_LDA(At, 1, 1); PG8_STAGE(PG8_SA(1, 0), a3, voffA);
            PG8_BAR; PG8_WAIT_L(0); PG8_MMA(1, 0, At, B0); PG8_BAR; PG8_SCHED;
            PG8_STAGE(PG8_SB(1, 1), b3 + hstep, voffB);
            PG8_WAIT_V(6); PG8_BAR; PG8_MMA(1, 1, At, B1); PG8_BAR;
            }
        }
        if constexpr (ALIGN_EPI) { if (wr == 0) PG8_BAR; }
        if constexpr (!Epi::AFTER_DRAIN) { E(acc, cur, wr, wc, fr, fq); S.done(cur); }
        if (!has_next) break;
#pragma unroll
        for (int a = 0; a < 2; ++a)
#pragma unroll
            for (int b = 0; b < 2; ++b)
#pragma unroll
                for (int m = 0; m < 4; ++m)
#pragma unroll
                    for (int n = 0; n < 2; ++n) acc[a][b][m][n] = (f32x4){0.f, 0.f, 0.f, 0.f};
        cur = nxt; cA = nA; cB = nB; ++ui;
        if constexpr (ALIGN_EPI) { if (wr == 1) PG8_BAR; }
    }
    PG8_WAIT_V(0);
    if constexpr (!ALIGN_EPI) { if (wr == 0) PG8_BAR; }
    PG8_BAR;
    if constexpr (Epi::AFTER_DRAIN) { E.fused(acc, cur, wr, wc, fr, fq, lds, wid, lane); S.done(cur); }
#undef PG8_SA
#undef PG8_SB
#undef PG8_STAGE
#undef PG8_STAGE_A
#undef PG8_LDA
#undef PG8_LDB
#undef PG8_MMA
#undef PG8_WAIT_V
#undef PG8_WAIT_L
#undef PG8_BAR
#undef PG8_SCHED
}
}
typedef unsigned short bf16_t;
constexpr int D_MODEL = 1024, BATCH = 8, SEQ = 2048, TOK = BATCH * SEQ;
constexpr int CHUNK = 64, NCHUNK = SEQ / CHUNK;
constexpr int RW = 512, AW = 512, NH = 8;
constexpr int IN_COLS = 3328, SHIFT_COLS = 1792;
constexpr int C_R = 0, C_K = 512, C_V = 1024, C_WD = 1536, C_AD = 1600, C_GD = 1664, C_QA = 1792, C_KA = 2304, C_VA = 2816;
constexpr int D_FF = 2816, NE = 8, D_FFE = 1408;
constexpr float RMS_EPS = 1e-6f, GN_EPS = 64e-5f;
constexpr int NWAVES = 8, NTHREADS = 512;

constexpr size_t MiB = 1u << 20;
constexpr size_t WS_CTL = 0, CTL_ZERO_BYTES = 64 * 1024;
constexpr size_t SZ_WIN = (size_t)IN_COLS * D_MODEL * 2, SZ_WOUT = (size_t)D_MODEL * D_MODEL * 2, SZ_FGU = (size_t)2 * D_FF * D_MODEL * 2, SZ_FDN = (size_t)D_MODEL * D_FF * 2;
constexpr size_t SZ_MGU = (size_t)2 * D_FFE * D_MODEL * 2, SZ_MDN = (size_t)D_MODEL * D_FFE * 2;
constexpr size_t WS_WIN = 1 * MiB, WS_WOUT = WS_WIN + 2 * SZ_WIN, WS_FGU = WS_WOUT + 2 * SZ_WOUT, WS_FDN = WS_FGU + SZ_FGU, WS_LORA = WS_FDN + SZ_FDN, WS_WEND = WS_LORA + 512 * 1024;
constexpr size_t LORA_W2T = 0, LORA_A2T = 2 * 512 * 64 * 2, LORA_G2T = 4 * 512 * 64 * 2;
constexpr size_t WS_XN = 35 * MiB;
constexpr size_t WS_PROJ = 67 * MiB;
constexpr size_t WS_CHUNK = 171 * MiB;
constexpr size_t WS_GP = WS_CHUNK, WS_QP = WS_CHUNK + 16 * MiB, WS_HT = WS_CHUNK + 32 * MiB, WS_ZT = WS_CHUNK + 48 * MiB, WS_GATE = WS_CHUNK + 64 * MiB;
constexpr size_t WS_BONUS = 251 * MiB;
constexpr size_t WS_TAB = 252 * MiB;
constexpr int MOE_MAXROWS = 2 * TOK + NE * 256;
constexpr size_t TAB_ROUTE_E = 0, TAB_ROUTE_G = 64 * 1024, TAB_POS = 192 * 1024, TAB_ROWIDX = 320 * 1024, TAB_GATEPOS = 464 * 1024, TAB_SEGT = 608 * 1024;
constexpr size_t WS_SLOT = 1 * MiB;
constexpr size_t WS_ACT2 = 69 * MiB;
static_assert(WS_SLOT + (size_t)MOE_MAXROWS * D_MODEL * 2 <= WS_ACT2 && WS_ACT2 + (size_t)MOE_MAXROWS * D_FFE * 2 <= 171 * MiB && TAB_ROWIDX + MOE_MAXROWS * 4 <= TAB_GATEPOS && TAB_GATEPOS + MOE_MAXROWS * 4 <= TAB_SEGT, "moe map");
constexpr size_t WS_MGU = WS_CHUNK, WS_MDN = WS_MGU + NE * SZ_MGU;
constexpr size_t WS_END = 253 * MiB;
static_assert(WS_MDN + NE * SZ_MDN <= WS_BONUS && WS_GATE + 16 * MiB <= WS_BONUS, "map");
static_assert(WS_WEND <= WS_XN, "weights fit below XN");

#define GAS __attribute__((address_space(1)))
#define LAS __attribute__((address_space(3)))
typedef unsigned short bf16;
typedef unsigned v4u __attribute__((ext_vector_type(4)));
typedef float f32x4 __attribute__((ext_vector_type(4)));
typedef short bf16x8 __attribute__((ext_vector_type(8)));
typedef GAS unsigned gu32;
typedef GAS unsigned long long gu64;
#define RLX_AGENT __ATOMIC_RELAXED, __HIP_MEMORY_SCOPE_AGENT
#define LDS_WAIT() asm volatile("s_waitcnt lgkmcnt(0)" ::: "memory")
#define VM_WAIT() asm volatile("s_waitcnt vmcnt(0)" ::: "memory")
__device__ __forceinline__ unsigned long long rt() { return __builtin_amdgcn_s_memrealtime(); }
__device__ __forceinline__ unsigned f2bf(float f) { unsigned u = __builtin_bit_cast(unsigned, f); return (u + 0x7fffu + ((u >> 16) & 1u)) >> 16; }
__device__ __forceinline__ unsigned pk2(float lo, float hi) { return f2bf(lo) | (f2bf(hi) << 16); }
constexpr int CW_BAR = 1024;
#define XB_TMO      128
#define XB_XCNT(j)  (256  + 64 * (j))
#define XB_XSUB(j)  (1280 + 64 * (j))
#define XB_XGEN(j)  (2304 + 64 * (j))
#define XB_TOP      3328
#define XB_TOPGEN   3392
#define XCD_BAR_WORDS 3456
#define XB_SPIN_CAP (1u << 18)

__device__ __forceinline__ unsigned xb_ld(unsigned* p)              { return __hip_atomic_load(p, __ATOMIC_RELAXED, __HIP_MEMORY_SCOPE_AGENT); }
__device__ __forceinline__ unsigned xb_add(unsigned* p, unsigned v) { return __hip_atomic_fetch_add(p, v, __ATOMIC_RELAXED, __HIP_MEMORY_SCOPE_AGENT); }
__device__ __forceinline__ unsigned xb_xcc_id() { return (unsigned)__builtin_amdgcn_s_getreg((3 << 11) | 20) & 0xFu; }
#define XB_SPIN(cond, bar) do { unsigned _sp = 0; while (cond) { __builtin_amdgcn_s_sleep(1); \
    if ((++_sp & 255u) == 0u) { if (xb_ld(&(bar)[XB_TMO])) break; if (_sp > XB_SPIN_CAP) { atomicAdd(&(bar)[XB_TMO], 1u); break; } } } } while (0)

struct XcdBarrier {
    unsigned* bar; unsigned x;
    volatile LAS unsigned* st;
};

__device__ __forceinline__ XcdBarrier xcd_barrier_post(unsigned* bar, volatile LAS unsigned* st) {
    XcdBarrier b; b.bar = bar; b.x = xb_xcc_id(); b.st = st;
    if (threadIdx.x == 0) (void)xb_add(&bar[XB_XCNT(b.x)], 1u);
    return b;
}
__device__ __forceinline__ void xcd_barrier_complete(unsigned* bar, unsigned x, unsigned& nloc, unsigned& nx) {
    const unsigned G = gridDim.x * gridDim.y * gridDim.z;
    unsigned sum, cnt, mine, sp = 0u;
    for (;;) {
        sum = 0u; cnt = 0u; mine = 0u;
#pragma unroll
        for (unsigned j = 0; j < 16; ++j) { const unsigned c = xb_ld(&bar[XB_XCNT(j)]); sum += c; cnt += (c > 0u) ? 1u : 0u; mine = (j == x) ? c : mine; }
        if (sum == G) break;
        __builtin_amdgcn_s_sleep(1);
        if ((++sp & 255u) == 0u) { if (xb_ld(&bar[XB_TMO])) break; if (sp > XB_SPIN_CAP) { atomicAdd(&bar[XB_TMO], 1u); break; } }
    }
    nloc = mine > 0u ? mine : 1u; nx = cnt > 0u ? cnt : 1u;
}

__device__ __forceinline__ void xcd_barrier(const XcdBarrier& b) {
    asm volatile("s_waitcnt vmcnt(0)" ::: "memory");
    __syncthreads();
    if (threadIdx.x == 0) {
        unsigned* bar = b.bar;
        __builtin_amdgcn_s_waitcnt(0);
        unsigned nloc = b.st[0], nx = b.st[1];
        if (nloc == 0u) { xcd_barrier_complete(bar, b.x, nloc, nx); b.st[0] = nloc; b.st[1] = nx; }
        const unsigned old = xb_add(&bar[XB_XSUB(b.x)], 1u);
        const unsigned gen = old / nloc;
        if (old + 1u == (gen + 1u) * nloc) {
            __builtin_amdgcn_fence(__ATOMIC_RELEASE, "agent");
            asm volatile("s_waitcnt vmcnt(0)" ::: "memory");
            const unsigned og = xb_add(&bar[XB_TOP], 1u);
            const unsigned tg = og / nx;
            if (og + 1u == (tg + 1u) * nx) xb_add(&bar[XB_TOPGEN], 1u);
            else XB_SPIN(xb_ld(&bar[XB_TOPGEN]) == tg, bar);
            __builtin_amdgcn_fence(__ATOMIC_ACQUIRE, "agent");
            xb_add(&bar[XB_XGEN(b.x)], 1u);
            asm volatile("s_waitcnt vmcnt(0)" ::: "memory");
        } else {
            XB_SPIN(xb_ld(&bar[XB_XGEN(b.x)]) == gen, bar);
            __builtin_amdgcn_fence(__ATOMIC_ACQUIRE, "agent");
            asm volatile("s_waitcnt vmcnt(0)" ::: "memory");
        }
    }
    __syncthreads();
}
__device__ __forceinline__ float bf2f(unsigned h) { return __builtin_bit_cast(float, h << 16); }
__device__ __forceinline__ float wave_sum(float v) {
#pragma unroll
    for (int o = 1; o < 64; o <<= 1) v += __shfl_xor(v, o);
    return v;
}
typedef float f32x2_t __attribute__((ext_vector_type(2))); typedef __bf16 bf16x2_t __attribute__((ext_vector_type(2)));
__device__ __forceinline__ unsigned cvtpk(float lo, float hi) { const f32x2_t v = {lo, hi}; const bf16x2_t b = __builtin_convertvector(v, bf16x2_t); return __builtin_bit_cast(unsigned, b); }
__device__ __forceinline__ float sigmoidf_(float x) { return 1.f / (1.f + __expf(-x)); }

__device__ __forceinline__ void p0_transpose_item(const float* W, int K, int N, bf16_t* WT, int row_off, int rmul, LAS float* scr, int item, int lane) {
    const int nblk = N / 32, kb = item / nblk, nb = item % nblk, k0 = 64 * kb, n0 = 32 * nb;
#pragma unroll 8
    for (int i = 0; i < 32; ++i) { const int kk = 2 * i + (lane >> 5); scr[kk * 33 + (lane & 31)] = W[(size_t)(k0 + kk) * N + n0 + (lane & 31)]; }
    LDS_WAIT(); asm volatile("" ::: "memory");
    const int c = lane & 7;
#pragma unroll
    for (int j = 0; j < 4; ++j) { const int n = (lane >> 3) + 8 * j; const LAS float* s = scr + (8 * c) * 33 + n;
        v4u o; o.x = pk2(s[0 * 33], s[1 * 33]); o.y = pk2(s[2 * 33], s[3 * 33]); o.z = pk2(s[4 * 33], s[5 * 33]); o.w = pk2(s[6 * 33], s[7 * 33]);
        *(GAS v4u*)(WT + (size_t)(row_off + (n0 + n) * rmul) * K + k0 + 8 * c) = o; }
    LDS_WAIT(); asm volatile("" ::: "memory");
}

template <int MODE>
__device__ __forceinline__ void norm_rows(int gw, int ngw, int lane, const float* x, const float* __restrict__ g, bf16_t* xn, float* outf, const float* __restrict__ router, int* route_e, float2* route_g,
                                          const bf16_t* slot = nullptr, const int2* pos = nullptr) {
    for (int row = gw; row < TOK; row += ngw) {
        const float4* xr = (const float4*)(x + (size_t)row * D_MODEL);
        float4 v[4]; float s = 0.f;
        int2 pp = make_int2(0, 0); if (MODE == 3) pp = pos[row];
#pragma unroll
        for (int j = 0; j < 4; ++j) { v[j] = xr[lane + 64 * j];
            if (MODE == 3) {
                const uint2 s0 = *(const uint2*)(slot + (size_t)pp.x * D_MODEL + (lane + 64 * j) * 4), s1 = *(const uint2*)(slot + (size_t)pp.y * D_MODEL + (lane + 64 * j) * 4);
                v[j].x += bf2f(s0.x & 0xffffu) + bf2f(s1.x & 0xffffu); v[j].y += bf2f(s0.x >> 16) + bf2f(s1.x >> 16); v[j].z += bf2f(s0.y & 0xffffu) + bf2f(s1.y & 0xffffu); v[j].w += bf2f(s0.y >> 16) + bf2f(s1.y >> 16);
            }
#ifdef DBG_SANITIZE
            if (MODE >= 2) { if (!(fabsf(v[j].x) < 1e30f)) v[j].x = 0.f; if (!(fabsf(v[j].y) < 1e30f)) v[j].y = 0.f; if (!(fabsf(v[j].z) < 1e30f)) v[j].z = 0.f; if (!(fabsf(v[j].w) < 1e30f)) v[j].w = 0.f; }
#endif
            s += v[j].x * v[j].x + v[j].y * v[j].y + v[j].z * v[j].z + v[j].w * v[j].w; }
        s = wave_sum(s);
        const float rstd = rsqrtf(s * (1.f / D_MODEL) + RMS_EPS);
        float lg[8];
#pragma unroll
        for (int e = 0; e < 8; ++e) lg[e] = 0.f;
#pragma unroll
        for (int j = 0; j < 4; ++j) {
            const int c0 = (lane + 64 * j) * 4;
            const float4 gg = *(const float4*)(g + c0);
            const float h0 = v[j].x * rstd * gg.x, h1 = v[j].y * rstd * gg.y, h2 = v[j].z * rstd * gg.z, h3 = v[j].w * rstd * gg.w;
            if (MODE >= 2) { *(float4*)(outf + (size_t)row * D_MODEL + c0) = make_float4(h0, h1, h2, h3); }
            else { uint2 o; o.x = pk2(h0, h1); o.y = pk2(h2, h3); *(uint2*)(xn + (size_t)row * D_MODEL + c0) = o; }
            if (MODE == 1) {
                const float hh[4] = {h0, h1, h2, h3};
#pragma unroll
                for (int i = 0; i < 4; ++i) {
                    const float4 r0 = *(const float4*)(router + (size_t)(c0 + i) * 8), r1 = *(const float4*)(router + (size_t)(c0 + i) * 8 + 4);
                    lg[0] += hh[i] * r0.x; lg[1] += hh[i] * r0.y; lg[2] += hh[i] * r0.z; lg[3] += hh[i] * r0.w;
                    lg[4] += hh[i] * r1.x; lg[5] += hh[i] * r1.y; lg[6] += hh[i] * r1.z; lg[7] += hh[i] * r1.w;
                }
            }
        }
        if (MODE == 1) {
#pragma unroll
            for (int e = 0; e < 8; ++e) lg[e] = wave_sum(lg[e]);
            if (lane == 0) {
                int i0 = 0; float v0 = lg[0];
#pragma unroll
                for (int e = 1; e < 8; ++e) if (lg[e] > v0) { v0 = lg[e]; i0 = e; }
                int i1 = -1; float v1 = -3.0e38f;
#pragma unroll
                for (int e = 0; e < 8; ++e) if (e != i0 && lg[e] > v1) { v1 = lg[e]; i1 = e; }
                const float e1 = __expf(v1 - v0), inv = 1.f / (1.f + e1);
                route_e[row] = i0 | (i1 << 8); route_g[row] = make_float2(inv, e1 * inv);
            }
        }
    }
}


struct MoeTabs { int* route_e; float2* route_g; int2* pos; int* rowidx; float* gatepos; int* segt; };
__device__ __forceinline__ int wave_sum_i(int v) {
#pragma unroll
    for (int o = 1; o < 64; o <<= 1) v += __shfl_xor(v, o);
    return v;
}
__device__ __forceinline__ void moe_build_lists(LAS unsigned char* lds, int bid, int G, const MoeTabs& T) {
    int tid_ = threadIdx.x; asm volatile("" : "+v"(tid_));
    const int tid = tid_, lane = tid & 63, wave = __builtin_amdgcn_readfirstlane(tid >> 6);
    LAS int* cnt = (LAS int*)lds;
#pragma unroll 1
    for (int tb = bid; tb < TOK / 64; tb += G) {
        __syncthreads();
        if (tid < 32) cnt[tid] = 0;
        __syncthreads();
        int ct[8], cp[8];
#pragma unroll
        for (int k = 0; k < 8; ++k) { ct[k] = 0; cp[k] = 0; }
        for (int tok = tid; tok < TOK; tok += NTHREADS) {
            const int e = T.route_e[tok], e0 = e & 0xff, e1 = (e >> 8) & 0xff; const bool before = tok < 64 * tb;
#pragma unroll
            for (int k = 0; k < 8; ++k) { const int c = (e0 == k ? 1 : 0) + (e1 == k ? 1 : 0); ct[k] += c; cp[k] += before ? c : 0; }
        }
#pragma unroll
        for (int k = 0; k < 8; ++k) { const int a = wave_sum_i(ct[k]), b = wave_sum_i(cp[k]); if (lane == 0) { atomicAdd((int*)&cnt[k], a); atomicAdd((int*)&cnt[8 + k], b); } }
        __syncthreads();
        if (tid == 0) { int s = 0; for (int k = 0; k < 8; ++k) { cnt[16 + k] = s; s += (cnt[k] + 255) & ~255; } cnt[24] = s; }
        __syncthreads();
        if (wave == 0) {
            const int tok = 64 * tb + lane; const int e = T.route_e[tok], e0 = e & 0xff, e1 = (e >> 8) & 0xff; const float2 gg = T.route_g[tok];
            const unsigned long long below = (1ull << lane) - 1ull; int p0 = 0, p1 = 0;
#pragma unroll
            for (int k = 0; k < 8; ++k) {
                const unsigned long long m0 = __ballot(e0 == k), m1 = __ballot(e1 == k);
                const int r = __popcll(m0 & below) + __popcll(m1 & below) + cnt[16 + k] + cnt[8 + k];
                if (e0 == k) p0 = r; if (e1 == k) p1 = r;
            }
            T.pos[tok] = make_int2(p0, p1); T.rowidx[p0] = tok; T.rowidx[p1] = tok; T.gatepos[p0] = gg.x; T.gatepos[p1] = gg.y;
        }
        if (tb == 0) {
            for (int k = 0; k < 8; ++k) for (int p = cnt[16 + k] + cnt[k] + tid; p < cnt[17 + k]; p += NTHREADS) { T.rowidx[p] = 0; T.gatepos[p] = 0.f; }
            if (tid < 9) T.segt[tid] = cnt[16 + tid] >> 8;
        }
    }
}
typedef float f32x16 __attribute__((ext_vector_type(16)));
typedef short s16x4 __attribute__((ext_vector_type(4)));
constexpr int ATT_WAVE_BYTES = 16384, ATT_TBL = 8 * ATT_WAVE_BYTES, ATT_SCR = ATT_TBL + 8 * 260 * 4, ATT_SSQ = ATT_SCR + 8 * 64 * 4, ATT_LDS = ATT_SSQ + 8 * 64 * 4;
constexpr float LOG2E = 1.4426950408889634f;
__device__ __forceinline__ int crow(int r, int hi) { return (r & 3) + 8 * (r >> 2) + 4 * hi; }
__device__ __forceinline__ s16x4 vtr(const LAS unsigned char* p) { return __builtin_bit_cast(s16x4, __builtin_amdgcn_ds_read_tr16_b64_v4i16((LAS s16x4*)p)); }
__device__ __forceinline__ bf16x8 scale_q(uint4 u) {
    const unsigned w[4] = {u.x, u.y, u.z, u.w}; unsigned o[4];
#pragma unroll
    for (int i = 0; i < 4; ++i) o[i] = pk2(bf2f(w[i] & 0xffffu) * 0.125f, bf2f(w[i] >> 16) * 0.125f);
    return __builtin_bit_cast(bf16x8, make_uint4(o[0], o[1], o[2], o[3]));
}
__device__ __forceinline__ void attn_qblock(f32x16& o0, f32x16& o1, float& l_out, int qb, int b, int n, int h, int lane, LAS unsigned char* vt, LAS float* scr, const LAS float* mytbl, const bf16_t* __restrict__ proj) {
    const int r32 = lane & 31, hi = lane >> 5;
    const size_t row0 = (size_t)b * SEQ + n * CHUNK;
    bf16x8 qr[4];
    {
        const bf16_t* qp = proj + (row0 + qb * 32 + r32) * IN_COLS + C_QA + h * 64 + 8 * hi;
#pragma unroll
        for (int ds = 0; ds < 4; ++ds) qr[ds] = scale_q(*(const uint4*)(qp + 16 * ds));
    }
    float m = -1.0e30f, l = 0.f;
#pragma unroll
    for (int r = 0; r < 16; ++r) { o0[r] = 0.f; o1[r] = 0.f; }
    const int iq = qb * 32 + r32;
    const int c_lo = (n >= 8) ? 0 : (8 - n);
    const int trow = (4 * hi + ((lane & 15) >> 2)) * 128 + ((lane >> 4) & 1) * 32 + (lane & 3) * 8;
#pragma unroll 1
    for (int c = c_lo; c <= 8; ++c) {
        const size_t krow0 = (size_t)b * SEQ + (size_t)(n + c - 8) * CHUNK;
        uint4 vv[8];
        {
            const bf16_t* vp = proj + (krow0 + lane) * IN_COLS + C_VA + h * 64;
#pragma unroll
            for (int i = 0; i < 8; ++i) vv[i] = *(const uint4*)(vp + 8 * i);
        }
        bf16x8 kf[4][2];
        {
            const bf16_t* kp = proj + (krow0 + r32) * IN_COLS + C_KA + h * 64 + 8 * hi;
#pragma unroll
            for (int ds = 0; ds < 4; ++ds) { kf[ds][0] = *(const bf16x8*)(kp + 16 * ds); kf[ds][1] = *(const bf16x8*)(kp + (size_t)32 * IN_COLS + 16 * ds); }
        }
#pragma unroll
        for (int i = 0; i < 8; ++i) *(LAS v4u*)(vt + lane * 128 + i * 16) = (v4u){vv[i].x, vv[i].y, vv[i].z, vv[i].w};
        f32x16 p0, p1;
#pragma unroll
        for (int r = 0; r < 16; ++r) { p0[r] = 0.f; p1[r] = 0.f; }
#pragma unroll
        for (int ds = 0; ds < 4; ++ds) { p0 = __builtin_amdgcn_mfma_f32_32x32x16_bf16(kf[ds][0], qr[ds], p0, 0, 0, 0); p1 = __builtin_amdgcn_mfma_f32_32x32x16_bf16(kf[ds][1], qr[ds], p1, 0, 0, 0); }
        if (c <= 5) {
            const float bc = mytbl[256];
#pragma unroll
            for (int r = 0; r < 16; ++r) { p0[r] = p0[r] * LOG2E + bc; p1[r] = p1[r] * LOG2E + bc; }
        } else {
            const int base = iq + 64 * (8 - c);
#pragma unroll
            for (int r = 0; r < 16; ++r) {
                const int k0 = crow(r, hi); int i0 = base - k0, i1 = base - k0 - 32;
                i0 = (i0 > 128 ? 128 : i0) + 128; i1 = (i1 > 128 ? 128 : i1) + 128;
                p0[r] = p0[r] * LOG2E + mytbl[i0]; p1[r] = p1[r] * LOG2E + mytbl[i1];
            }
        }
        float mt = fmaxf(p0[0], p1[0]);
#pragma unroll
        for (int r = 1; r < 16; ++r) mt = fmaxf(mt, fmaxf(p0[r], p1[r]));
        mt = fmaxf(mt, __shfl_xor(mt, 32));
        const float mn = fmaxf(m, mt), alpha = __builtin_amdgcn_exp2f(m - mn);
        m = mn;
        float rs = 0.f;
#pragma unroll
        for (int r = 0; r < 16; ++r) { p0[r] = __builtin_amdgcn_exp2f(p0[r] - mn); p1[r] = __builtin_amdgcn_exp2f(p1[r] - mn); rs += p0[r] + p1[r]; }
        rs += __shfl_xor(rs, 32);
        l = l * alpha + rs;
        if (hi == 0) scr[r32] = alpha;
#pragma unroll
        for (int r = 0; r < 16; ++r) { const float a = scr[crow(r, hi)]; o0[r] *= a; o1[r] *= a; }
        bf16x8 pa[4];
#pragma unroll
        for (int s = 0; s < 2; ++s) {
            pa[s] = __builtin_bit_cast(bf16x8, make_uint4(cvtpk(p0[8 * s + 0], p0[8 * s + 1]), cvtpk(p0[8 * s + 2], p0[8 * s + 3]), cvtpk(p0[8 * s + 4], p0[8 * s + 5]), cvtpk(p0[8 * s + 6], p0[8 * s + 7])));
            pa[2 + s] = __builtin_bit_cast(bf16x8, make_uint4(cvtpk(p1[8 * s + 0], p1[8 * s + 1]), cvtpk(p1[8 * s + 2], p1[8 * s + 3]), cvtpk(p1[8 * s + 4], p1[8 * s + 5]), cvtpk(p1[8 * s + 6], p1[8 * s + 7])));
        }
#pragma unroll
        for (int ks = 0; ks < 4; ++ks) {
            const LAS unsigned char* vb = vt + ks * 16 * 128 + trow;
            const s16x4 a0 = vtr(vb), a1 = vtr(vb + 8 * 128), b0 = vtr(vb + 64), b1 = vtr(vb + 8 * 128 + 64);
            const bf16x8 v0 = (bf16x8){a0[0], a0[1], a0[2], a0[3], a1[0], a1[1], a1[2], a1[3]}, v1 = (bf16x8){b0[0], b0[1], b0[2], b0[3], b1[0], b1[1], b1[2], b1[3]};
            o0 = __builtin_amdgcn_mfma_f32_32x32x16_bf16(pa[ks], v0, o0, 0, 0, 0);
            o1 = __builtin_amdgcn_mfma_f32_32x32x16_bf16(pa[ks], v1, o1, 0, 0, 0);
        }
    }
    l_out = l;
}
__device__ __forceinline__ void attn_unit(LAS unsigned char* ldsp, int unit, const bf16_t* __restrict__ proj, const float* __restrict__ rel_bias, const float* __restrict__ gnorm, bf16_t* ymix) {
    int tid_ = threadIdx.x; asm volatile("" : "+v"(tid_));
    const int tid = tid_, lane = tid & 63, h = __builtin_amdgcn_readfirstlane(tid >> 6), r32 = lane & 31, hi = lane >> 5;
    const int b = unit >> 5, n = unit & 31;
    LAS float* tbl = (LAS float*)(ldsp + ATT_TBL);
    __syncthreads();
    for (int i = tid; i < 8 * 257; i += NTHREADS) { const int e = i / 257, k = i - e * 257; tbl[e * 260 + k] = rel_bias[k * 8 + e] * LOG2E; }
    __syncthreads();
    LAS unsigned char* vt = ldsp + h * ATT_WAVE_BYTES;
    LAS float* scr = (LAS float*)(ldsp + ATT_SCR) + h * 64;
    LAS float* ssq = (LAS float*)(ldsp + ATT_SSQ);
    f32x16 oA0, oA1, oB0, oB1; float lA, lB;
    attn_qblock(oA0, oA1, lA, 0, b, n, h, lane, vt, scr, tbl + h * 260, proj);
    attn_qblock(oB0, oB1, lB, 1, b, n, h, lane, vt, scr, tbl + h * 260, proj);
    LAS float* ost = (LAS float*)vt;
    if (hi == 0) { scr[r32] = 1.f / lA; scr[32 + r32] = 1.f / lB; }
#pragma unroll
    for (int r = 0; r < 16; ++r) {
        const int qa = crow(r, hi), qbq = 32 + qa; const float ia = scr[qa], ib = scr[qbq];
        ost[qa * 64 + (r32 ^ qa)] = oA0[r] * ia; ost[qa * 64 + ((32 + r32) ^ qa)] = oA1[r] * ia;
        ost[qbq * 64 + (r32 ^ qbq)] = oB0[r] * ib; ost[qbq * 64 + ((32 + r32) ^ qbq)] = oB1[r] * ib;
    }
    float v[64]; float s = 0.f;
#pragma unroll
    for (int d = 0; d < 64; ++d) { v[d] = ost[lane * 64 + (d ^ lane)]; s += v[d] * v[d]; }
    ssq[h * 64 + lane] = s;
    __syncthreads();
    float tot = 0.f;
#pragma unroll
    for (int e = 0; e < 8; ++e) tot += ssq[e * 64 + lane];
    const float rstd = rsqrtf(tot * (1.f / AW) + RMS_EPS);
    const float* gp = gnorm + h * 64;
    bf16_t* op = ymix + ((size_t)b * SEQ + n * CHUNK + lane) * D_MODEL + RW + h * 64;
#pragma unroll
    for (int d = 0; d < 64; d += 8) {
        const float4 g0 = *(const float4*)(gp + d), g1 = *(const float4*)(gp + d + 4);
        uint4 o; o.x = pk2(v[d] * rstd * g0.x, v[d + 1] * rstd * g0.y); o.y = pk2(v[d + 2] * rstd * g0.z, v[d + 3] * rstd * g0.w);
        o.z = pk2(v[d + 4] * rstd * g1.x, v[d + 5] * rstd * g1.y); o.w = pk2(v[d + 6] * rstd * g1.z, v[d + 7] * rstd * g1.w);
        *(uint4*)(op + d) = o;
    }
}
constexpr int R1_RS = 72, R1_RSB = R1_RS * 2;
constexpr int R1_MAT = 64 * R1_RSB;
constexpr int R1_SGRSB = 136 * 2;
constexpr int R1_X = 0;
constexpr int R1_TW = R1_X, R1_AD = R1_X + R1_MAT, R1_SG = R1_X + 2 * R1_MAT;
constexpr int R1_MAB = R1_X, R1_MAK = R1_X + R1_MAT, R1_NRB = R1_X + 2 * R1_MAT, R1_NRK = R1_X + 3 * R1_MAT;
constexpr int R1_Y = R1_X + 4 * R1_MAT;
constexpr int R1_FRS = 68;
constexpr int R1_WL = R1_Y, R1_AL = R1_Y + 64 * R1_FRS * 4;
constexpr int R1_Z = R1_Y + 2 * 64 * R1_FRS * 4;
constexpr int R1_AH = R1_Z, R1_BH = R1_Z + R1_MAT, R1_KH = R1_Z + 2 * R1_MAT, R1_RH = R1_Z + 3 * R1_MAT, R1_BTT = R1_Z + 4 * R1_MAT, R1_KTT = R1_Z + 5 * R1_MAT, R1_VT = R1_Z + 6 * R1_MAT;
constexpr int R1_TII = R1_Z + 7 * R1_MAT;
constexpr int R1_TIIRSB = 48;
constexpr int R1_MD = R1_TII + 4 * 16 * R1_TIIRSB;
constexpr int R1_TOT = R1_MD + 4 * 16 * 17 * 4;
constexpr int R1_GC = R1_TOT + 8 * 64 * 4;
constexpr int R1_LDS = R1_GC + 256;
struct RwkvW { const float *mu, *w0, *a0, *k_k, *k_a, *r_k; const bf16_t *w2T, *a2T, *g2T; };
struct RwkvChunkOut { bf16_t *Gp, *Qp, *HT, *ZT, *gate; float* bonus; unsigned* dbg; };
typedef unsigned u2v __attribute__((ext_vector_type(2)));
__device__ __forceinline__ bf16x8 mk8(u2v a, u2v b) { return __builtin_bit_cast(bf16x8, (v4u){a.x, a.y, b.x, b.y}); }
__device__ __forceinline__ bf16x8 packx(const f32x4& a, const f32x4& b) { return __builtin_bit_cast(bf16x8, (v4u){cvtpk(a[0], a[1]), cvtpk(a[2], a[3]), cvtpk(b[0], b[1]), cvtpk(b[2], b[3])}); }
#define MFMA16(a, b, c) __builtin_amdgcn_mfma_f32_16x16x32_bf16((a), (b), (c), 0, 0, 0)
__device__ __forceinline__ void rwkv_chunk_unit(LAS unsigned char* lds, int unit, const bf16_t* __restrict__ proj, const RwkvW& W0, const RwkvChunkOut& O) {
    int tid_ = threadIdx.x; asm volatile("" : "+v"(tid_));
    const int tid = tid_, lane = tid & 63, w = __builtin_amdgcn_readfirstlane(tid >> 6), li = lane & 15, g = lane >> 4;
    const int c = unit & 31, h = (unit >> 5) & 7, b = unit >> 8;
    const int tk = tid >> 3, sub = tid & 7;
    RwkvW W = W0;
    asm volatile("" : "+s"(W.mu), "+s"(W.w0), "+s"(W.a0), "+s"(W.k_k), "+s"(W.k_a), "+s"(W.r_k), "+s"(W.w2T), "+s"(W.a2T), "+s"(W.g2T));
    const size_t row = (size_t)b * SEQ + c * CHUNK + tk;
    const f32x4 z4 = {0.f, 0.f, 0.f, 0.f};
#define LDF(base, rsb, row0, k0) (*(const LAS bf16x8*)(lds + (base) + ((row0) + li) * (rsb) + ((k0) + 8 * g) * 2))
#define LDP(base, row0, pair) mk8(*(const LAS u2v*)(lds + (base) + ((row0) + li) * R1_RSB + (32 * (pair) + 4 * g) * 2), *(const LAS u2v*)(lds + (base) + ((row0) + li) * R1_RSB + (32 * (pair) + 16 + 4 * g) * 2))
    __syncthreads();
    float rr[8], kv[8], vv[8];
    {
        const bf16_t* pr = proj + row * IN_COLS; const bool has_prev = (c * CHUNK + tk) > 0; const bf16_t* pp = pr - IN_COLS;
        auto ld8 = [&](int col, float (&o)[8]) {
            const uint4 cu = *(const uint4*)(pr + col); uint4 pu = make_uint4(0, 0, 0, 0); if (has_prev) pu = *(const uint4*)(pp + col);
            const float4 m0 = *(const float4*)(W.mu + col), m1 = *(const float4*)(W.mu + col + 4);
            const unsigned cw[4] = {cu.x, cu.y, cu.z, cu.w}, pw[4] = {pu.x, pu.y, pu.z, pu.w}; const float mm[8] = {m0.x, m0.y, m0.z, m0.w, m1.x, m1.y, m1.z, m1.w};
#pragma unroll
            for (int i = 0; i < 4; ++i) { const float c0 = bf2f(cw[i] & 0xffffu), c1 = bf2f(cw[i] >> 16), p0 = bf2f(pw[i] & 0xffffu), p1 = bf2f(pw[i] >> 16);
                o[2 * i] = c0 + mm[2 * i] * (p0 - c0); o[2 * i + 1] = c1 + mm[2 * i + 1] * (p1 - c1); }
        };
        float t8[8];
        ld8(C_WD + sub * 8, t8);
        *(LAS v4u*)(lds + R1_TW + tk * R1_RSB + sub * 16) = (v4u){pk2(tanhf(t8[0]), tanhf(t8[1])), pk2(tanhf(t8[2]), tanhf(t8[3])), pk2(tanhf(t8[4]), tanhf(t8[5])), pk2(tanhf(t8[6]), tanhf(t8[7]))};
        ld8(C_AD + sub * 8, t8);
        *(LAS v4u*)(lds + R1_AD + tk * R1_RSB + sub * 16) = (v4u){pk2(t8[0], t8[1]), pk2(t8[2], t8[3]), pk2(t8[4], t8[5]), pk2(t8[6], t8[7])};
#pragma unroll
        for (int q = 0; q < 2; ++q) {
            ld8(C_GD + sub * 16 + q * 8, t8);
            *(LAS v4u*)(lds + R1_SG + tk * R1_SGRSB + sub * 32 + q * 16) = (v4u){pk2(sigmoidf_(t8[0]), sigmoidf_(t8[1])), pk2(sigmoidf_(t8[2]), sigmoidf_(t8[3])), pk2(sigmoidf_(t8[4]), sigmoidf_(t8[5])), pk2(sigmoidf_(t8[6]), sigmoidf_(t8[7]))};
        }
        ld8(C_R + h * 64 + sub * 8, rr); ld8(C_K + h * 64 + sub * 8, kv); ld8(C_V + h * 64 + sub * 8, vv);
#if defined(DBG_RWKV) && DBG_RWKV == 14
        {
            float n0 = 0.f, n1 = 0.f;
            for (int q = 0; q < 2; ++q) { ld8(C_GD + sub * 16 + q * 8, t8); for (int i = 0; i < 8; ++i) { if (!(fabsf(t8[i]) < 1e30f)) n0 += 1.f; else if (!(fabsf(sigmoidf_(t8[i])) < 1e30f)) n1 += 1.f; } }
            n0 = wave_sum(n0); n1 = wave_sum(n1);
            if (lane == 0 && h == 0) { atomicAdd((float*)(O.dbg + 528), n0); atomicAdd((float*)(O.dbg + 529), n1); }
        }
#endif
    }
    __syncthreads();
#if defined(DBG_RWKV) && DBG_RWKV == 14
    {
        float n2 = 0.f;
        for (int q = 0; q < 2; ++q) { const v4u u = *(const LAS v4u*)(lds + R1_SG + tk * R1_SGRSB + sub * 32 + q * 16); const unsigned w_[4] = {u.x, u.y, u.z, u.w};
            for (int i = 0; i < 4; ++i) { if ((w_[i] & 0x7f80u) == 0x7f80u) n2 += 1.f; if ((w_[i] & 0x7f800000u) == 0x7f800000u) n2 += 1.f; } }
        n2 = wave_sum(n2);
        if (lane == 0 && h == 0) atomicAdd((float*)(O.dbg + 530), n2);
    }
#endif
    {
        const int mb = w >> 1, nb0 = 2 * (w & 1);
        const bf16_t* w2r = W.w2T + (size_t)(h * 64 + 16 * mb + li) * 64 + 8 * g; const bf16_t* a2r = W.a2T + (size_t)(h * 64 + 16 * mb + li) * 64 + 8 * g;
        const bf16_t* g2r = W.g2T + (size_t)(h * 64 + 16 * mb + li) * 128 + 8 * g;
        bf16x8 wa[2], aa[2], ga[4];
#pragma unroll
        for (int ks = 0; ks < 2; ++ks) { wa[ks] = *(const bf16x8*)(w2r + 32 * ks); aa[ks] = *(const bf16x8*)(a2r + 32 * ks); }
#pragma unroll
        for (int ks = 0; ks < 4; ++ks) ga[ks] = *(const bf16x8*)(g2r + 32 * ks);
#pragma unroll
        for (int q = 0; q < 2; ++q) {
            const int nb = nb0 + q;
            f32x4 aw = z4, a_ = z4, ag = z4;
#pragma unroll
            for (int ks = 0; ks < 2; ++ks) { aw = MFMA16(wa[ks], LDF(R1_TW, R1_RSB, 16 * nb, 32 * ks), aw); a_ = MFMA16(aa[ks], LDF(R1_AD, R1_RSB, 16 * nb, 32 * ks), a_); }
#pragma unroll
            for (int ks = 0; ks < 4; ++ks) ag = MFMA16(ga[ks], LDF(R1_SG, R1_SGRSB, 16 * nb, 32 * ks), ag);
            const int t = 16 * nb + li, ch = 16 * mb + 4 * g;
            *(LAS f32x4*)(lds + R1_WL + (t * R1_FRS + ch) * 4) = aw;
            *(LAS f32x4*)(lds + R1_AL + (t * R1_FRS + ch) * 4) = a_;
            *(uint2*)(O.gate + ((size_t)b * SEQ + c * CHUNK + t) * RW + h * 64 + ch) = make_uint2(cvtpk(ag[0], ag[1]), cvtpk(ag[2], ag[3]));
#if defined(DBG_RWKV) && (DBG_RWKV == 12 || DBG_RWKV == 13)
            {
                const bf16x8 ones = __builtin_bit_cast(bf16x8, (v4u){0x3f803f80u, 0x3f803f80u, 0x3f803f80u, 0x3f803f80u});
                f32x4 t1 = z4, t2 = z4;
                for (int ks = 0; ks < 4; ++ks) { t1 = MFMA16(ones, LDF(R1_SG, R1_SGRSB, 16 * nb, 32 * ks), t1); t2 = MFMA16(ga[ks], ones, t2); }
                const size_t eo = ((size_t)b * SEQ + c * CHUNK + t) * RW + h * 64 + ch;
                *(uint2*)(O.Gp + eo) = make_uint2(cvtpk(t1[0], t1[1]), cvtpk(t1[2], t1[3]));
                *(uint2*)(O.Qp + eo) = make_uint2(cvtpk(t2[0], t2[1]), cvtpk(t2[2], t2[3]));
                *(uint2*)(O.HT + eo) = make_uint2(cvtpk(aw[0], aw[1]), cvtpk(aw[2], aw[3]));
            }
#endif
        }
    }
    __syncthreads();
    float ld_[8], av[8], kk[8], kp[8], Lc[8];
    {
        const int c0 = h * 64 + sub * 8;
        const f32x4 wl0 = *(const LAS f32x4*)(lds + R1_WL + (tk * R1_FRS + sub * 8) * 4), wl1 = *(const LAS f32x4*)(lds + R1_WL + (tk * R1_FRS + sub * 8 + 4) * 4);
        const f32x4 al0 = *(const LAS f32x4*)(lds + R1_AL + (tk * R1_FRS + sub * 8) * 4), al1 = *(const LAS f32x4*)(lds + R1_AL + (tk * R1_FRS + sub * 8 + 4) * 4);
        const float wl[8] = {wl0[0], wl0[1], wl0[2], wl0[3], wl1[0], wl1[1], wl1[2], wl1[3]}, al[8] = {al0[0], al0[1], al0[2], al0[3], al1[0], al1[1], al1[2], al1[3]};
        float ss = 0.f, bon = 0.f;
#pragma unroll
        for (int i = 0; i < 8; ++i) {
            const float xx = -(wl[i] + W.w0[c0 + i]); const float sp = (xx > 20.f) ? xx : __logf(1.f + __expf(xx));
            ld_[i] = -__expf(-sp - 0.5f);
            av[i] = sigmoidf_(al[i] + W.a0[c0 + i]);
            kk[i] = kv[i] * W.k_k[c0 + i]; ss += kk[i] * kk[i];
            kp[i] = kv[i] * (1.f + (av[i] - 1.f) * W.k_a[c0 + i]);
            bon += rr[i] * kp[i] * W.r_k[c0 + i];
        }
        ss += __shfl_xor(ss, 1); ss += __shfl_xor(ss, 2); ss += __shfl_xor(ss, 4);
        bon += __shfl_xor(bon, 1); bon += __shfl_xor(bon, 2); bon += __shfl_xor(bon, 4);
        const float inv = 1.f / fmaxf(sqrtf(ss), 1e-12f);
#pragma unroll
        for (int i = 0; i < 8; ++i) kk[i] *= inv;
        if (sub == 0) O.bonus[row * NH + h] = bon;
        const int tl = lane >> 3;
#pragma unroll
        for (int i = 0; i < 8; ++i) {
            float x = ld_[i];
            float y = __shfl_up(x, 8); if (tl >= 1) x += y;
            y = __shfl_up(x, 16); if (tl >= 2) x += y;
            y = __shfl_up(x, 32); if (tl >= 4) x += y;
            Lc[i] = x;
        }
        if (tl == 7) { *(LAS f32x4*)(lds + R1_TOT + (w * 64 + sub * 8) * 4) = (f32x4){Lc[0], Lc[1], Lc[2], Lc[3]}; *(LAS f32x4*)(lds + R1_TOT + (w * 64 + sub * 8 + 4) * 4) = (f32x4){Lc[4], Lc[5], Lc[6], Lc[7]}; }
    }
    __syncthreads();
    {
        float off[8], tot[8];
#pragma unroll
        for (int i = 0; i < 8; ++i) { off[i] = 0.f; tot[i] = 0.f; }
#pragma unroll
        for (int ww = 0; ww < 8; ++ww) {
            const f32x4 t0 = *(const LAS f32x4*)(lds + R1_TOT + (ww * 64 + sub * 8) * 4), t1 = *(const LAS f32x4*)(lds + R1_TOT + (ww * 64 + sub * 8 + 4) * 4);
            const float tt[8] = {t0[0], t0[1], t0[2], t0[3], t1[0], t1[1], t1[2], t1[3]};
#pragma unroll
            for (int i = 0; i < 8; ++i) { tot[i] += tt[i]; if (ww < w) off[i] += tt[i]; }
        }
        float ah[8], bh[8], kh[8], rh[8], bt[8], kt[8];
#pragma unroll
        for (int i = 0; i < 8; ++i) {
            const float L = Lc[i] + off[i];
            const float eL = __expf(L), eLx = __expf(L - ld_[i]), enL = __expf(-L), eCL = __expf(tot[i] - L);
            const float bb = kk[i] * av[i];
            ah[i] = -kk[i] * eLx; bh[i] = bb * enL; kh[i] = kp[i] * enL; rh[i] = rr[i] * eL; bt[i] = bb * eCL; kt[i] = kp[i] * eCL;
        }
        *(LAS v4u*)(lds + R1_AH + tk * R1_RSB + sub * 16) = (v4u){pk2(ah[0], ah[1]), pk2(ah[2], ah[3]), pk2(ah[4], ah[5]), pk2(ah[6], ah[7])};
        *(LAS v4u*)(lds + R1_BH + tk * R1_RSB + sub * 16) = (v4u){pk2(bh[0], bh[1]), pk2(bh[2], bh[3]), pk2(bh[4], bh[5]), pk2(bh[6], bh[7])};
        *(LAS v4u*)(lds + R1_KH + tk * R1_RSB + sub * 16) = (v4u){pk2(kh[0], kh[1]), pk2(kh[2], kh[3]), pk2(kh[4], kh[5]), pk2(kh[6], kh[7])};
        *(LAS v4u*)(lds + R1_RH + tk * R1_RSB + sub * 16) = (v4u){pk2(rh[0], rh[1]), pk2(rh[2], rh[3]), pk2(rh[4], rh[5]), pk2(rh[6], rh[7])};
#pragma unroll
        for (int i = 0; i < 8; ++i) {
            const int chn = sub * 8 + i;
            *(LAS unsigned short*)(lds + R1_BTT + chn * R1_RSB + tk * 2) = (unsigned short)f2bf(bt[i]);
            *(LAS unsigned short*)(lds + R1_KTT + chn * R1_RSB + tk * 2) = (unsigned short)f2bf(kt[i]);
            *(LAS unsigned short*)(lds + R1_VT + chn * R1_RSB + tk * 2) = (unsigned short)f2bf(vv[i]);
        }
        if (tk == 63) {
#pragma unroll
            for (int i = 0; i < 8; ++i) *(LAS float*)(lds + R1_GC + (sub * 8 + i) * 4) = __expf(tot[i]);
        }
    }
    __syncthreads();
    {
        const int mb = w >> 1, nb0 = 2 * (w & 1);
        const bf16x8 fa0 = LDF(R1_AH, R1_RSB, 16 * mb, 0), fa1 = LDF(R1_AH, R1_RSB, 16 * mb, 32), fr0 = LDF(R1_RH, R1_RSB, 16 * mb, 0), fr1 = LDF(R1_RH, R1_RSB, 16 * mb, 32);
#pragma unroll
        for (int q = 0; q < 2; ++q) {
            const int nb = nb0 + q;
            f32x4 mab = z4, mak = z4, nrb = z4, nrk = z4;
            if (nb <= mb) {
                const bf16x8 fb0 = LDF(R1_BH, R1_RSB, 16 * nb, 0), fb1 = LDF(R1_BH, R1_RSB, 16 * nb, 32), fk0 = LDF(R1_KH, R1_RSB, 16 * nb, 0), fk1 = LDF(R1_KH, R1_RSB, 16 * nb, 32);
                mab = MFMA16(fa0, fb0, mab); mab = MFMA16(fa1, fb1, mab); mak = MFMA16(fa0, fk0, mak); mak = MFMA16(fa1, fk1, mak);
                nrb = MFMA16(fr0, fb0, nrb); nrb = MFMA16(fr1, fb1, nrb); nrk = MFMA16(fr0, fk0, nrk); nrk = MFMA16(fr1, fk1, nrk);
            }
            const int s = 16 * nb + li;
#pragma unroll
            for (int r = 0; r < 4; ++r) {
                const int t = 16 * mb + 4 * g + r; const bool lo = s < t, le = s <= t;
                const float m1 = lo ? mab[r] : 0.f, m2 = lo ? mak[r] : 0.f, n1 = le ? nrb[r] : 0.f, n2 = le ? nrk[r] : 0.f;
                *(LAS unsigned short*)(lds + R1_MAB + t * R1_RSB + s * 2) = (unsigned short)f2bf(m1);
                *(LAS unsigned short*)(lds + R1_MAK + t * R1_RSB + s * 2) = (unsigned short)f2bf(m2);
                *(LAS unsigned short*)(lds + R1_NRB + t * R1_RSB + s * 2) = (unsigned short)f2bf(n1);
                *(LAS unsigned short*)(lds + R1_NRK + t * R1_RSB + s * 2) = (unsigned short)f2bf(n2);
                if (nb == mb) *(LAS float*)(lds + R1_MD + ((mb * 16 + 4 * g + r) * 17 + li) * 4) = m1;
            }
        }
    }
    __syncthreads();
    f32x4 acc[4];
    if (w == 0) {
        float T[16];
        const LAS float* md = (const LAS float*)(lds + R1_MD) + g * 16 * 17;
#pragma unroll
        for (int r = 0; r < 16; ++r) {
            float a = (r == li) ? 1.f : 0.f;
#pragma unroll
            for (int s = 0; s < r; ++s) a += md[r * 17 + s] * T[s];
            T[r] = a;
            *(LAS unsigned short*)(lds + R1_TII + (g * 16 + r) * R1_TIIRSB + li * 2) = (unsigned short)f2bf(a);
        }
    }
    if (w >= 4) {
        const int vb = w - 4;
#pragma unroll
        for (int mb = 0; mb < 4; ++mb) { acc[mb] = z4;
#pragma unroll
            for (int ks = 0; ks < 2; ++ks) acc[mb] = MFMA16(LDF(R1_MAK, R1_RSB, 16 * mb, 32 * ks), LDF(R1_VT, R1_RSB, 16 * vb, 32 * ks), acc[mb]); }
    } else {
#pragma unroll
        for (int mb = 0; mb < 4; ++mb)
#pragma unroll
            for (int r = 0; r < 4; ++r) acc[mb][r] = bf2f(*(const LAS unsigned short*)(lds + R1_AH + (16 * mb + 4 * g + r) * R1_RSB + (16 * w + li) * 2));
    }
    __syncthreads();
    f32x4 X0, X1, X2, X3;
    {
#define LDT(i) mk8(*(const LAS u2v*)(lds + R1_TII + ((i) * 16 + li) * R1_TIIRSB + 8 * g), (u2v){0u, 0u})
#define LDM1(i, j) mk8(*(const LAS u2v*)(lds + R1_MAB + (16 * (i) + li) * R1_RSB + (16 * (j) + 4 * g) * 2), (u2v){0u, 0u})
        X0 = MFMA16(LDT(0), packx(acc[0], z4), z4);
        f32x4 a1 = MFMA16(LDM1(1, 0), packx(X0, z4), acc[1]);
        X1 = MFMA16(LDT(1), packx(a1, z4), z4);
        f32x4 a2 = MFMA16(LDP(R1_MAB, 32, 0), packx(X0, X1), acc[2]);
        X2 = MFMA16(LDT(2), packx(a2, z4), z4);
        f32x4 a3 = MFMA16(LDP(R1_MAB, 48, 0), packx(X0, X1), acc[3]);
        a3 = MFMA16(LDM1(3, 2), packx(X2, z4), a3);
        X3 = MFMA16(LDT(3), packx(a3, z4), z4);
    }
    const bf16x8 x01 = packx(X0, X1), x23 = packx(X2, X3);
#if defined(DBG_RWKV) && (DBG_RWKV == 12 || DBG_RWKV == 13)
    return;
#endif
    const size_t ub = (size_t)unit * 4096;
    if (w < 4) {
        const int kb = w, pos = 32 * (kb >> 1) + 8 * g + 4 * (kb & 1);
#pragma unroll
        for (int nb = 0; nb < 4; ++nb) {
            f32x4 ag = z4;
            if (nb == kb) {
#pragma unroll
                for (int r = 0; r < 4; ++r) if (li == 4 * g + r) ag[r] = *(const LAS float*)(lds + R1_GC + (16 * kb + 4 * g + r) * 4);
            }
            ag = MFMA16(x01, LDP(R1_BTT, 16 * nb, 0), ag); ag = MFMA16(x23, LDP(R1_BTT, 16 * nb, 1), ag);
            *(uint2*)(O.Gp + ub + (size_t)(16 * nb + li) * 64 + pos) = make_uint2(cvtpk(ag[0], ag[1]), cvtpk(ag[2], ag[3]));
            const u2v rq = *(const LAS u2v*)(lds + R1_RH + (16 * nb + li) * R1_RSB + (16 * kb + 4 * g) * 2);
            f32x4 aq = {bf2f(rq.x & 0xffffu), bf2f(rq.x >> 16), bf2f(rq.y & 0xffffu), bf2f(rq.y >> 16)};
            aq = MFMA16(x01, LDP(R1_NRB, 16 * nb, 0), aq); aq = MFMA16(x23, LDP(R1_NRB, 16 * nb, 1), aq);
            *(uint2*)(O.Qp + ub + (size_t)(16 * nb + li) * 64 + pos) = make_uint2(cvtpk(aq[0], aq[1]), cvtpk(aq[2], aq[3]));
        }
    } else {
        const int vb = w - 4;
        const bf16x8 fv0 = LDF(R1_VT, R1_RSB, 16 * vb, 0), fv1 = LDF(R1_VT, R1_RSB, 16 * vb, 32);
#pragma unroll
        for (int mb = 0; mb < 4; ++mb) {
            f32x4 az = z4;
            az = MFMA16(LDP(R1_NRB, 16 * mb, 0), x01, az); az = MFMA16(LDP(R1_NRB, 16 * mb, 1), x23, az);
            az = MFMA16(LDF(R1_NRK, R1_RSB, 16 * mb, 0), fv0, az); az = MFMA16(LDF(R1_NRK, R1_RSB, 16 * mb, 32), fv1, az);
            *(uint2*)(O.ZT + ub + (size_t)(16 * vb + li) * 64 + 16 * mb + 4 * g) = make_uint2(cvtpk(az[0], az[1]), cvtpk(az[2], az[3]));
            f32x4 ah_ = z4;
            ah_ = MFMA16(LDP(R1_BTT, 16 * mb, 0), x01, ah_); ah_ = MFMA16(LDP(R1_BTT, 16 * mb, 1), x23, ah_);
            ah_ = MFMA16(LDF(R1_KTT, R1_RSB, 16 * mb, 0), fv0, ah_); ah_ = MFMA16(LDF(R1_KTT, R1_RSB, 16 * mb, 32), fv1, ah_);
            *(uint2*)(O.HT + ub + (size_t)(16 * vb + li) * 64 + 16 * mb + 4 * g) = make_uint2(cvtpk(ah_[0], ah_[1]), cvtpk(ah_[2], ah_[3]));
        }
    }
#undef LDT
#undef LDM1
#undef LDF
#undef LDP
}
constexpr int R2_YRS = 65;
constexpr int R2_LDS = 2 * 64 * R2_YRS * 4;
struct RwkvScanIn { const bf16_t *Gp, *Qp, *HT, *ZT, *gate; const float* bonus; const float *mu, *ln_w, *ln_b; };
struct ChunkFrags { bf16x8 G[4][2], Q[4][2]; uint2 H[4], Z[4]; };
__device__ __forceinline__ void r2_load(ChunkFrags& F, const RwkvScanIn& I, size_t ub, int vb, int li, int g) {
#pragma unroll
    for (int mb = 0; mb < 4; ++mb) {
#pragma unroll
        for (int p = 0; p < 2; ++p) { F.G[mb][p] = *(const bf16x8*)(I.Gp + ub + (size_t)(16 * mb + li) * 64 + 32 * p + 8 * g); F.Q[mb][p] = *(const bf16x8*)(I.Qp + ub + (size_t)(16 * mb + li) * 64 + 32 * p + 8 * g); }
        F.H[mb] = *(const uint2*)(I.HT + ub + (size_t)(16 * vb + li) * 64 + 16 * mb + 4 * g);
        F.Z[mb] = *(const uint2*)(I.ZT + ub + (size_t)(16 * vb + li) * 64 + 16 * mb + 4 * g);
    }
}
__device__ __forceinline__ f32x4 bf4(uint2 u) { return (f32x4){bf2f(u.x & 0xffffu), bf2f(u.x >> 16), bf2f(u.y & 0xffffu), bf2f(u.y >> 16)}; }
__device__ __forceinline__ void r2_step(const ChunkFrags& F, f32x4 (&S)[4], bf16x8& s01, bf16x8& s23, LAS float* ybuf, int vb, int li, int g) {
    f32x4 Sn[4];
#pragma unroll
    for (int mb = 0; mb < 4; ++mb) {
        f32x4 y = bf4(F.Z[mb]);
        y = MFMA16(F.Q[mb][0], s01, y); y = MFMA16(F.Q[mb][1], s23, y);
#pragma unroll
        for (int r = 0; r < 4; ++r) ybuf[(16 * mb + 4 * g + r) * R2_YRS + 16 * vb + li] = y[r];
        f32x4 s = bf4(F.H[mb]);
        s = MFMA16(F.G[mb][0], s01, s); s = MFMA16(F.G[mb][1], s23, s);
        Sn[mb] = s;
    }
#pragma unroll
    for (int mb = 0; mb < 4; ++mb) S[mb] = Sn[mb];
    s01 = packx(S[0], S[1]); s23 = packx(S[2], S[3]);
}
__device__ __forceinline__ void r2_epilogue(const LAS float* ybuf, int et, size_t row, int h, bool has_prev, const bf16_t* __restrict__ proj, const RwkvScanIn& I, bf16_t* ymix) {
    const int t = et >> 2, q4 = et & 3, c0 = h * 64 + q4 * 16;
    const bf16_t* pr = proj + row * IN_COLS + C_V + c0;
    uint4 cu[2], pu[2], gu[2];
#pragma unroll
    for (int i = 0; i < 2; ++i) { cu[i] = *(const uint4*)(pr + 8 * i); pu[i] = make_uint4(0, 0, 0, 0); if (has_prev) pu[i] = *(const uint4*)(pr - IN_COLS + 8 * i); gu[i] = *(const uint4*)(I.gate + row * RW + c0 + 8 * i); }
    const float bon = I.bonus[row * NH + h];
    float y[16]; float s1 = 0.f;
#pragma unroll
    for (int i = 0; i < 16; ++i) { y[i] = ybuf[t * R2_YRS + q4 * 16 + i]; s1 += y[i]; }
    s1 += __shfl_xor(s1, 1); s1 += __shfl_xor(s1, 2);
    const float mean = s1 * (1.f / 64.f); float s2 = 0.f;
#pragma unroll
    for (int i = 0; i < 16; ++i) { const float d = y[i] - mean; s2 += d * d; }
    s2 += __shfl_xor(s2, 1); s2 += __shfl_xor(s2, 2);
    const float rstd = rsqrtf(s2 * (1.f / 64.f) + GN_EPS);
    unsigned ow[8];
#pragma unroll
    for (int i = 0; i < 2; ++i) {
        const unsigned cw[4] = {cu[i].x, cu[i].y, cu[i].z, cu[i].w}, pw[4] = {pu[i].x, pu[i].y, pu[i].z, pu[i].w}, gw_[4] = {gu[i].x, gu[i].y, gu[i].z, gu[i].w};
#pragma unroll
        for (int j = 0; j < 4; ++j) {
            float o2[2];
#pragma unroll
            for (int u = 0; u < 2; ++u) {
                const int ci = c0 + 8 * i + 2 * j + u, yi = 8 * i + 2 * j + u;
                const float cur = bf2f(u ? (cw[j] >> 16) : (cw[j] & 0xffffu)), prev = bf2f(u ? (pw[j] >> 16) : (pw[j] & 0xffffu)), gt = bf2f(u ? (gw_[j] >> 16) : (gw_[j] & 0xffffu));
                const float vsh = cur + I.mu[C_V + ci] * (prev - cur);
                o2[u] = ((y[yi] - mean) * rstd * I.ln_w[ci] + I.ln_b[ci] + bon * vsh) * gt;
            }
            ow[4 * i + j] = pk2(o2[0], o2[1]);
        }
    }
    *(uint4*)(ymix + row * D_MODEL + c0) = make_uint4(ow[0], ow[1], ow[2], ow[3]);
    *(uint4*)(ymix + row * D_MODEL + c0 + 8) = make_uint4(ow[4], ow[5], ow[6], ow[7]);
}
__device__ __forceinline__ void rwkv_scan_unit(LAS unsigned char* lds, int unit  , const bf16_t* __restrict__ proj, const RwkvScanIn& I0, bf16_t* ymix) {
    int tid_ = threadIdx.x; asm volatile("" : "+v"(tid_));
    const int tid = tid_, lane = tid & 63, w = __builtin_amdgcn_readfirstlane(tid >> 6), li = lane & 15, g = lane >> 4;
    const int b = unit >> 3, h = unit & 7;
    RwkvScanIn I = I0;
    asm volatile("" : "+s"(I.Gp), "+s"(I.Qp), "+s"(I.HT), "+s"(I.ZT), "+s"(I.gate), "+s"(I.bonus), "+s"(I.mu), "+s"(I.ln_w), "+s"(I.ln_b));
    LAS float* ybase = (LAS float*)lds;
    __syncthreads();
    if (w < 4) {
        const int vb = w;
        f32x4 S[4];
#pragma unroll
        for (int mb = 0; mb < 4; ++mb) S[mb] = (f32x4){0.f, 0.f, 0.f, 0.f};
        bf16x8 s01 = packx(S[0], S[1]), s23 = s01;
        const size_t ub0 = (size_t)unit * NCHUNK * 4096;
        ChunkFrags FA, FB;
        r2_load(FA, I, ub0, vb, li, g);
#pragma unroll 1
        for (int c = 0; c < NCHUNK; c += 2) {
            r2_load(FB, I, ub0 + (size_t)(c + 1) * 4096, vb, li, g);
            r2_step(FA, S, s01, s23, ybase, vb, li, g);
            __syncthreads();
            if (c + 2 < NCHUNK) r2_load(FA, I, ub0 + (size_t)(c + 2) * 4096, vb, li, g);
            r2_step(FB, S, s01, s23, ybase + 64 * R2_YRS, vb, li, g);
            __syncthreads();
        }
    } else {
        const int et = tid - 256;
#pragma unroll 1
        for (int c = 0; c < NCHUNK; ++c) {
            __syncthreads();
            const int tl = c * CHUNK + (et >> 2);
            r2_epilogue(ybase + (c & 1) * 64 * R2_YRS, et, (size_t)b * SEQ + tl, h, tl > 0, proj, I, ymix);
        }
    }
}
#ifdef DBG_RWKV
struct RwkvParams { const float *mu, *w0, *w2, *a0, *a2, *g2, *k_k, *k_a, *r_k, *ln_w, *ln_b; };
constexpr int RWKV_LDS = (7 * 4096 + 8192 + 64) * 4;
__device__ __forceinline__ void rwkv_naive_unit(float* sm, int unit, const bf16_t* __restrict__ proj, const RwkvParams& P0, bf16_t* ymix) {
    float* sR = sm; float* sDEC = sm + 4096; float* sKP = sm + 2 * 4096; float* sV = sm + 3 * 4096; float* sKK = sm + 4 * 4096; float* sKKA = sm + 5 * 4096; float* sG = sm + 6 * 4096;
    float* sST = sm + 7 * 4096;
    float* sBON = sST + 8192;
    int tid_ = threadIdx.x; asm volatile("" : "+v"(tid_));
    const int tid = tid_, b = unit >> 3, h = unit & 7;
    const int tk = tid >> 3, sub = tid & 7;
    float S[8];
#pragma unroll
    for (int i = 0; i < 8; ++i) S[i] = 0.f;
#pragma unroll 1
    for (int cb = 0; cb < NCHUNK; ++cb) {
        const int t0 = cb * CHUNK;
        RwkvParams P = P0;
        asm volatile("" : "+s"(P.mu), "+s"(P.w0), "+s"(P.w2), "+s"(P.a0), "+s"(P.a2), "+s"(P.g2));
        asm volatile("" : "+s"(P.k_k), "+s"(P.k_a), "+s"(P.r_k), "+s"(P.ln_w), "+s"(P.ln_b));
        const size_t row = (size_t)b * SEQ + t0 + tk;
        const bf16_t* pr = proj + row * IN_COLS;
        const bool has_prev = (t0 + tk) > 0;
        const bf16_t* pp = pr - IN_COLS;
        auto shifted = [&](int col) -> float { const float cur = bf2f(pr[col]); const float prev = has_prev ? bf2f(pp[col]) : 0.f; return cur + P.mu[col] * (prev - cur); };
#pragma unroll
        for (int i = 0; i < 8; ++i) { const int j = sub * 8 + i; sST[tk * 128 + j] = tanhf(shifted(C_WD + j)); }
        __syncthreads();
        float av[8];
        {
            float acc[8];
#pragma unroll
            for (int i = 0; i < 8; ++i) acc[i] = P.w0[h * 64 + sub * 8 + i];
#pragma unroll 2
            for (int j = 0; j < 64; ++j) { const float t = sST[tk * 128 + j]; const float* wr = P.w2 + (size_t)j * RW + h * 64 + sub * 8;
#pragma unroll
                for (int i = 0; i < 8; ++i) acc[i] += t * wr[i]; }
#pragma unroll
            for (int i = 0; i < 8; ++i) { const float xx = -acc[i]; const float sp = (xx > 20.f) ? xx : log1pf(__expf(xx)); const float w = -sp - 0.5f; sDEC[tk * 64 + sub * 8 + i] = __expf(-__expf(w)); }
        }
        __syncthreads();
#pragma unroll
        for (int i = 0; i < 8; ++i) { const int j = sub * 8 + i; sST[tk * 128 + j] = shifted(C_AD + j); }
        __syncthreads();
        {
            float acc[8];
#pragma unroll
            for (int i = 0; i < 8; ++i) acc[i] = P.a0[h * 64 + sub * 8 + i];
#pragma unroll 2
            for (int j = 0; j < 64; ++j) { const float t = sST[tk * 128 + j]; const float* wr = P.a2 + (size_t)j * RW + h * 64 + sub * 8;
#pragma unroll
                for (int i = 0; i < 8; ++i) acc[i] += t * wr[i]; }
#pragma unroll
            for (int i = 0; i < 8; ++i) av[i] = sigmoidf_(acc[i]);
        }
        __syncthreads();
#pragma unroll
        for (int i = 0; i < 16; ++i) { const int j = sub * 16 + i; sST[tk * 128 + j] = sigmoidf_(shifted(C_GD + j)); }
        __syncthreads();
        {
            float acc[8];
#pragma unroll
            for (int i = 0; i < 8; ++i) acc[i] = 0.f;
#pragma unroll 2
            for (int j = 0; j < 128; ++j) { const float t = sST[tk * 128 + j]; const float* wr = P.g2 + (size_t)j * RW + h * 64 + sub * 8;
#pragma unroll
                for (int i = 0; i < 8; ++i) acc[i] += t * wr[i]; }
#pragma unroll
            for (int i = 0; i < 8; ++i) sG[tk * 64 + sub * 8 + i] = acc[i];
        }
        {
            float rr[8], kv[8], vv[8], kk[8], kp[8]; float ss = 0.f, bon = 0.f;
#pragma unroll
            for (int i = 0; i < 8; ++i) {
                const int c = h * 64 + sub * 8 + i;
                rr[i] = shifted(C_R + c); kv[i] = shifted(C_K + c); vv[i] = shifted(C_V + c);
                kk[i] = kv[i] * P.k_k[c]; ss += kk[i] * kk[i];
                kp[i] = kv[i] * (1.f + (av[i] - 1.f) * P.k_a[c]);
                bon += rr[i] * kp[i] * P.r_k[c];
            }
            ss += __shfl_xor(ss, 1); ss += __shfl_xor(ss, 2); ss += __shfl_xor(ss, 4);
            bon += __shfl_xor(bon, 1); bon += __shfl_xor(bon, 2); bon += __shfl_xor(bon, 4);
            const float inv = 1.f / fmaxf(sqrtf(ss), 1e-12f);
#pragma unroll
            for (int i = 0; i < 8; ++i) {
                const int o = tk * 64 + sub * 8 + i; const float kn = kk[i] * inv;
                sR[o] = rr[i]; sKP[o] = kp[i]; sV[o] = vv[i]; sKK[o] = kn; sKKA[o] = kn * av[i];
            }
            if (sub == 0) sBON[tk] = bon;
        }
        __syncthreads();
#pragma unroll 1
        for (int t = 0; t < CHUNK; ++t) {
            const float* dk = sDEC + t * 64 + sub * 8; const float* kkp = sKK + t * 64 + sub * 8; const float* kap = sKKA + t * 64 + sub * 8;
            const float* kpp = sKP + t * 64 + sub * 8; const float* rp = sR + t * 64 + sub * 8;
            float sa = 0.f;
#pragma unroll
            for (int i = 0; i < 8; ++i) sa -= S[i] * kkp[i];
            sa += __shfl_xor(sa, 1); sa += __shfl_xor(sa, 2); sa += __shfl_xor(sa, 4);
            const float vt = sV[t * 64 + tk];
            float y = 0.f;
#pragma unroll
            for (int i = 0; i < 8; ++i) { S[i] = S[i] * dk[i] + sa * kap[i] + vt * kpp[i]; y += S[i] * rp[i]; }
            y += __shfl_xor(y, 1); y += __shfl_xor(y, 2); y += __shfl_xor(y, 4);
            if (sub == 0) sST[t * 64 + tk] = y;
        }
        __syncthreads();
        {
            float yv[8]; float s1 = 0.f;
#pragma unroll
            for (int i = 0; i < 8; ++i) { yv[i] = sST[tk * 64 + sub * 8 + i]; s1 += yv[i]; }
            s1 += __shfl_xor(s1, 1); s1 += __shfl_xor(s1, 2); s1 += __shfl_xor(s1, 4);
            const float mean = s1 * (1.f / 64.f); float s2 = 0.f;
#pragma unroll
            for (int i = 0; i < 8; ++i) { const float d = yv[i] - mean; s2 += d * d; }
            s2 += __shfl_xor(s2, 1); s2 += __shfl_xor(s2, 2); s2 += __shfl_xor(s2, 4);
            const float rstd = rsqrtf(s2 * (1.f / 64.f) + GN_EPS); const float bon = sBON[tk];
            unsigned pk[4];
#pragma unroll
            for (int i = 0; i < 8; i += 2) {
                float o[2];
#pragma unroll
                for (int u = 0; u < 2; ++u) { const int c = h * 64 + sub * 8 + i + u; const int o_ = tk * 64 + sub * 8 + i + u;
                    o[u] = ((yv[i + u] - mean) * rstd * P.ln_w[c] + P.ln_b[c] + bon * sV[o_]) * sG[o_]; }
                pk[i >> 1] = pk2(o[0], o[1]);
            }
            *(uint4*)(ymix + row * D_MODEL + h * 64 + sub * 8) = make_uint4(pk[0], pk[1], pk[2], pk[3]);
        }
        __syncthreads();
    }
}

#endif
constexpr int LDS_PHASE_BYTES = 150 * 1024;
constexpr int LDSCTL_OFF = LDS_PHASE_BYTES;
constexpr int LDS_BYTES = LDS_PHASE_BYTES + 1024;
#ifdef DBG_RWKV
static_assert(RWKV_LDS <= LDS_PHASE_BYTES, "dbg");
#endif
static_assert(R1_LDS <= LDS_PHASE_BYTES && R2_LDS <= LDS_PHASE_BYTES && pg8::STAGE_BYTES <= LDS_PHASE_BYTES && ATT_LDS <= LDS_PHASE_BYTES, "LDS map");

struct Args {
    const float* in[26]; float* out; unsigned char* ws;
};
static_assert(sizeof(Args) == 28 * 8, "Args has no padding");

__global__ void __launch_bounds__(NTHREADS, 2) mega_fwd(Args args) {
    extern __shared__ __attribute__((aligned(16))) unsigned char lds[];
    LAS unsigned char* ldsp = (LAS unsigned char*)lds;
    const int G = gridDim.x, bid = blockIdx.x;
#define IDS() int tid = threadIdx.x; asm volatile("" : "+v"(tid)); const int lane = tid & 63, wave = __builtin_amdgcn_readfirstlane(tid >> 6), gw = bid * NWAVES + wave, ngw = G * NWAVES; (void)lane; (void)gw; (void)ngw
    typedef const __attribute__((address_space(4))) Args* KArgs;
#define KA() ({ KArgs _p = (KArgs)__builtin_amdgcn_kernarg_segment_ptr(); asm volatile("" : "+s"(_p)); _p; })
#define IN(i) (KA()->in[i])
#define WSP(off) (KA()->ws + (off))
#define OUTP() (KA()->out)
    { IDS(); for (int u = tid; u < (LDS_BYTES - LDSCTL_OFF) / 4; u += NTHREADS) ((LAS unsigned*)(ldsp + LDSCTL_OFF))[u] = 0u; }
    __syncthreads();
    XcdBarrier bar = xcd_barrier_post((unsigned*)((gu32*)WSP(WS_CTL) + CW_BAR), (volatile LAS unsigned*)(ldsp + LDSCTL_OFF));
#define GRID_BAR() xcd_barrier(bar)
    enum { I_X = 0, I_NMG, I_WIN, I_MU, I_W0, I_W2, I_A0, I_A2, I_G2, I_KK, I_KA, I_RK, I_LNW, I_LNB, I_RELB, I_ANG, I_WOUT, I_NFG, I_FWG, I_FWU, I_FWD, I_ROUTER, I_MWG, I_MWU, I_MWD, I_NFINAL };

    {
        IDS();
        LAS float* scr = (LAS float*)(ldsp + wave * 16384);
        constexpr int I_IN = (D_MODEL / 64) * (IN_COLS / 32), I_OUT = (D_MODEL / 64) * (D_MODEL / 32), I_FG = (D_MODEL / 64) * (D_FF / 32), I_FD = (D_FF / 64) * (D_MODEL / 32);
        constexpr int I_MG = (D_MODEL / 64) * (D_FFE / 32), I_MD = (D_FFE / 64) * (D_MODEL / 32);
        constexpr int NITEMS = 2 * I_IN + 2 * I_OUT + 2 * I_FG + I_FD;
#pragma unroll 1
        for (int it = gw; it < NITEMS; it += ngw) {
            int r = it;
            if (r < 2 * I_IN) { const int l = r / I_IN; p0_transpose_item(IN(I_WIN) + (size_t)l * D_MODEL * IN_COLS, D_MODEL, IN_COLS, (bf16_t*)WSP(WS_WIN) + (size_t)l * IN_COLS * D_MODEL, 0, 1, scr, r % I_IN, lane); continue; } r -= 2 * I_IN;
            if (r < 2 * I_OUT) { const int l = r / I_OUT; p0_transpose_item(IN(I_WOUT) + (size_t)l * D_MODEL * D_MODEL, D_MODEL, D_MODEL, (bf16_t*)WSP(WS_WOUT) + (size_t)l * D_MODEL * D_MODEL, 0, 1, scr, r % I_OUT, lane); continue; } r -= 2 * I_OUT;
            if (r < I_FG) { p0_transpose_item(IN(I_FWG), D_MODEL, D_FF, (bf16_t*)WSP(WS_FGU), 0, 2, scr, r, lane); continue; } r -= I_FG;
            if (r < I_FG) { p0_transpose_item(IN(I_FWU), D_MODEL, D_FF, (bf16_t*)WSP(WS_FGU), 1, 2, scr, r, lane); continue; } r -= I_FG;
            p0_transpose_item(IN(I_FWD), D_FF, D_MODEL, (bf16_t*)WSP(WS_FDN), 0, 1, scr, r, lane);
        }
        {
            const int gt = bid * NTHREADS + tid, ngt = G * NTHREADS;
            const float* w2 = IN(I_W2); const float* a2 = IN(I_A2); const float* g2 = IN(I_G2);
            bf16_t* w2T = (bf16_t*)WSP(WS_LORA + LORA_W2T); bf16_t* a2T = (bf16_t*)WSP(WS_LORA + LORA_A2T); bf16_t* g2T = (bf16_t*)WSP(WS_LORA + LORA_G2T);
            for (int i = gt; i < 2 * 512 * 64; i += ngt) { const int l = i >> 15, r = i & 32767, ch = r >> 6, j = r & 63; w2T[i] = (bf16_t)f2bf(w2[l * 32768 + j * 512 + ch]); a2T[i] = (bf16_t)f2bf(a2[l * 32768 + j * 512 + ch]); }
            for (int i = gt; i < 2 * 512 * 128; i += ngt) { const int l = i >> 16, r = i & 65535, ch = r >> 7, j = r & 127; g2T[i] = (bf16_t)f2bf(g2[l * 65536 + j * 512 + ch]); }
        }
        { IDS(); norm_rows<0>(gw, ngw, lane, IN(I_X), IN(I_NMG), (bf16_t*)WSP(WS_XN), nullptr, nullptr, nullptr, nullptr); }
    }
    cg::this_grid().sync();

#pragma unroll 1
    for (int l = 0; l < 2; ++l) {
        {
            pg8::Gemm g{(bf16_t*)WSP(WS_XN), (bf16_t*)WSP(WS_WIN) + (size_t)l * IN_COLS * D_MODEL, TOK, IN_COLS, D_MODEL}; pg8::StaticOrder S; S.init(TOK, IN_COLS, G, bid);
            pg8::EpiBf16 E{(bf16_t*)WSP(WS_PROJ), IN_COLS};
            pg8::gemm_phase<pg8::EpiBf16, pg8::StaticOrder, true, true>(ldsp, g, S, E);
        }
        GRID_BAR();
        {
            RwkvW Wt{IN(I_MU) + l * SHIFT_COLS, IN(I_W0) + l * RW, IN(I_A0) + l * RW, IN(I_KK) + l * RW, IN(I_KA) + l * RW, IN(I_RK) + l * RW,
                     (const bf16_t*)WSP(WS_LORA + LORA_W2T) + (size_t)l * 512 * 64, (const bf16_t*)WSP(WS_LORA + LORA_A2T) + (size_t)l * 512 * 64, (const bf16_t*)WSP(WS_LORA + LORA_G2T) + (size_t)l * 512 * 128};
            RwkvChunkOut Oc{(bf16_t*)WSP(WS_GP), (bf16_t*)WSP(WS_QP), (bf16_t*)WSP(WS_HT), (bf16_t*)WSP(WS_ZT), (bf16_t*)WSP(WS_GATE), (float*)WSP(WS_BONUS), (unsigned*)WSP(WS_CTL)};
#pragma unroll 1
            for (int u = bid; u < BATCH * NH * NCHUNK; u += G) rwkv_chunk_unit(ldsp, u, (const bf16_t*)WSP(WS_PROJ), Wt, Oc);
        }
        GRID_BAR();
#if defined(DBG_RWKV) && DBG_RWKV >= 10 && DBG_RWKV != 14
        if (l == 0) {
            IDS();
            gu32* cw = (gu32*)WSP(WS_CTL);
#if DBG_RWKV == 10 || DBG_RWKV == 12 || DBG_RWKV == 13
            const bf16_t* arr[3] = {(const bf16_t*)WSP(WS_GP), (const bf16_t*)WSP(WS_QP), (const bf16_t*)WSP(WS_HT)};
#else
            const bf16_t* arr[3] = {(const bf16_t*)WSP(WS_ZT), (const bf16_t*)WSP(WS_GATE), (const bf16_t*)WSP(WS_GATE)};
#endif
            for (int k = 0; k < 3; ++k) {
                float n_ = 0.f;
#if DBG_RWKV == 13
                const int k2 = k; const int kk_ = 0;
#define k kk_
#endif
                for (size_t i = (size_t)(bid * NTHREADS + tid) * 8; i < (size_t)2048 * 4096; i += (size_t)G * NTHREADS * 8) {
                    const uint4 u = *(const uint4*)(arr[k] + i); const unsigned w_[4] = {u.x, u.y, u.z, u.w};
#if DBG_RWKV == 13
                    { const int tokrow = (int)(i / 512), tseq = tokrow & (SEQ - 1); const int cat = (tseq == 0) ? 0 : ((tseq & 63) == 0 ? 1 : 2);
                      for (int q = 0; q < 4; ++q) { if (k == 0 && cat == (int)k2) { if ((w_[q] & 0x7f80u) == 0x7f80u) n_ += 1.f; if ((w_[q] & 0x7f800000u) == 0x7f800000u) n_ += 1.f; } } }
#else
                    for (int q = 0; q < 4; ++q) { if ((w_[q] & 0x7f80u) == 0x7f80u) n_ += 1.f; if ((w_[q] & 0x7f800000u) == 0x7f800000u) n_ += 1.f; }
#endif
                }
#if DBG_RWKV == 11
                if (k == 2) { n_ = 0.f; const float* bo = (const float*)WSP(WS_BONUS); for (int i = bid * NTHREADS + tid; i < TOK * NH; i += G * NTHREADS) if (!(fabsf(bo[i]) < 1e30f)) n_ += 1.f; }
#endif
#if DBG_RWKV == 13
#undef k
#endif
                n_ = wave_sum(n_);
                if (lane == 0) atomicAdd((float*)(cw + 528 + k), n_);
            }
        }
#endif
        {
#pragma unroll 1
            for (int i = bid; i < BATCH * NCHUNK; i += G) {
                int au;
                if (i < BATCH * NH) {
                    RwkvScanIn Si{(const bf16_t*)WSP(WS_GP), (const bf16_t*)WSP(WS_QP), (const bf16_t*)WSP(WS_HT), (const bf16_t*)WSP(WS_ZT), (const bf16_t*)WSP(WS_GATE), (const float*)WSP(WS_BONUS),
                                  IN(I_MU) + l * SHIFT_COLS, IN(I_LNW) + l * RW, IN(I_LNB) + l * RW};
#ifdef DBG_RWKV
                    if (l == 0) {
                        RwkvParams Pn{IN(I_MU) + l * SHIFT_COLS, IN(I_W0) + l * RW, IN(I_W2) + (size_t)l * 64 * RW, IN(I_A0) + l * RW, IN(I_A2) + (size_t)l * 64 * RW, IN(I_G2) + (size_t)l * 128 * RW,
                                      IN(I_KK) + l * RW, IN(I_KA) + l * RW, IN(I_RK) + l * RW, IN(I_LNW) + l * RW, IN(I_LNB) + l * RW};
                        rwkv_scan_unit(ldsp, i, (const bf16_t*)WSP(WS_PROJ), Si, (bf16_t*)OUTP());
                        rwkv_naive_unit((float*)lds, i, (const bf16_t*)WSP(WS_PROJ), Pn, (bf16_t*)WSP(WS_XN));
                    } else {
                        RwkvParams Pn{IN(I_MU) + l * SHIFT_COLS, IN(I_W0) + l * RW, IN(I_W2) + (size_t)l * 64 * RW, IN(I_A0) + l * RW, IN(I_A2) + (size_t)l * 64 * RW, IN(I_G2) + (size_t)l * 128 * RW,
                                      IN(I_KK) + l * RW, IN(I_KA) + l * RW, IN(I_RK) + l * RW, IN(I_LNW) + l * RW, IN(I_LNB) + l * RW};
                        rwkv_naive_unit((float*)lds, i, (const bf16_t*)WSP(WS_PROJ), Pn, (bf16_t*)WSP(WS_XN));
                    }
#else
                    rwkv_scan_unit(ldsp, i, (const bf16_t*)WSP(WS_PROJ), Si, (bf16_t*)WSP(WS_XN));
#endif
                    au = (i >> 3) * NCHUNK + (i & 7);
                } else { const int j = i - BATCH * NH; au = (j / 24) * NCHUNK + 8 + (j % 24); }
                attn_unit(ldsp, au, (const bf16_t*)WSP(WS_PROJ), IN(I_RELB) + (size_t)l * 257 * 8, IN(I_ANG) + l * AW, (bf16_t*)WSP(WS_XN));
            }
        }
        GRID_BAR();
#ifdef DBG_RWKV
        if (l == 0) {
            IDS();
            const bf16_t* ya = (const bf16_t*)WSP(WS_XN); const bf16_t* yb = (const bf16_t*)OUTP();
            float se[3] = {0.f, 0.f, 0.f}, sy[3] = {0.f, 0.f, 0.f}, nf[3] = {0.f, 0.f, 0.f};
            for (int row = gw; row < TOK; row += ngw) {
                const int t = row & (SEQ - 1); const int rg = t < 64 ? 0 : (t < 128 ? 1 : 2);
                const uint4 ua = *(const uint4*)(ya + (size_t)row * D_MODEL + lane * 8), ub_ = *(const uint4*)(yb + (size_t)row * D_MODEL + lane * 8);
                const unsigned wa_[4] = {ua.x, ua.y, ua.z, ua.w}, wb_[4] = {ub_.x, ub_.y, ub_.z, ub_.w};
                float e = 0.f, y2 = 0.f, n_ = 0.f;
                for (int q = 0; q < 4; ++q) for (int u = 0; u < 2; ++u) {
                    const float a_ = bf2f(u ? wa_[q] >> 16 : wa_[q] & 0xffffu), b_ = bf2f(u ? wb_[q] >> 16 : wb_[q] & 0xffffu);
                    if (!(fabsf(b_) < 1e30f)) n_ += 1.f; else e += (a_ - b_) * (a_ - b_);
                    y2 += a_ * a_;
                }
                for (int k = 0; k < 3; ++k) if (k == rg) { se[k] += e; sy[k] += y2; nf[k] += n_; }
            }
            gu32* cw = (gu32*)WSP(WS_CTL);
            for (int k = 0; k < 3; ++k) { const float a_ = wave_sum(se[k]), b_ = wave_sum(sy[k]), c_ = wave_sum(nf[k]);
                if (lane == 0) { atomicAdd((float*)(cw + 512 + k), a_); atomicAdd((float*)(cw + 520 + k), b_); if (DBG_RWKV < 10) atomicAdd((float*)(cw + 528 + k), c_); } }
            GRID_BAR();
        }
#endif
        {
            pg8::Gemm g{(bf16_t*)WSP(WS_XN), (bf16_t*)WSP(WS_WOUT) + (size_t)l * D_MODEL * D_MODEL, TOK, D_MODEL, D_MODEL}; pg8::StaticOrder S; S.init(TOK, D_MODEL, G, bid);
            pg8::EpiRes E{(l == 0) ? IN(I_X) : (const float*)OUTP(), OUTP(), D_MODEL, nullptr, 0};
            pg8::gemm_phase<pg8::EpiRes, pg8::StaticOrder, true, true>(ldsp, g, S, E);
        }
        GRID_BAR();
        if (l == 0) {
            { IDS(); norm_rows<0>(gw, ngw, lane, OUTP(), IN(I_NFG), (bf16_t*)WSP(WS_XN), nullptr, nullptr, nullptr, nullptr); }
            GRID_BAR();
            {
                pg8::Gemm g{(bf16_t*)WSP(WS_XN), (bf16_t*)WSP(WS_FGU), TOK, 2 * D_FF, D_MODEL}; pg8::StaticOrder S; S.init(TOK, 2 * D_FF, G, bid);
                pg8::EpiSwiglu E{(bf16_t*)WSP(WS_PROJ), D_FF};
                pg8::gemm_phase<pg8::EpiSwiglu, pg8::StaticOrder, true, true>(ldsp, g, S, E);
            }
            GRID_BAR();
            {
                pg8::Gemm g{(bf16_t*)WSP(WS_PROJ), (bf16_t*)WSP(WS_FDN), TOK, D_MODEL, D_FF}; pg8::StaticOrder S; S.init(TOK, D_MODEL, G, bid);
                pg8::EpiRes E{OUTP(), OUTP(), D_MODEL, nullptr, 0};
                pg8::gemm_phase<pg8::EpiRes, pg8::StaticOrder, true, true>(ldsp, g, S, E);
            }
            GRID_BAR();
            { IDS(); norm_rows<0>(gw, ngw, lane, OUTP(), IN(I_NMG) + D_MODEL, (bf16_t*)WSP(WS_XN), nullptr, nullptr, nullptr, nullptr); }
            GRID_BAR();
        } else {
            { IDS(); norm_rows<1>(gw, ngw, lane, OUTP(), IN(I_NFG) + D_MODEL, (bf16_t*)WSP(WS_XN), nullptr, IN(I_ROUTER), (int*)WSP(WS_TAB + TAB_ROUTE_E), (float2*)WSP(WS_TAB + TAB_ROUTE_G)); }
            {
                IDS();
                LAS float* scr = (LAS float*)(ldsp + wave * 16384);
                constexpr int I_MG = (D_MODEL / 64) * (D_FFE / 32), I_MD = (D_FFE / 64) * (D_MODEL / 32);
#pragma unroll 1
                for (int it = gw; it < NE * (2 * I_MG + I_MD); it += ngw) {
                    const int e = it / (2 * I_MG + I_MD); int r = it - e * (2 * I_MG + I_MD);
                    if (r < I_MG) { p0_transpose_item(IN(I_MWG) + (size_t)e * D_MODEL * D_FFE, D_MODEL, D_FFE, (bf16_t*)WSP(WS_MGU) + (size_t)e * 2 * D_FFE * D_MODEL, 0, 2, scr, r, lane); continue; } r -= I_MG;
                    if (r < I_MG) { p0_transpose_item(IN(I_MWU) + (size_t)e * D_MODEL * D_FFE, D_MODEL, D_FFE, (bf16_t*)WSP(WS_MGU) + (size_t)e * 2 * D_FFE * D_MODEL, 1, 2, scr, r, lane); continue; } r -= I_MG;
                    p0_transpose_item(IN(I_MWD) + (size_t)e * D_FFE * D_MODEL, D_FFE, D_MODEL, (bf16_t*)WSP(WS_MDN) + (size_t)e * D_MODEL * D_FFE, 0, 1, scr, r, lane);
                }
            }
            GRID_BAR();
            {
                MoeTabs Tb{(int*)WSP(WS_TAB + TAB_ROUTE_E), (float2*)WSP(WS_TAB + TAB_ROUTE_G), (int2*)WSP(WS_TAB + TAB_POS), (int*)WSP(WS_TAB + TAB_ROWIDX), (float*)WSP(WS_TAB + TAB_GATEPOS), (int*)WSP(WS_TAB + TAB_SEGT)};
                moe_build_lists(ldsp, bid, G, Tb);
            }
            GRID_BAR();
            {
                pg8::Gemm g{(bf16_t*)WSP(WS_XN), (bf16_t*)WSP(WS_MGU), MOE_MAXROWS, 2 * D_FFE, D_MODEL};
                pg8::MoeOrder S{(const int*)WSP(WS_TAB + TAB_SEGT), 2 * D_FFE / 256, G, bid, SZ_MGU};
                pg8::EpiSwiglu E{(bf16_t*)WSP(WS_ACT2), D_FFE};
                pg8::gemm_phase<pg8::EpiSwiglu, pg8::MoeOrder, true, true, true>(ldsp, g, S, E, (const int*)WSP(WS_TAB + TAB_ROWIDX));
            }
            GRID_BAR();
            {
                pg8::Gemm g{(bf16_t*)WSP(WS_ACT2), (bf16_t*)WSP(WS_MDN), MOE_MAXROWS, D_MODEL, D_FFE};
                pg8::MoeOrder S{(const int*)WSP(WS_TAB + TAB_SEGT), D_MODEL / 256, G, bid, SZ_MDN};
                pg8::EpiSlot E{(bf16_t*)WSP(WS_SLOT), D_MODEL, (const float*)WSP(WS_TAB + TAB_GATEPOS)};
                pg8::gemm_phase<pg8::EpiSlot, pg8::MoeOrder, true, true>(ldsp, g, S, E);
            }
            GRID_BAR();
        }
    }
    { IDS(); norm_rows<3>(gw, ngw, lane, OUTP(), IN(I_NFINAL), nullptr, OUTP(), nullptr, nullptr, nullptr, (const bf16_t*)WSP(WS_SLOT), (const int2*)WSP(WS_TAB + TAB_POS)); }
#ifdef DBG_RWKV
    {
        IDS();
        const float* cw = (const float*)WSP(WS_CTL);
        const float wts[3] = {0.1f, 0.3f, 0.9f}; float diag = 0.f;
        for (int k = 0; k < 3; ++k) { const float se = __hip_atomic_load(cw + 512 + k, RLX_AGENT), sy = __hip_atomic_load(cw + 520 + k, RLX_AGENT), nf = __hip_atomic_load(cw + 528 + k, RLX_AGENT);
#if DBG_RWKV == 1
            if (nf > 0.f || se > 0.01f * sy) diag += wts[k];
#elif DBG_RWKV == 12
            if (k == 0) diag = sqrtf(nf / (2048.f * 4096.f));
#elif DBG_RWKV == 13 || DBG_RWKV == 14
            if (nf > 0.f) diag += wts[k];
#elif DBG_RWKV >= 10
            if (nf > 0.f) diag += wts[k];
#else
            if (k == DBG_RWKV - 2) diag = (nf > 0.f) ? 7.f : fminf(sqrtf(se / sy), 5.f);
#endif
        }
        __syncthreads();
        float* o = OUTP();
        for (int row = gw; row < TOK; row += ngw) for (int j = 0; j < 4; ++j) { float4 v = *(float4*)(o + (size_t)row * D_MODEL + (lane + 64 * j) * 4); const float sc = 1.f + diag; v.x *= sc; v.y *= sc; v.z *= sc; v.w *= sc; *(float4*)(o + (size_t)row * D_MODEL + (lane + 64 * j) * 4) = v; }
    }
#endif
}

extern "C" void kernel_launch(void* const* d_in, const int* in_sizes, int n_in, void* d_out, int out_size, void* d_ws, size_t ws_size, hipStream_t stream) {
    static int grid = 0;
    if (grid == 0) {
        if (n_in != 26 || in_sizes[0] != TOK * D_MODEL || out_size != TOK * D_MODEL || ws_size < WS_END) {
            fprintf(stderr, "kernel_launch: unexpected problem: n_in %d in0 %d out %d ws %zu (need %zu); nothing launched\n", n_in, n_in > 0 ? in_sizes[0] : -1, out_size, ws_size, (size_t)WS_END); grid = -1; return; }
        int dev = 0, cus = 0, per_cu = 0;
        if (hipGetDevice(&dev) != hipSuccess || hipDeviceGetAttribute(&cus, hipDeviceAttributeMultiprocessorCount, dev) != hipSuccess) { fprintf(stderr, "kernel_launch: device query failed\n"); grid = -1; return; }
        if (hipFuncSetAttribute((const void*)mega_fwd, hipFuncAttributeMaxDynamicSharedMemorySize, LDS_BYTES) != hipSuccess) { fprintf(stderr, "kernel_launch: hipFuncSetAttribute failed\n"); grid = -1; return; }
        if (hipOccupancyMaxActiveBlocksPerMultiprocessor(&per_cu, (const void*)mega_fwd, NTHREADS, LDS_BYTES) != hipSuccess || per_cu < 1) { fprintf(stderr, "kernel_launch: occupancy query says %d blocks per CU; nothing launched\n", per_cu); (void)hipGetLastError(); grid = -1; return; }
        grid = cus;
    }
    if (grid < 0) return;
    if (hipMemsetAsync((char*)d_ws + WS_CTL, 0, CTL_ZERO_BYTES, stream) != hipSuccess) { fprintf(stderr, "kernel_launch: hipMemsetAsync failed\n"); return; }
    Args a{};
    for (int i = 0; i < 26; ++i) a.in[i] = (const float*)d_in[i];
    a.out = (float*)d_out; a.ws = (unsigned char*)d_ws;
    void* kargs[] = {&a};
    const hipError_t le = hipLaunchCooperativeKernel((const void*)mega_fwd, dim3(grid), dim3(NTHREADS), kargs, LDS_BYTES, stream);
    if (le != hipSuccess) fprintf(stderr, "kernel_launch: cooperative launch failed: %s (grid %d x %d threads, %d B LDS)\n", hipGetErrorString(le), grid, NTHREADS, LDS_BYTES);
}
```

```cpp
#include <hip/hip_runtime.h>
#include <hip/hip_cooperative_groups.h>
#include <cstdio>
#include <cstdint>
namespace cg = cooperative_groups;

namespace pg8 {
#define PG8_LAS __attribute__((address_space(3)))
typedef unsigned short bf16_t;
typedef short bf16x8 __attribute__((ext_vector_type(8)));
typedef float f32x4 __attribute__((ext_vector_type(4)));
typedef unsigned u32x4 __attribute__((ext_vector_type(4)));
constexpr int BM = 256, BK = 64, HALF = 128, HTB = HALF * BK * 2  , STAGE_BYTES = 8 * HTB, NXCD = 8, WGM = 8;

__host__ __device__ __forceinline__ int lds_byte(int r, int c) { const int st = (r >> 4) * 2 + (c >> 5), rr = r & 15, cc = c & 31, ob = rr * 64 + cc * 2; return st * 1024 + (ob ^ (((ob >> 9) & 1) << 5)); }
__host__ __device__ __forceinline__ void stage_rc(int b, int& R, int& C) { const int st = b / 1024, sb = b % 1024, swz = sb ^ (((sb >> 9) & 1) << 5); R = (st >> 1) * 16 + swz / 64; C = (st & 1) * 32 + (swz % 64) / 2; }
__host__ __device__ __forceinline__ int perm32(int rho) { const int n = rho >> 4, i = rho & 15; return 8 * (i >> 2) + 4 * n + (i & 3); }

struct Unit { int pm, pn; size_t boff; };
struct Gemm { const bf16_t* A; const bf16_t* Bt; int M, N, K; };

struct StaticOrder {
    int nM, nN, nwg, G, c;
    __host__ __device__ void init(int M, int N, int G_, int c_) { nM = M / BM; nN = N / BM; nwg = nM * nN; G = G_; c = c_; }
    __host__ __device__ bool next(int i, Unit& u) const {
        const long L = (long)i * G + c; if (L >= nwg) return false;
        int wgid = (int)L; { const int q = nwg / NXCD, r = nwg % NXCD, xcd = wgid % NXCD, off = wgid / NXCD; wgid = (xcd < r ? xcd * (q + 1) : r * (q + 1) + (xcd - r) * q) + off; }
        const int nig = WGM * nN, gid = wgid / nig, fm = gid * WGM, gsz = (nM - fm) < WGM ? (nM - fm) : WGM;
        u.pm = fm + ((wgid % nig) % gsz); u.pn = (wgid % nig) / gsz; u.boff = 0; return true;
    }
    __device__ __forceinline__ void a_ready(const Unit&) const {}
    __device__ __forceinline__ void done(const Unit&) const {}
};

__device__ __forceinline__ unsigned cvt_pk_bf16(float lo, float hi) { unsigned r; asm volatile("v_cvt_pk_bf16_f32 %0, %1, %2" : "=v"(r) : "v"(lo), "v"(hi)); return r; }
typedef float f32x2 __attribute__((ext_vector_type(2)));
typedef unsigned u32x2 __attribute__((ext_vector_type(2)));
struct EpiBf16 {
    static constexpr bool PERM = true, AFTER_DRAIN = false;
    bf16_t* O; int ldc;
    __device__ __forceinline__ void operator()(const f32x4 (&acc)[2][2][4][2], const Unit& u, int wr, int wc, int fr, int fq) const {
        const int row0 = u.pm * BM + wr * 64 + fr; const int col0 = u.pn * BM + wc * 32 + 8 * fq;
#pragma unroll
        for (int ai = 0; ai < 2; ++ai)
#pragma unroll
            for (int m = 0; m < 4; ++m) { bf16_t* rowp = O + (size_t)(row0 + ai * HALF + m * 16) * ldc + col0;
#pragma unroll
                for (int bj = 0; bj < 2; ++bj) { const f32x4 v0 = acc[ai][bj][m][0], v1 = acc[ai][bj][m][1];
                    u32x4 w; w.x = cvt_pk_bf16(v0[0], v0[1]); w.y = cvt_pk_bf16(v0[2], v0[3]); w.z = cvt_pk_bf16(v1[0], v1[1]); w.w = cvt_pk_bf16(v1[2], v1[3]);
                    *(u32x4*)(rowp + bj * HALF) = w; } }
    }
};
struct EpiSwiglu {
    static constexpr bool PERM = true, AFTER_DRAIN = false;
    bf16_t* O; int ldc;
    __device__ __forceinline__ void operator()(const f32x4 (&acc)[2][2][4][2], const Unit& u, int wr, int wc, int fr, int fq) const {
        const int row0 = u.pm * BM + wr * 64 + fr; const int col0 = (u.pn * BM + wc * 32 + 8 * fq) >> 1;
#pragma unroll
        for (int ai = 0; ai < 2; ++ai)
#pragma unroll
            for (int m = 0; m < 4; ++m) { bf16_t* rowp = O + (size_t)(row0 + ai * HALF + m * 16) * ldc + col0;
#pragma unroll
                for (int bj = 0; bj < 2; ++bj) { const f32x4 v0 = acc[ai][bj][m][0], v1 = acc[ai][bj][m][1];
                    const float g0 = v0[0], g1 = v0[2], g2 = v1[0], g3 = v1[2];
                    const float a0 = g0 * __builtin_amdgcn_rcpf(1.f + __expf(-g0)) * v0[1], a1 = g1 * __builtin_amdgcn_rcpf(1.f + __expf(-g1)) * v0[3];
                    const float a2 = g2 * __builtin_amdgcn_rcpf(1.f + __expf(-g2)) * v1[1], a3 = g3 * __builtin_amdgcn_rcpf(1.f + __expf(-g3)) * v1[3];
                    u32x2 w; w.x = cvt_pk_bf16(a0, a1); w.y = cvt_pk_bf16(a2, a3);
                    *(u32x2*)(rowp + bj * (HALF / 2)) = w; } }
    }
};
struct EpiRes {
    static constexpr bool PERM = false, AFTER_DRAIN = false;
    const float* base; float* out; int ldc; const float* scale; int sstride;
    __device__ __forceinline__ void operator()(const f32x4 (&acc)[2][2][4][2], const Unit& u, int wr, int wc, int fr, int fq) const {
        const int col0 = u.pn * BM + wc * 32 + 4 * fq;
#pragma unroll
        for (int ai = 0; ai < 2; ++ai)
#pragma unroll
            for (int m = 0; m < 4; ++m) { const int r = u.pm * BM + ai * HALF + wr * 64 + m * 16 + fr; const size_t off = (size_t)r * ldc + col0;
                const float sc = scale ? scale[(size_t)r * sstride] : 1.f;
#pragma unroll
                for (int bj = 0; bj < 2; ++bj)
#pragma unroll
                    for (int n = 0; n < 2; ++n) { const f32x4 bs = *(const f32x4*)(base + off + bj * HALF + n * 16); *(f32x4*)(out + off + bj * HALF + n * 16) = bs + acc[ai][bj][m][n] * sc; }
                asm volatile("" ::: "memory"); }
    }
};
struct EpiSlot {
    static constexpr bool PERM = true, AFTER_DRAIN = false;
    bf16_t* O; int ldc; const float* rscale;
    __device__ __forceinline__ void operator()(const f32x4 (&acc)[2][2][4][2], const Unit& u, int wr, int wc, int fr, int fq) const {
        const int row0 = u.pm * BM + wr * 64 + fr; const int col0 = u.pn * BM + wc * 32 + 8 * fq;
#pragma unroll
        for (int ai = 0; ai < 2; ++ai)
#pragma unroll
            for (int m = 0; m < 4; ++m) { const int r = row0 + ai * HALF + m * 16; const float sc = rscale[r]; bf16_t* rowp = O + (size_t)r * ldc + col0;
#pragma unroll
                for (int bj = 0; bj < 2; ++bj) { const f32x4 v0 = acc[ai][bj][m][0] * sc, v1 = acc[ai][bj][m][1] * sc;
                    u32x4 w; w.x = cvt_pk_bf16(v0[0], v0[1]); w.y = cvt_pk_bf16(v0[2], v0[3]); w.z = cvt_pk_bf16(v1[0], v1[1]); w.w = cvt_pk_bf16(v1[2], v1[3]);
                    *(u32x4*)(rowp + bj * HALF) = w; } }
    }
};
struct MoeOrder {
    const int* segt; int NT, G, c; size_t estride;
    __device__ __forceinline__ bool next(int i, Unit& u) const {
        const int Mt = segt[8]; const long L = (long)i * G + c; if (L >= (long)Mt * NT) return false;
        u.pm = (int)(L / NT); u.pn = (int)(L % NT); int e = 0;
#pragma unroll
        for (int k = 1; k < 8; ++k) if (u.pm >= segt[k]) e = k;
        u.boff = (size_t)e * estride; return true;
    }
    __device__ __forceinline__ void a_ready(const Unit&) const {}
    __device__ __forceinline__ void done(const Unit&) const {}
};
template <class Epi, class Sched, bool ALIGN_EPI = false, bool SP2 = false, bool GATHER = false>
__device__ __forceinline__ void gemm_phase(PG8_LAS unsigned char* lds, const Gemm g, const Sched& S, const Epi& E, const int* ridx = nullptr) {
    static_assert(!GATHER || SP2, "row gather is wired into the SP2 loop only");
    int tid_ = threadIdx.x; asm volatile("" : "+v"(tid_));
    const int tid = tid_, wid = __builtin_amdgcn_readfirstlane(tid >> 6), lane = tid & 63, wr = wid >> 2, wc = wid & 3, fr = lane & 15, fq = lane >> 4;
    const int K = g.K, nt = K / BK;
    unsigned voffA[2], voffB[2];
#pragma unroll
    for (int i = 0; i < 2; ++i) { int R, C; stage_rc(tid * 16 + i * 8192, R, C); const int Rb = Epi::PERM ? ((R & ~31) + perm32(R & 31)) : R;
        voffA[i] = (unsigned)(R * K + C) * 2u; voffB[i] = (unsigned)(Rb * K + C) * 2u; }
    unsigned vA0[2] = {0u, 0u}, vA1[2] = {0u, 0u}; int rn[4] = {0, 0, 0, 0};
    auto rows_load = [&](int pm) { _Pragma("unroll") for (int i = 0; i < 2; ++i) { int R, C; stage_rc(tid * 16 + i * 8192, R, C); rn[i] = ridx[pm * BM + R]; rn[2 + i] = ridx[pm * BM + HALF + R]; } };
    auto rows_set = [&]() { _Pragma("unroll") for (int i = 0; i < 2; ++i) { int R, C; stage_rc(tid * 16 + i * 8192, R, C); vA0[i] = (unsigned)(rn[i] * K + C) * 2u; vA1[i] = (unsigned)(rn[2 + i] * K + C) * 2u; } };
    const size_t kstep = (size_t)(BK * 2);
    const size_t hstep = (size_t)HALF * K * 2;
    const size_t tstep = 2 * hstep;
    const unsigned ldsw = (unsigned)wid * 1024u;
    const int aoff = lds_byte(wr * 64 + fr, fq * 8), boff = lds_byte(wc * 32 + fr, fq * 8);
#define PG8_SA(b, h) (((b) * 2 + (h)) * HTB)
#define PG8_SB(b, h) ((4 + (b) * 2 + (h)) * HTB)
#define PG8_STAGE(bufoff, gbase, voff) do { _Pragma("unroll") for (int _i = 0; _i < 2; ++_i) \
        __builtin_amdgcn_global_load_lds((const unsigned*)((const char*)(gbase) + (voff)[_i]), (PG8_LAS unsigned*)(lds + (bufoff) + ldsw + _i * 8192), 16, 0, 0); } while (0)
#define PG8_STAGE_A(bufoff, gptr, half) do { if constexpr (GATHER) { if ((half) == 0) PG8_STAGE(bufoff, gptr, vA0); else PG8_STAGE(bufoff, gptr, vA1); } else { PG8_STAGE(bufoff, (gptr) + (half) * hstep, voffA); } } while (0)
#define PG8_LDA(dst, b, h) do { _Pragma("unroll") for (int m = 0; m < 4; ++m) _Pragma("unroll") for (int k = 0; k < 2; ++k) dst[m][k] = *(const PG8_LAS bf16x8*)(lds + PG8_SA(b, h) + aoff + m * 2048 + k * 1024); } while (0)
#define PG8_LDB(dst, b, h) do { _Pragma("unroll") for (int n = 0; n < 2; ++n) _Pragma("unroll") for (int k = 0; k < 2; ++k) dst[n][k] = *(const PG8_LAS bf16x8*)(lds + PG8_SB(b, h) + boff + n * 2048 + k * 1024); } while (0)
#define PG8_MMA(ai, bj, At, Bt) do { __builtin_amdgcn_s_setprio(1); _Pragma("unroll") for (int m = 0; m < 4; ++m) _Pragma("unroll") for (int n = 0; n < 2; ++n) _Pragma("unroll") for (int k = 0; k < 2; ++k) \
        acc[ai][bj][m][n] = __builtin_amdgcn_mfma_f32_16x16x32_bf16(Bt[n][k], At[m][k], acc[ai][bj][m][n], 0, 0, 0); __builtin_amdgcn_s_setprio(0); } while (0)
#define PG8_WAIT_V(n) asm volatile("s_waitcnt vmcnt(" #n ")" ::: "memory")
#define PG8_WAIT_L(n) asm volatile("s_waitcnt lgkmcnt(" #n ")" ::: "memory")
#define PG8_BAR __builtin_amdgcn_s_barrier()
#define PG8_SCHED __builtin_amdgcn_sched_barrier(0)
    Unit cur, nxt; int ui = 0;
    if (!S.next(0, cur)) return;
    f32x4 acc[2][2][4][2];
#pragma unroll
    for (int a = 0; a < 2; ++a)
#pragma unroll
        for (int b = 0; b < 2; ++b)
#pragma unroll
            for (int m = 0; m < 4; ++m)
#pragma unroll
                for (int n = 0; n < 2; ++n) acc[a][b][m][n] = (f32x4){0.f, 0.f, 0.f, 0.f};
    bf16x8 At[4][2], B0[2][2], B1[2][2];
    const char* cA = (const char*)g.A + (GATHER ? (size_t)0 : (size_t)cur.pm * tstep); const char* cB = (const char*)g.Bt + cur.boff + (size_t)cur.pn * tstep;
    if constexpr (GATHER) { rows_load(cur.pm); rows_set(); }
    S.a_ready(cur);
    if constexpr (SP2) {
        PG8_STAGE(PG8_SB(0, 0), cB, voffB); PG8_STAGE(PG8_SB(0, 1), cB + hstep, voffB); PG8_STAGE_A(PG8_SA(0, 0), cA, 0); PG8_STAGE_A(PG8_SA(0, 1), cA, 1);
        if (wr == 1) PG8_BAR;
        PG8_WAIT_V(2); PG8_BAR;
        PG8_STAGE(PG8_SB(1, 0), cB + kstep, voffB); PG8_STAGE_A(PG8_SA(1, 0), cA + kstep, 0); PG8_STAGE(PG8_SB(1, 1), cB + hstep + kstep, voffB);
        PG8_WAIT_V(6); PG8_BAR;
    } else {
        PG8_STAGE(PG8_SB(0, 0), cB, voffB); PG8_STAGE(PG8_SA(0, 0), cA, voffA); PG8_STAGE(PG8_SB(0, 1), cB + hstep, voffB); PG8_STAGE(PG8_SA(0, 1), cA + hstep, voffA);
        if (wr == 1) PG8_BAR;
        PG8_WAIT_V(4); PG8_BAR;
        PG8_STAGE(PG8_SB(1, 0), cB + kstep, voffB); PG8_STAGE(PG8_SA(1, 0), cA + kstep, voffA); PG8_STAGE(PG8_SB(1, 1), cB + hstep + kstep, voffB);
        PG8_WAIT_V(6); PG8_BAR;
    }
    for (;;) {
        const bool has_next = S.next(ui + 1, nxt);
        const char* nA = (has_next && !GATHER) ? (const char*)g.A + (size_t)nxt.pm * tstep : cA; const char* nB = has_next ? (const char*)g.Bt + nxt.boff + (size_t)nxt.pn * tstep : cB;
        for (int t = 0; t < nt; t += 2) {
            const bool last = (t == nt - 2);
            const char* a1 = cA + (size_t)(t + 1) * kstep;
            const char* a2 = last ? nA : cA + (size_t)(t + 2) * kstep; const char* b2 = last ? nB : cB + (size_t)(t + 2) * kstep;
            const char* a3 = a2 + kstep; const char* b3 = b2 + kstep;
            if (last && has_next) S.a_ready(nxt);
            if constexpr (SP2) {
            if constexpr (GATHER) { if (last && has_next) rows_load(nxt.pm); }
            PG8_LDB(B0, 0, 0); PG8_LDB(B1, 0, 1); PG8_SCHED; PG8_LDA(At, 0, 0); PG8_STAGE_A(PG8_SA(1, 1), a1, 1);
            PG8_WAIT_V(8); PG8_WAIT_L(0); PG8_BAR; PG8_MMA(0, 0, At, B0); PG8_MMA(0, 1, At, B1); PG8_BAR; PG8_SCHED;
            if constexpr (GATHER) { if (last && has_next) rows_set(); }
            PG8_LDA(At, 0, 1); PG8_STAGE(PG8_SB(0, 0), b2, voffB); PG8_STAGE(PG8_SB(0, 1), b2 + hstep, voffB); PG8_STAGE_A(PG8_SA(0, 0), a2, 0);
            PG8_WAIT_V(8); PG8_WAIT_L(0); PG8_BAR; PG8_MMA(1, 0, At, B0); PG8_MMA(1, 1, At, B1); PG8_BAR; PG8_SCHED;
            PG8_LDB(B0, 1, 0); PG8_LDB(B1, 1, 1); PG8_SCHED; PG8_LDA(At, 1, 0); PG8_STAGE_A(PG8_SA(0, 1), a2, 1);
            PG8_WAIT_V(8); PG8_WAIT_L(0); PG8_BAR; PG8_MMA(0, 0, At, B0); PG8_MMA(0, 1, At, B1); PG8_BAR; PG8_SCHED;
            PG8_LDA(At, 1, 1); PG8_STAGE(PG8_SB(1, 0), b3, voffB); PG8_STAGE(PG8_SB(1, 1), b3 + hstep, voffB); PG8_STAGE_A(PG8_SA(1, 0), a3, 0);
            PG8_WAIT_V(8); PG8_WAIT_L(0); PG8_BAR; PG8_MMA(1, 0, At, B0); PG8_MMA(1, 1, At, B1); PG8_BAR; PG8_SCHED;
            } else {
            PG8_LDB(B0, 0, 0); PG8_SCHED; PG8_LDA(At, 0, 0); PG8_STAGE(PG8_SA(1, 1), a1 + hstep, voffA);
            PG8_WAIT_L(8); PG8_BAR; PG8_WAIT_L(0); PG8_MMA(0, 0, At, B0); PG8_BAR; PG8_SCHED;
            PG8_LDB(B1, 0, 1); PG8_STAGE(PG8_SB(0, 0), b2, voffB);
            PG8_BAR; PG8_WAIT_L(0); PG8_MMA(0, 1, At, B1); PG8_BAR;
            PG8_LDA(At, 0, 1); PG8_STAGE(PG8_SA(0, 0), a2, voffA);
            PG8_BAR; PG8_WAIT_L(0); PG8_MMA(1, 0, At, B0); PG8_BAR; PG8_SCHED;
            PG8_STAGE(PG8_SB(0, 1), b2 + hstep, voffB);
            PG8_WAIT_V(6); PG8_BAR; PG8_MMA(1, 1, At, B1); PG8_BAR;
            PG8_LDB(B0, 1, 0); PG8_SCHED; PG8_LDA(At, 1, 0); PG8_STAGE(PG8_SA(0, 1), a2 + hstep, voffA);
            PG8_WAIT_L(8); PG8_BAR; PG8_WAIT_L(0); PG8_MMA(0, 0, At, B0); PG8_BAR; PG8_SCHED;
            PG8_LDB(B1, 1, 1); PG8_STAGE(PG8_SB(1, 0), b3, voffB);
            PG8_BAR; PG8_WAIT_L(0); PG8_MMA(0, 1, At, B1); PG8_BAR;
            PG8_LDA(At, 1, 1); PG8_STAGE(PG8_SA(1, 0), a3, voffA);
            PG8_BAR; PG8_WAIT_L(0); PG8_MMA(1, 0, At, B0); PG8_BAR; PG8_SCHED;
            PG8_STAGE(PG8_SB(1, 1), b3 + hstep, voffB);
            PG8_WAIT_V(6); PG8_BAR; PG8_MMA(1, 1, At, B1); PG8_BAR;
            }
        }
        if constexpr (ALIGN_EPI) { if (wr == 0) PG8_BAR; }
        if constexpr (!Epi::AFTER_DRAIN) { E(acc, cur, wr, wc, fr, fq); S.done(cur); }
        if (!has_next) break;
#pragma unroll
        for (int a = 0; a < 2; ++a)
#pragma unroll
            for (int b = 0; b < 2; ++b)
#pragma unroll
                for (int m = 0; m < 4; ++m)
#pragma unroll
                    for (int n = 0; n < 2; ++n) acc[a][b][m][n] = (f32x4){0.f, 0.f, 0.f, 0.f};
        cur = nxt; cA = nA; cB = nB; ++ui;
        if constexpr (ALIGN_EPI) { if (wr == 1) PG8_BAR; }
    }
    PG8_WAIT_V(0);
    if constexpr (!ALIGN_EPI) { if (wr == 0) PG8_BAR; }
    PG8_BAR;
    if constexpr (Epi::AFTER_DRAIN) { E.fused(acc, cur, wr, wc, fr, fq, lds, wid, lane); S.done(cur); }
#undef PG8_SA
#undef PG8_SB
#undef PG8_STAGE
#undef PG8_STAGE_A
#undef PG8_LDA
#undef PG8_LDB
#undef PG8_MMA
#undef PG8_WAIT_V
#undef PG8_WAIT_L
#undef PG8_BAR
#undef PG8_SCHED
}
}
typedef unsigned short bf16_t;
constexpr int D_MODEL = 1024, BATCH = 8, SEQ = 2048, TOK = BATCH * SEQ;
constexpr int CHUNK = 64, NCHUNK = SEQ / CHUNK;
constexpr int RW = 512, AW = 512, NH = 8;
constexpr int IN_COLS = 3328, SHIFT_COLS = 1792;
constexpr int C_R = 0, C_K = 512, C_V = 1024, C_WD = 1536, C_AD = 1600, C_GD = 1664, C_QA = 1792, C_KA = 2304, C_VA = 2816;
constexpr int D_FF = 2816, NE = 8, D_FFE = 1408;
constexpr float RMS_EPS = 1e-6f, GN_EPS = 64e-5f;
constexpr int NWAVES = 8, NTHREADS = 512;

constexpr size_t MiB = 1u << 20;
constexpr size_t WS_CTL = 0, CTL_ZERO_BYTES = 64 * 1024;
constexpr size_t SZ_WIN = (size_t)IN_COLS * D_MODEL * 2, SZ_WOUT = (size_t)D_MODEL * D_MODEL * 2, SZ_FGU = (size_t)2 * D_FF * D_MODEL * 2, SZ_FDN = (size_t)D_MODEL * D_FF * 2;
constexpr size_t SZ_MGU = (size_t)2 * D_FFE * D_MODEL * 2, SZ_MDN = (size_t)D_MODEL * D_FFE * 2;
constexpr size_t WS_WIN = 1 * MiB, WS_WOUT = WS_WIN + 2 * SZ_WIN, WS_FGU = WS_WOUT + 2 * SZ_WOUT, WS_FDN = WS_FGU + SZ_FGU, WS_LORA = WS_FDN + SZ_FDN, WS_WEND = WS_LORA + 512 * 1024;
constexpr size_t LORA_W2T = 0, LORA_A2T = 2 * 512 * 64 * 2, LORA_G2T = 4 * 512 * 64 * 2;
constexpr size_t WS_XN = 35 * MiB;
constexpr size_t WS_PROJ = 67 * MiB;
constexpr size_t WS_CHUNK = 171 * MiB;
constexpr size_t WS_GP = WS_CHUNK, WS_QP = WS_CHUNK + 16 * MiB, WS_HT = WS_CHUNK + 32 * MiB, WS_ZT = WS_CHUNK + 48 * MiB, WS_GATE = WS_CHUNK + 64 * MiB;
constexpr size_t WS_BONUS = 251 * MiB;
constexpr size_t WS_TAB = 252 * MiB;
constexpr int MOE_MAXROWS = 2 * TOK + NE * 256;
constexpr size_t TAB_ROUTE_E = 0, TAB_ROUTE_G = 64 * 1024, TAB_POS = 192 * 1024, TAB_ROWIDX = 320 * 1024, TAB_GATEPOS = 464 * 1024, TAB_SEGT = 608 * 1024;
constexpr size_t WS_SLOT = 1 * MiB;
constexpr size_t WS_ACT2 = 69 * MiB;
static_assert(WS_SLOT + (size_t)MOE_MAXROWS * D_MODEL * 2 <= WS_ACT2 && WS_ACT2 + (size_t)MOE_MAXROWS * D_FFE * 2 <= 171 * MiB && TAB_ROWIDX + MOE_MAXROWS * 4 <= TAB_GATEPOS && TAB_GATEPOS + MOE_MAXROWS * 4 <= TAB_SEGT, "moe map");
constexpr size_t WS_MGU = WS_CHUNK, WS_MDN = WS_MGU + NE * SZ_MGU;
constexpr size_t WS_END = 253 * MiB;
static_assert(WS_MDN + NE * SZ_MDN <= WS_BONUS && WS_GATE + 16 * MiB <= WS_BONUS, "map");
static_assert(WS_WEND <= WS_XN, "weights fit below XN");

#define GAS __attribute__((address_space(1)))
#define LAS __attribute__((address_space(3)))
typedef unsigned short bf16;
typedef unsigned v4u __attribute__((ext_vector_type(4)));
typedef float f32x4 __attribute__((ext_vector_type(4)));
typedef short bf16x8 __attribute__((ext_vector_type(8)));
typedef GAS unsigned gu32;
typedef GAS unsigned long long gu64;
#define RLX_AGENT __ATOMIC_RELAXED, __HIP_MEMORY_SCOPE_AGENT
#define LDS_WAIT() asm volatile("s_waitcnt lgkmcnt(0)" ::: "memory")
#define VM_WAIT() asm volatile("s_waitcnt vmcnt(0)" ::: "memory")
__device__ __forceinline__ unsigned long long rt() { return __builtin_amdgcn_s_memrealtime(); }
__device__ __forceinline__ unsigned f2bf(float f) { unsigned u = __builtin_bit_cast(unsigned, f); return (u + 0x7fffu + ((u >> 16) & 1u)) >> 16; }
__device__ __forceinline__ unsigned pk2(float lo, float hi) { return f2bf(lo) | (f2bf(hi) << 16); }
constexpr int CW_BAR = 1024;
#define XB_TMO      128
#define XB_XCNT(j)  (256  + 64 * (j))
#define XB_XSUB(j)  (1280 + 64 * (j))
#define XB_XGEN(j)  (2304 + 64 * (j))
#define XB_TOP      3328
#define XB_TOPGEN   3392
#define XCD_BAR_WORDS 3456
#define XB_SPIN_CAP (1u << 18)

__device__ __forceinline__ unsigned xb_ld(unsigned* p)              { return __hip_atomic_load(p, __ATOMIC_RELAXED, __HIP_MEMORY_SCOPE_AGENT); }
__device__ __forceinline__ unsigned xb_add(unsigned* p, unsigned v) { return __hip_atomic_fetch_add(p, v, __ATOMIC_RELAXED, __HIP_MEMORY_SCOPE_AGENT); }
__device__ __forceinline__ unsigned xb_xcc_id() { return (unsigned)__builtin_amdgcn_s_getreg((3 << 11) | 20) & 0xFu; }
#define XB_SPIN(cond, bar) do { unsigned _sp = 0; while (cond) { __builtin_amdgcn_s_sleep(1); \
    if ((++_sp & 255u) == 0u) { if (xb_ld(&(bar)[XB_TMO])) break; if (_sp > XB_SPIN_CAP) { atomicAdd(&(bar)[XB_TMO], 1u); break; } } } } while (0)

struct XcdBarrier {
    unsigned* bar; unsigned x;
    volatile LAS unsigned* st;
};

__device__ __forceinline__ XcdBarrier xcd_barrier_post(unsigned* bar, volatile LAS unsigned* st) {
    XcdBarrier b; b.bar = bar; b.x = xb_xcc_id(); b.st = st;
    if (threadIdx.x == 0) (void)xb_add(&bar[XB_XCNT(b.x)], 1u);
    return b;
}
__device__ __forceinline__ void xcd_barrier_complete(unsigned* bar, unsigned x, unsigned& nloc, unsigned& nx) {
    const unsigned G = gridDim.x * gridDim.y * gridDim.z;
    unsigned sum, cnt, mine, sp = 0u;
    for (;;) {
        sum = 0u; cnt = 0u; mine = 0u;
#pragma unroll
        for (unsigned j = 0; j < 16; ++j) { const unsigned c = xb_ld(&bar[XB_XCNT(j)]); sum += c; cnt += (c > 0u) ? 1u : 0u; mine = (j == x) ? c : mine; }
        if (sum == G) break;
        __builtin_amdgcn_s_sleep(1);
        if ((++sp & 255u) == 0u) { if (xb_ld(&bar[XB_TMO])) break; if (sp > XB_SPIN_CAP) { atomicAdd(&bar[XB_TMO], 1u); break; } }
    }
    nloc = mine > 0u ? mine : 1u; nx = cnt > 0u ? cnt : 1u;
}

__device__ __forceinline__ void xcd_barrier(const XcdBarrier& b) {
    asm volatile("s_waitcnt vmcnt(0)" ::: "memory");
    __syncthreads();
    if (threadIdx.x == 0) {
        unsigned* bar = b.bar;
        __builtin_amdgcn_s_waitcnt(0);
        unsigned nloc = b.st[0], nx = b.st[1];
        if (nloc == 0u) { xcd_barrier_complete(bar, b.x, nloc, nx); b.st[0] = nloc; b.st[1] = nx; }
        const unsigned old = xb_add(&bar[XB_XSUB(b.x)], 1u);
        const unsigned gen = old / nloc;
        if (old + 1u == (gen + 1u) * nloc) {
            __builtin_amdgcn_fence(__ATOMIC_RELEASE, "agent");
            asm volatile("s_waitcnt vmcnt(0)" ::: "memory");
            const unsigned og = xb_add(&bar[XB_TOP], 1u);
            const unsigned tg = og / nx;
            if (og + 1u == (tg + 1u) * nx) xb_add(&bar[XB_TOPGEN], 1u);
            else XB_SPIN(xb_ld(&bar[XB_TOPGEN]) == tg, bar);
            __builtin_amdgcn_fence(__ATOMIC_ACQUIRE, "agent");
            xb_add(&bar[XB_XGEN(b.x)], 1u);
            asm volatile("s_waitcnt vmcnt(0)" ::: "memory");
        } else {
            XB_SPIN(xb_ld(&bar[XB_XGEN(b.x)]) == gen, bar);
            __builtin_amdgcn_fence(__ATOMIC_ACQUIRE, "agent");
            asm volatile("s_waitcnt vmcnt(0)" ::: "memory");
        }
    }
    __syncthreads();
}
__device__ __forceinline__ float bf2f(unsigned h) { return __builtin_bit_cast(float, h << 16); }
__device__ __forceinline__ float wave_sum(float v) {
#pragma unroll
    for (int o = 1; o < 64; o <<= 1) v += __shfl_xor(v, o);
    return v;
}
typedef float f32x2_t __attribute__((ext_vector_type(2))); typedef __bf16 bf16x2_t __attribute__((ext_vector_type(2)));
__device__ __forceinline__ unsigned cvtpk(float lo, float hi) { const f32x2_t v = {lo, hi}; const bf16x2_t b = __builtin_convertvector(v, bf16x2_t); return __builtin_bit_cast(unsigned, b); }
__device__ __forceinline__ float sigmoidf_(float x) { return 1.f / (1.f + __expf(-x)); }

__device__ __forceinline__ void p0_transpose_item(const float* W, int K, int N, bf16_t* WT, int row_off, int rmul, LAS float* scr, int item, int lane) {
    const int nblk = N / 32, kb = item / nblk, nb = item % nblk, k0 = 64 * kb, n0 = 32 * nb;
#pragma unroll 8
    for (int i = 0; i < 32; ++i) { const int kk = 2 * i + (lane >> 5); scr[kk * 33 + (lane & 31)] = W[(size_t)(k0 + kk) * N + n0 + (lane & 31)]; }
    LDS_WAIT(); asm volatile("" ::: "memory");
    const int c = lane & 7;
#pragma unroll
    for (int j = 0; j < 4; ++j) { const int n = (lane >> 3) + 8 * j; const LAS float* s = scr + (8 * c) * 33 + n;
        v4u o; o.x = pk2(s[0 * 33], s[1 * 33]); o.y = pk2(s[2 * 33], s[3 * 33]); o.z = pk2(s[4 * 33], s[5 * 33]); o.w = pk2(s[6 * 33], s[7 * 33]);
        *(GAS v4u*)(WT + (size_t)(row_off + (n0 + n) * rmul) * K + k0 + 8 * c) = o; }
    LDS_WAIT(); asm volatile("" ::: "memory");
}

template <int MODE>
__device__ __forceinline__ void norm_rows(int gw, int ngw, int lane, const float* x, const float* __restrict__ g, bf16_t* xn, float* outf, const float* __restrict__ router, int* route_e, float2* route_g,
                                          const bf16_t* slot = nullptr, const int2* pos = nullptr) {
    for (int row = gw; row < TOK; row += ngw) {
        const float4* xr = (const float4*)(x + (size_t)row * D_MODEL);
        float4 v[4]; float s = 0.f;
        int2 pp = make_int2(0, 0); if (MODE == 3) pp = pos[row];
#pragma unroll
        for (int j = 0; j < 4; ++j) { v[j] = xr[lane + 64 * j];
            if (MODE == 3) {
                const uint2 s0 = *(const uint2*)(slot + (size_t)pp.x * D_MODEL + (lane + 64 * j) * 4), s1 = *(const uint2*)(slot + (size_t)pp.y * D_MODEL + (lane + 64 * j) * 4);
                v[j].x += bf2f(s0.x & 0xffffu) + bf2f(s1.x & 0xffffu); v[j].y += bf2f(s0.x >> 16) + bf2f(s1.x >> 16); v[j].z += bf2f(s0.y & 0xffffu) + bf2f(s1.y & 0xffffu); v[j].w += bf2f(s0.y >> 16) + bf2f(s1.y >> 16);
            }
#ifdef DBG_SANITIZE
            if (MODE >= 2) { if (!(fabsf(v[j].x) < 1e30f)) v[j].x = 0.f; if (!(fabsf(v[j].y) < 1e30f)) v[j].y = 0.f; if (!(fabsf(v[j].z) < 1e30f)) v[j].z = 0.f; if (!(fabsf(v[j].w) < 1e30f)) v[j].w = 0.f; }
#endif
            s += v[j].x * v[j].x + v[j].y * v[j].y + v[j].z * v[j].z + v[j].w * v[j].w; }
        s = wave_sum(s);
        const float rstd = rsqrtf(s * (1.f / D_MODEL) + RMS_EPS);
        float lg[8];
#pragma unroll
        for (int e = 0; e < 8; ++e) lg[e] = 0.f;
#pragma unroll
        for (int j = 0; j < 4; ++j) {
            const int c0 = (lane + 64 * j) * 4;
            const float4 gg = *(const float4*)(g + c0);
            const float h0 = v[j].x * rstd * gg.x, h1 = v[j].y * rstd * gg.y, h2 = v[j].z * rstd * gg.z, h3 = v[j].w * rstd * gg.w;
            if (MODE >= 2) { *(float4*)(outf + (size_t)row * D_MODEL + c0) = make_float4(h0, h1, h2, h3); }
            else { uint2 o; o.x = pk2(h0, h1); o.y = pk2(h2, h3); *(uint2*)(xn + (size_t)row * D_MODEL + c0) = o; }
            if (MODE == 1) {
                const float hh[4] = {h0, h1, h2, h3};
#pragma unroll
                for (int i = 0; i < 4; ++i) {
                    const float4 r0 = *(const float4*)(router + (size_t)(c0 + i) * 8), r1 = *(const float4*)(router + (size_t)(c0 + i) * 8 + 4);
                    lg[0] += hh[i] * r0.x; lg[1] += hh[i] * r0.y; lg[2] += hh[i] * r0.z; lg[3] += hh[i] * r0.w;
                    lg[4] += hh[i] * r1.x; lg[5] += hh[i] * r1.y; lg[6] += hh[i] * r1.z; lg[7] += hh[i] * r1.w;
                }
            }
        }
        if (MODE == 1) {
#pragma unroll
            for (int e = 0; e < 8; ++e) lg[e] = wave_sum(lg[e]);
            if (lane == 0) {
                int i0 = 0; float v0 = lg[0];
#pragma unroll
                for (int e = 1; e < 8; ++e) if (lg[e] > v0) { v0 = lg[e]; i0 = e; }
                int i1 = -1; float v1 = -3.0e38f;
#pragma unroll
                for (int e = 0; e < 8; ++e) if (e != i0 && lg[e] > v1) { v1 = lg[e]; i1 = e; }
                const float e1 = __expf(v1 - v0), inv = 1.f / (1.f + e1);
                route_e[row] = i0 | (i1 << 8); route_g[row] = make_float2(inv, e1 * inv);
            }
        }
    }
}


struct MoeTabs { int* route_e; float2* route_g; int2* pos; int* rowidx; float* gatepos; int* segt; };
__device__ __forceinline__ int wave_sum_i(int v) {
#pragma unroll
    for (int o = 1; o < 64; o <<= 1) v += __shfl_xor(v, o);
    return v;
}
__device__ __forceinline__ void moe_build_lists(LAS unsigned char* lds, int bid, int G, const MoeTabs& T) {
    int tid_ = threadIdx.x; asm volatile("" : "+v"(tid_));
    const int tid = tid_, lane = tid & 63, wave = __builtin_amdgcn_readfirstlane(tid >> 6);
    LAS int* cnt = (LAS int*)lds;
#pragma unroll 1
    for (int tb = bid; tb < TOK / 64; tb += G) {
        __syncthreads();
        if (tid < 32) cnt[tid] = 0;
        __syncthreads();
        int ct[8], cp[8];
#pragma unroll
        for (int k = 0; k < 8; ++k) { ct[k] = 0; cp[k] = 0; }
        for (int tok = tid; tok < TOK; tok += NTHREADS) {
            const int e = T.route_e[tok], e0 = e & 0xff, e1 = (e >> 8) & 0xff; const bool before = tok < 64 * tb;
#pragma unroll
            for (int k = 0; k < 8; ++k) { const int c = (e0 == k ? 1 : 0) + (e1 == k ? 1 : 0); ct[k] += c; cp[k] += before ? c : 0; }
        }
#pragma unroll
        for (int k = 0; k < 8; ++k) { const int a = wave_sum_i(ct[k]), b = wave_sum_i(cp[k]); if (lane == 0) { atomicAdd((int*)&cnt[k], a); atomicAdd((int*)&cnt[8 + k], b); } }
        __syncthreads();
        if (tid == 0) { int s = 0; for (int k = 0; k < 8; ++k) { cnt[16 + k] = s; s += (cnt[k] + 255) & ~255; } cnt[24] = s; }
        __syncthreads();
        if (wave == 0) {
            const int tok = 64 * tb + lane; const int e = T.route_e[tok], e0 = e & 0xff, e1 = (e >> 8) & 0xff; const float2 gg = T.route_g[tok];
            const unsigned long long below = (1ull << lane) - 1ull; int p0 = 0, p1 = 0;
#pragma unroll
            for (int k = 0; k < 8; ++k) {
                const unsigned long long m0 = __ballot(e0 == k), m1 = __ballot(e1 == k);
                const int r = __popcll(m0 & below) + __popcll(m1 & below) + cnt[16 + k] + cnt[8 + k];
                if (e0 == k) p0 = r; if (e1 == k) p1 = r;
            }
            T.pos[tok] = make_int2(p0, p1); T.rowidx[p0] = tok; T.rowidx[p1] = tok; T.gatepos[p0] = gg.x; T.gatepos[p1] = gg.y;
        }
        if (tb == 0) {
            for (int k = 0; k < 8; ++k) for (int p = cnt[16 + k] + cnt[k] + tid; p < cnt[17 + k]; p += NTHREADS) { T.rowidx[p] = 0; T.gatepos[p] = 0.f; }
            if (tid < 9) T.segt[tid] = cnt[16 + tid] >> 8;
        }
    }
}
typedef float f32x16 __attribute__((ext_vector_type(16)));
typedef short s16x4 __attribute__((ext_vector_type(4)));
constexpr int ATT_OSTRSB = 144;
constexpr int ATT_WAVE_BYTES = 8192 + 64 * ATT_OSTRSB, ATT_TBL = 8 * ATT_WAVE_BYTES, ATT_SCR = ATT_TBL + 8 * 260 * 4, ATT_SSQ = ATT_SCR + 8 * 64 * 4, ATT_LDS = ATT_SSQ + 8 * 64 * 4;
constexpr float LOG2E = 1.4426950408889634f;
__device__ __forceinline__ int crow(int r, int hi) { return (r & 3) + 8 * (r >> 2) + 4 * hi; }
__device__ __forceinline__ s16x4 vtr(const LAS unsigned char* p) { return __builtin_bit_cast(s16x4, __builtin_amdgcn_ds_read_tr16_b64_v4i16((LAS s16x4*)p)); }
__device__ __forceinline__ bf16x8 scale_q(uint4 u) {
    const unsigned w[4] = {u.x, u.y, u.z, u.w}; unsigned o[4];
#pragma unroll
    for (int i = 0; i < 4; ++i) o[i] = pk2(bf2f(w[i] & 0xffffu) * 0.125f, bf2f(w[i] >> 16) * 0.125f);
    return __builtin_bit_cast(bf16x8, make_uint4(o[0], o[1], o[2], o[3]));
}
__device__ __forceinline__ void attn_qblock(int qb, int b, int n, int h, int lane, LAS unsigned char* vt, LAS float* scr, const LAS float* mytbl, const bf16_t* __restrict__ proj) {
    const int r32 = lane & 31, hi = lane >> 5;
    const size_t row0 = (size_t)b * SEQ + n * CHUNK;
    bf16x8 qr[4];
    {
        const bf16_t* qp = proj + (row0 + qb * 32 + r32) * IN_COLS + C_QA + h * 64 + 8 * hi;
#pragma unroll
        for (int ds = 0; ds < 4; ++ds) qr[ds] = scale_q(*(const uint4*)(qp + 16 * ds));
    }
    float m = -1.0e30f, l = 0.f; f32x16 o0, o1;
#pragma unroll
    for (int r = 0; r < 16; ++r) { o0[r] = 0.f; o1[r] = 0.f; }
    const int iq = qb * 32 + r32;
    const int j_lo = (n >= 8) ? 0 : 2 * (8 - n);
    const int trow = (4 * hi + ((lane & 15) >> 2)) * 128 + ((lane >> 4) & 1) * 32 + (lane & 3) * 8;
    uint4 vv[4]; bf16x8 kf[4];
    auto load_tile = [&](int j, uint4 (&v_)[4], bf16x8 (&k_)[4]) {
        const size_t krow0 = (size_t)b * SEQ + (size_t)(n - 8) * CHUNK + (size_t)j * 32;
        const bf16_t* vp = proj + (krow0 + (lane >> 1)) * IN_COLS + C_VA + h * 64 + (lane & 1) * 32;
#pragma unroll
        for (int i = 0; i < 4; ++i) v_[i] = *(const uint4*)(vp + 8 * i);
        const bf16_t* kp = proj + (krow0 + r32) * IN_COLS + C_KA + h * 64 + 8 * hi;
#pragma unroll
        for (int ds = 0; ds < 4; ++ds) k_[ds] = *(const bf16x8*)(kp + 16 * ds);
    };
    load_tile(j_lo, vv, kf);
#pragma unroll
    for (int i = 0; i < 4; ++i) *(LAS v4u*)(vt + (lane >> 1) * 128 + (lane & 1) * 64 + i * 16) = (v4u){vv[i].x, vv[i].y, vv[i].z, vv[i].w};
#pragma unroll 1
    for (int j = j_lo; j < 18; ++j) {
        f32x16 p0;
#pragma unroll
        for (int r = 0; r < 16; ++r) p0[r] = 0.f;
#pragma unroll
        for (int ds = 0; ds < 4; ++ds) p0 = __builtin_amdgcn_mfma_f32_32x32x16_bf16(kf[ds], qr[ds], p0, 0, 0, 0);
        __builtin_amdgcn_sched_barrier(0);
        if (j < 17) load_tile(j + 1, vv, kf);
        if (j < 12) {
            const float bc = mytbl[256];
#pragma unroll
            for (int r = 0; r < 16; ++r) p0[r] = p0[r] * LOG2E + bc;
        } else {
            const int base = iq + 512 - 32 * j;
#pragma unroll
            for (int r = 0; r < 16; ++r) { int i0 = base - crow(r, hi); i0 = (i0 > 128 ? 128 : i0) + 128; p0[r] = p0[r] * LOG2E + mytbl[i0]; }
        }
        float mt = p0[0];
#pragma unroll
        for (int r = 1; r < 16; ++r) mt = fmaxf(mt, p0[r]);
        mt = fmaxf(mt, __shfl_xor(mt, 32));
        if (__any(mt > m + 8.f)) {
            const float mn = fmaxf(m, mt), alpha = __builtin_amdgcn_exp2f(m - mn);
            m = mn; l *= alpha;
            if (hi == 0) scr[r32] = alpha;
#pragma unroll
            for (int r = 0; r < 16; ++r) { const float a = scr[crow(r, hi)]; o0[r] *= a; o1[r] *= a; }
        }
        float rs = 0.f;
#pragma unroll
        for (int r = 0; r < 16; ++r) { p0[r] = __builtin_amdgcn_exp2f(p0[r] - m); rs += p0[r]; }
        rs += __shfl_xor(rs, 32);
        l += rs;
        bf16x8 pa[2];
#pragma unroll
        for (int s = 0; s < 2; ++s)
            pa[s] = __builtin_bit_cast(bf16x8, make_uint4(cvtpk(p0[8 * s + 0], p0[8 * s + 1]), cvtpk(p0[8 * s + 2], p0[8 * s + 3]), cvtpk(p0[8 * s + 4], p0[8 * s + 5]), cvtpk(p0[8 * s + 6], p0[8 * s + 7])));
#pragma unroll
        for (int ks = 0; ks < 2; ++ks) {
            const LAS unsigned char* vb = vt + ks * 16 * 128 + trow;
            const s16x4 a0 = vtr(vb), a1 = vtr(vb + 8 * 128), b0 = vtr(vb + 64), b1 = vtr(vb + 8 * 128 + 64);
            const bf16x8 v0 = (bf16x8){a0[0], a0[1], a0[2], a0[3], a1[0], a1[1], a1[2], a1[3]}, v1 = (bf16x8){b0[0], b0[1], b0[2], b0[3], b1[0], b1[1], b1[2], b1[3]};
            o0 = __builtin_amdgcn_mfma_f32_32x32x16_bf16(pa[ks], v0, o0, 0, 0, 0);
            o1 = __builtin_amdgcn_mfma_f32_32x32x16_bf16(pa[ks], v1, o1, 0, 0, 0);
        }
        if (j < 17) {
#pragma unroll
            for (int i = 0; i < 4; ++i) *(LAS v4u*)(vt + (lane >> 1) * 128 + (lane & 1) * 64 + i * 16) = (v4u){vv[i].x, vv[i].y, vv[i].z, vv[i].w};
        }
    }
    if (hi == 0) scr[r32] = 1.f / l;
    LAS unsigned char* ost = vt + 8192;
#pragma unroll
    for (int r = 0; r < 16; ++r) {
        const int q = crow(r, hi); const float il = scr[q];
        *(LAS unsigned short*)(ost + (qb * 32 + q) * ATT_OSTRSB + r32 * 2) = (unsigned short)f2bf(o0[r] * il);
        *(LAS unsigned short*)(ost + (qb * 32 + q) * ATT_OSTRSB + (32 + r32) * 2) = (unsigned short)f2bf(o1[r] * il);
    }
}
__device__ __forceinline__ void attn_half_unit(LAS unsigned char* ldsp, int b, int n, int qb, const bf16_t* __restrict__ proj, const float* __restrict__ rel_bias, const float* __restrict__ gnorm, bf16_t* ymix) {
    int tid_ = threadIdx.x; asm volatile("" : "+v"(tid_));
    const int tid = tid_, lane = tid & 63, h = __builtin_amdgcn_readfirstlane(tid >> 6), r32 = lane & 31, hi = lane >> 5;
    LAS float* tbl = (LAS float*)(ldsp + ATT_TBL);
    __syncthreads();
    for (int i = tid; i < 8 * 257; i += NTHREADS) { const int e = i / 257, k = i - e * 257; tbl[e * 260 + k] = rel_bias[k * 8 + e] * LOG2E; }
    __syncthreads();
    LAS unsigned char* vt = ldsp + h * ATT_WAVE_BYTES;
    LAS float* scr = (LAS float*)(ldsp + ATT_SCR) + h * 64;
    LAS float* ssq = (LAS float*)(ldsp + ATT_SSQ);
    attn_qblock(qb, b, n, h, lane, vt, scr, tbl + h * 260, proj);
    float v[32]; float s = 0.f;
    {
        const LAS unsigned char* orow = vt + 8192 + (qb * 32 + r32) * ATT_OSTRSB + hi * 64;
#pragma unroll
        for (int d = 0; d < 32; d += 8) { const v4u u = *(const LAS v4u*)(orow + d * 2); const unsigned w_[4] = {u.x, u.y, u.z, u.w};
#pragma unroll
            for (int i = 0; i < 4; ++i) { v[d + 2 * i] = bf2f(w_[i] & 0xffffu); v[d + 2 * i + 1] = bf2f(w_[i] >> 16); s += v[d + 2 * i] * v[d + 2 * i] + v[d + 2 * i + 1] * v[d + 2 * i + 1]; } }
    }
    s += __shfl_xor(s, 32);
    if (hi == 0) ssq[h * 64 + r32] = s;
    __syncthreads();
    float tot = 0.f;
#pragma unroll
    for (int e = 0; e < 8; ++e) tot += ssq[e * 64 + r32];
    const float rstd = rsqrtf(tot * (1.f / AW) + RMS_EPS);
    const float* gp = gnorm + h * 64 + hi * 32;
    bf16_t* op = ymix + ((size_t)b * SEQ + n * CHUNK + qb * 32 + r32) * D_MODEL + RW + h * 64 + hi * 32;
#pragma unroll
    for (int d = 0; d < 32; d += 8) {
        const float4 g0 = *(const float4*)(gp + d), g1 = *(const float4*)(gp + d + 4);
        uint4 o; o.x = pk2(v[d] * rstd * g0.x, v[d + 1] * rstd * g0.y); o.y = pk2(v[d + 2] * rstd * g0.z, v[d + 3] * rstd * g0.w);
        o.z = pk2(v[d + 4] * rstd * g1.x, v[d + 5] * rstd * g1.y); o.w = pk2(v[d + 6] * rstd * g1.z, v[d + 7] * rstd * g1.w);
        *(uint4*)(op + d) = o;
    }
}
constexpr int R1_RS = 72, R1_RSB = R1_RS * 2;
constexpr int R1_MAT = 64 * R1_RSB;
constexpr int R1_SGRSB = 136 * 2;
constexpr int R1_X = 0;
constexpr int R1_TW = R1_X, R1_AD = R1_X + R1_MAT, R1_SG = R1_X + 2 * R1_MAT;
constexpr int R1_MAB = R1_X, R1_MAK = R1_X + R1_MAT, R1_NRB = R1_X + 2 * R1_MAT, R1_NRK = R1_X + 3 * R1_MAT;
constexpr int R1_Y = R1_X + 4 * R1_MAT;
constexpr int R1_FRS = 68;
constexpr int R1_WL = R1_Y, R1_AL = R1_Y + 64 * R1_FRS * 4;
constexpr int R1_Z = R1_Y + 2 * 64 * R1_FRS * 4;
constexpr int R1_AH = R1_Z, R1_BH = R1_Z + R1_MAT, R1_KH = R1_Z + 2 * R1_MAT, R1_RH = R1_Z + 3 * R1_MAT, R1_BTT = R1_Z + 4 * R1_MAT, R1_KTT = R1_Z + 5 * R1_MAT, R1_VT = R1_Z + 6 * R1_MAT;
constexpr int R1_TII = R1_Z + 7 * R1_MAT;
constexpr int R1_TIIRSB = 48;
constexpr int R1_MD = R1_TII + 4 * 16 * R1_TIIRSB;
constexpr int R1_TOT = R1_MD + 4 * 16 * 17 * 4;
constexpr int R1_GC = R1_TOT + 8 * 64 * 4;
constexpr int R1_LDS = R1_GC + 256;
__device__ __forceinline__ float fexp(float x) { return __builtin_amdgcn_exp2f(x * 1.4426950408889634f); }
__device__ __forceinline__ float fsigmoid(float x) { return __builtin_amdgcn_rcpf(1.f + __builtin_amdgcn_exp2f(-1.4426950408889634f * x)); }
__device__ __forceinline__ float ftanh(float x) { return 1.f - 2.f * __builtin_amdgcn_rcpf(1.f + __builtin_amdgcn_exp2f(2.8853900817779268f * x)); }
#define R1_BAR() do { asm volatile("s_waitcnt lgkmcnt(0)" ::: "memory"); __builtin_amdgcn_s_barrier(); asm volatile("" ::: "memory"); } while (0)
struct RwkvW { const float *mu, *w0, *a0, *k_k, *k_a, *r_k; const bf16_t *w2T, *a2T, *g2T; };
struct RwkvChunkOut { bf16_t *Gp, *Qp, *HT, *ZT, *gate; float* bonus; unsigned* dbg; };
typedef unsigned u2v __attribute__((ext_vector_type(2)));
__device__ __forceinline__ bf16x8 mk8(u2v a, u2v b) { return __builtin_bit_cast(bf16x8, (v4u){a.x, a.y, b.x, b.y}); }
__device__ __forceinline__ bf16x8 packx(const f32x4& a, const f32x4& b) { return __builtin_bit_cast(bf16x8, (v4u){cvtpk(a[0], a[1]), cvtpk(a[2], a[3]), cvtpk(b[0], b[1]), cvtpk(b[2], b[3])}); }
#define MFMA16(a, b, c) __builtin_amdgcn_mfma_f32_16x16x32_bf16((a), (b), (c), 0, 0, 0)
__device__ __forceinline__ void rwkv_chunk_unit(LAS unsigned char* lds, int unit, const bf16_t* __restrict__ proj, const RwkvW& W0, const RwkvChunkOut& O) {
    int tid_ = threadIdx.x; asm volatile("" : "+v"(tid_));
    const int tid = tid_, lane = tid & 63, w = __builtin_amdgcn_readfirstlane(tid >> 6), li = lane & 15, g = lane >> 4;
    const int c = unit & 31, h = (unit >> 5) & 7, b = unit >> 8;
    const int tk = tid >> 3, sub = tid & 7;
    RwkvW W = W0;
    asm volatile("" : "+s"(W.mu), "+s"(W.w0), "+s"(W.a0), "+s"(W.k_k), "+s"(W.k_a), "+s"(W.r_k), "+s"(W.w2T), "+s"(W.a2T), "+s"(W.g2T));
    const size_t row = (size_t)b * SEQ + c * CHUNK + tk;
    const f32x4 z4 = {0.f, 0.f, 0.f, 0.f};
#define LDF(base, rsb, row0, k0) (*(const LAS bf16x8*)(lds + (base) + ((row0) + li) * (rsb) + ((k0) + 8 * g) * 2))
#define LDP(base, row0, pair) mk8(*(const LAS u2v*)(lds + (base) + ((row0) + li) * R1_RSB + (32 * (pair) + 4 * g) * 2), *(const LAS u2v*)(lds + (base) + ((row0) + li) * R1_RSB + (32 * (pair) + 16 + 4 * g) * 2))
    R1_BAR();
    float rr[8], kv[8], vv[8];
    {
        const bf16_t* pr = proj + row * IN_COLS; const bool has_prev = (c * CHUNK + tk) > 0; const bf16_t* pp = pr - IN_COLS;
        auto ld8 = [&](int col, float (&o)[8]) {
            const uint4 cu = *(const uint4*)(pr + col); uint4 pu = make_uint4(0, 0, 0, 0); if (has_prev) pu = *(const uint4*)(pp + col);
            const float4 m0 = *(const float4*)(W.mu + col), m1 = *(const float4*)(W.mu + col + 4);
            const unsigned cw[4] = {cu.x, cu.y, cu.z, cu.w}, pw[4] = {pu.x, pu.y, pu.z, pu.w}; const float mm[8] = {m0.x, m0.y, m0.z, m0.w, m1.x, m1.y, m1.z, m1.w};
#pragma unroll
            for (int i = 0; i < 4; ++i) { const float c0 = bf2f(cw[i] & 0xffffu), c1 = bf2f(cw[i] >> 16), p0 = bf2f(pw[i] & 0xffffu), p1 = bf2f(pw[i] >> 16);
                o[2 * i] = c0 + mm[2 * i] * (p0 - c0); o[2 * i + 1] = c1 + mm[2 * i + 1] * (p1 - c1); }
        };
        float t8[8];
        ld8(C_WD + sub * 8, t8);
        *(LAS v4u*)(lds + R1_TW + tk * R1_RSB + sub * 16) = (v4u){cvtpk(ftanh(t8[0]), ftanh(t8[1])), cvtpk(ftanh(t8[2]), ftanh(t8[3])), cvtpk(ftanh(t8[4]), ftanh(t8[5])), cvtpk(ftanh(t8[6]), ftanh(t8[7]))};
        ld8(C_AD + sub * 8, t8);
        *(LAS v4u*)(lds + R1_AD + tk * R1_RSB + sub * 16) = (v4u){cvtpk(t8[0], t8[1]), cvtpk(t8[2], t8[3]), cvtpk(t8[4], t8[5]), cvtpk(t8[6], t8[7])};
#pragma unroll
        for (int q = 0; q < 2; ++q) {
            ld8(C_GD + sub * 16 + q * 8, t8);
            *(LAS v4u*)(lds + R1_SG + tk * R1_SGRSB + sub * 32 + q * 16) = (v4u){cvtpk(fsigmoid(t8[0]), fsigmoid(t8[1])), cvtpk(fsigmoid(t8[2]), fsigmoid(t8[3])), cvtpk(fsigmoid(t8[4]), fsigmoid(t8[5])), cvtpk(fsigmoid(t8[6]), fsigmoid(t8[7]))};
        }
        ld8(C_R + h * 64 + sub * 8, rr); ld8(C_K + h * 64 + sub * 8, kv); ld8(C_V + h * 64 + sub * 8, vv);
#if defined(DBG_RWKV) && DBG_RWKV == 14
        {
            float n0 = 0.f, n1 = 0.f;
            for (int q = 0; q < 2; ++q) { ld8(C_GD + sub * 16 + q * 8, t8); for (int i = 0; i < 8; ++i) { if (!(fabsf(t8[i]) < 1e30f)) n0 += 1.f; else if (!(fabsf(sigmoidf_(t8[i])) < 1e30f)) n1 += 1.f; } }
            n0 = wave_sum(n0); n1 = wave_sum(n1);
            if (lane == 0 && h == 0) { atomicAdd((float*)(O.dbg + 528), n0); atomicAdd((float*)(O.dbg + 529), n1); }
        }
#endif
    }
    R1_BAR();
#if defined(DBG_RWKV) && DBG_RWKV == 14
    {
        float n2 = 0.f;
        for (int q = 0; q < 2; ++q) { const v4u u = *(const LAS v4u*)(lds + R1_SG + tk * R1_SGRSB + sub * 32 + q * 16); const unsigned w_[4] = {u.x, u.y, u.z, u.w};
            for (int i = 0; i < 4; ++i) { if ((w_[i] & 0x7f80u) == 0x7f80u) n2 += 1.f; if ((w_[i] & 0x7f800000u) == 0x7f800000u) n2 += 1.f; } }
        n2 = wave_sum(n2);
        if (lane == 0 && h == 0) atomicAdd((float*)(O.dbg + 530), n2);
    }
#endif
    {
        const int mb = w >> 1, nb0 = 2 * (w & 1);
        const bf16_t* w2r = W.w2T + (size_t)(h * 64 + 16 * mb + li) * 64 + 8 * g; const bf16_t* a2r = W.a2T + (size_t)(h * 64 + 16 * mb + li) * 64 + 8 * g;
        const bf16_t* g2r = W.g2T + (size_t)(h * 64 + 16 * mb + li) * 128 + 8 * g;
        bf16x8 wa[2], aa[2], ga[4];
#pragma unroll
        for (int ks = 0; ks < 2; ++ks) { wa[ks] = *(const bf16x8*)(w2r + 32 * ks); aa[ks] = *(const bf16x8*)(a2r + 32 * ks); }
#pragma unroll
        for (int ks = 0; ks < 4; ++ks) ga[ks] = *(const bf16x8*)(g2r + 32 * ks);
#pragma unroll
        for (int q = 0; q < 2; ++q) {
            const int nb = nb0 + q;
            f32x4 aw = z4, a_ = z4, ag = z4;
#pragma unroll
            for (int ks = 0; ks < 2; ++ks) { aw = MFMA16(wa[ks], LDF(R1_TW, R1_RSB, 16 * nb, 32 * ks), aw); a_ = MFMA16(aa[ks], LDF(R1_AD, R1_RSB, 16 * nb, 32 * ks), a_); }
#pragma unroll
            for (int ks = 0; ks < 4; ++ks) ag = MFMA16(ga[ks], LDF(R1_SG, R1_SGRSB, 16 * nb, 32 * ks), ag);
            const int t = 16 * nb + li, ch = 16 * mb + 4 * g;
            *(LAS f32x4*)(lds + R1_WL + (t * R1_FRS + ch) * 4) = aw;
            *(LAS f32x4*)(lds + R1_AL + (t * R1_FRS + ch) * 4) = a_;
            *(uint2*)(O.gate + ((size_t)b * SEQ + c * CHUNK + t) * RW + h * 64 + ch) = make_uint2(cvtpk(ag[0], ag[1]), cvtpk(ag[2], ag[3]));
#if defined(DBG_RWKV) && (DBG_RWKV == 12 || DBG_RWKV == 13)
            {
                const bf16x8 ones = __builtin_bit_cast(bf16x8, (v4u){0x3f803f80u, 0x3f803f80u, 0x3f803f80u, 0x3f803f80u});
                f32x4 t1 = z4, t2 = z4;
                for (int ks = 0; ks < 4; ++ks) { t1 = MFMA16(ones, LDF(R1_SG, R1_SGRSB, 16 * nb, 32 * ks), t1); t2 = MFMA16(ga[ks], ones, t2); }
                const size_t eo = ((size_t)b * SEQ + c * CHUNK + t) * RW + h * 64 + ch;
                *(uint2*)(O.Gp + eo) = make_uint2(cvtpk(t1[0], t1[1]), cvtpk(t1[2], t1[3]));
                *(uint2*)(O.Qp + eo) = make_uint2(cvtpk(t2[0], t2[1]), cvtpk(t2[2], t2[3]));
                *(uint2*)(O.HT + eo) = make_uint2(cvtpk(aw[0], aw[1]), cvtpk(aw[2], aw[3]));
            }
#endif
        }
    }
    R1_BAR();
    float ld_[8], av[8], kk[8], kp[8], Lc[8];
    {
        const int c0 = h * 64 + sub * 8;
        const f32x4 wl0 = *(const LAS f32x4*)(lds + R1_WL + (tk * R1_FRS + sub * 8) * 4), wl1 = *(const LAS f32x4*)(lds + R1_WL + (tk * R1_FRS + sub * 8 + 4) * 4);
        const f32x4 al0 = *(const LAS f32x4*)(lds + R1_AL + (tk * R1_FRS + sub * 8) * 4), al1 = *(const LAS f32x4*)(lds + R1_AL + (tk * R1_FRS + sub * 8 + 4) * 4);
        const float wl[8] = {wl0[0], wl0[1], wl0[2], wl0[3], wl1[0], wl1[1], wl1[2], wl1[3]}, al[8] = {al0[0], al0[1], al0[2], al0[3], al1[0], al1[1], al1[2], al1[3]};
        float ss = 0.f, bon = 0.f;
#pragma unroll
        for (int i = 0; i < 8; ++i) {
            const float xx = -(wl[i] + W.w0[c0 + i]); const float sp = (xx > 20.f) ? xx : __logf(1.f + fexp(xx));
            ld_[i] = -fexp(-sp - 0.5f);
            av[i] = fsigmoid(al[i] + W.a0[c0 + i]);
            kk[i] = kv[i] * W.k_k[c0 + i]; ss += kk[i] * kk[i];
            kp[i] = kv[i] * (1.f + (av[i] - 1.f) * W.k_a[c0 + i]);
            bon += rr[i] * kp[i] * W.r_k[c0 + i];
        }
        ss += __shfl_xor(ss, 1); ss += __shfl_xor(ss, 2); ss += __shfl_xor(ss, 4);
        bon += __shfl_xor(bon, 1); bon += __shfl_xor(bon, 2); bon += __shfl_xor(bon, 4);
        const float inv = __builtin_amdgcn_rsqf(fmaxf(ss, 1e-24f));
#pragma unroll
        for (int i = 0; i < 8; ++i) kk[i] *= inv;
        if (sub == 0) O.bonus[row * NH + h] = bon;
        const int tl = lane >> 3;
#pragma unroll
        for (int i = 0; i < 8; ++i) {
            float x = ld_[i];
            float y = __shfl_up(x, 8); if (tl >= 1) x += y;
            y = __shfl_up(x, 16); if (tl >= 2) x += y;
            y = __shfl_up(x, 32); if (tl >= 4) x += y;
            Lc[i] = x;
        }
        if (tl == 7) { *(LAS f32x4*)(lds + R1_TOT + (w * 64 + sub * 8) * 4) = (f32x4){Lc[0], Lc[1], Lc[2], Lc[3]}; *(LAS f32x4*)(lds + R1_TOT + (w * 64 + sub * 8 + 4) * 4) = (f32x4){Lc[4], Lc[5], Lc[6], Lc[7]}; }
    }
    R1_BAR();
    {
        float off[8], tot[8];
#pragma unroll
        for (int i = 0; i < 8; ++i) { off[i] = 0.f; tot[i] = 0.f; }
#pragma unroll
        for (int ww = 0; ww < 8; ++ww) {
            const f32x4 t0 = *(const LAS f32x4*)(lds + R1_TOT + (ww * 64 + sub * 8) * 4), t1 = *(const LAS f32x4*)(lds + R1_TOT + (ww * 64 + sub * 8 + 4) * 4);
            const float tt[8] = {t0[0], t0[1], t0[2], t0[3], t1[0], t1[1], t1[2], t1[3]};
#pragma unroll
            for (int i = 0; i < 8; ++i) { tot[i] += tt[i]; if (ww < w) off[i] += tt[i]; }
        }
        float ah[8], bh[8], kh[8], rh[8], bt[8], kt[8];
#pragma unroll
        for (int i = 0; i < 8; ++i) {
            const float L = Lc[i] + off[i];
            const float eL = fexp(L), eLx = fexp(L - ld_[i]), enL = fexp(-L), eCL = fexp(tot[i] - L);
            const float bb = kk[i] * av[i];
            ah[i] = -kk[i] * eLx; bh[i] = bb * enL; kh[i] = kp[i] * enL; rh[i] = rr[i] * eL; bt[i] = bb * eCL; kt[i] = kp[i] * eCL;
        }
        *(LAS v4u*)(lds + R1_AH + tk * R1_RSB + sub * 16) = (v4u){cvtpk(ah[0], ah[1]), cvtpk(ah[2], ah[3]), cvtpk(ah[4], ah[5]), cvtpk(ah[6], ah[7])};
        *(LAS v4u*)(lds + R1_BH + tk * R1_RSB + sub * 16) = (v4u){cvtpk(bh[0], bh[1]), cvtpk(bh[2], bh[3]), cvtpk(bh[4], bh[5]), cvtpk(bh[6], bh[7])};
        *(LAS v4u*)(lds + R1_KH + tk * R1_RSB + sub * 16) = (v4u){cvtpk(kh[0], kh[1]), cvtpk(kh[2], kh[3]), cvtpk(kh[4], kh[5]), cvtpk(kh[6], kh[7])};
        *(LAS v4u*)(lds + R1_RH + tk * R1_RSB + sub * 16) = (v4u){cvtpk(rh[0], rh[1]), cvtpk(rh[2], rh[3]), cvtpk(rh[4], rh[5]), cvtpk(rh[6], rh[7])};
#pragma unroll
        for (int i = 0; i < 8; ++i) {
            const int chn = sub * 8 + i;
            *(LAS unsigned short*)(lds + R1_BTT + chn * R1_RSB + tk * 2) = (unsigned short)f2bf(bt[i]);
            *(LAS unsigned short*)(lds + R1_KTT + chn * R1_RSB + tk * 2) = (unsigned short)f2bf(kt[i]);
            *(LAS unsigned short*)(lds + R1_VT + chn * R1_RSB + tk * 2) = (unsigned short)f2bf(vv[i]);
        }
        if (tk == 63) {
#pragma unroll
            for (int i = 0; i < 8; ++i) *(LAS float*)(lds + R1_GC + (sub * 8 + i) * 4) = fexp(tot[i]);
        }
    }
    R1_BAR();
    {
        const int mb = w >> 1, nb0 = 2 * (w & 1);
        const bf16x8 fa0 = LDF(R1_AH, R1_RSB, 16 * mb, 0), fa1 = LDF(R1_AH, R1_RSB, 16 * mb, 32), fr0 = LDF(R1_RH, R1_RSB, 16 * mb, 0), fr1 = LDF(R1_RH, R1_RSB, 16 * mb, 32);
#pragma unroll
        for (int q = 0; q < 2; ++q) {
            const int nb = nb0 + q;
            f32x4 mab = z4, mak = z4, nrb = z4, nrk = z4;
            if (nb <= mb) {
                const bf16x8 fb0 = LDF(R1_BH, R1_RSB, 16 * nb, 0), fb1 = LDF(R1_BH, R1_RSB, 16 * nb, 32), fk0 = LDF(R1_KH, R1_RSB, 16 * nb, 0), fk1 = LDF(R1_KH, R1_RSB, 16 * nb, 32);
                mab = MFMA16(fa0, fb0, mab); mab = MFMA16(fa1, fb1, mab); mak = MFMA16(fa0, fk0, mak); mak = MFMA16(fa1, fk1, mak);
                nrb = MFMA16(fr0, fb0, nrb); nrb = MFMA16(fr1, fb1, nrb); nrk = MFMA16(fr0, fk0, nrk); nrk = MFMA16(fr1, fk1, nrk);
            }
            const int s = 16 * nb + li;
#pragma unroll
            for (int r = 0; r < 4; ++r) {
                const int t = 16 * mb + 4 * g + r; const bool lo = s < t, le = s <= t;
                const float m1 = lo ? mab[r] : 0.f, m2 = lo ? mak[r] : 0.f, n1 = le ? nrb[r] : 0.f, n2 = le ? nrk[r] : 0.f;
                *(LAS unsigned short*)(lds + R1_MAB + t * R1_RSB + s * 2) = (unsigned short)f2bf(m1);
                *(LAS unsigned short*)(lds + R1_MAK + t * R1_RSB + s * 2) = (unsigned short)f2bf(m2);
                *(LAS unsigned short*)(lds + R1_NRB + t * R1_RSB + s * 2) = (unsigned short)f2bf(n1);
                *(LAS unsigned short*)(lds + R1_NRK + t * R1_RSB + s * 2) = (unsigned short)f2bf(n2);
                if (nb == mb) *(LAS float*)(lds + R1_MD + ((mb * 16 + 4 * g + r) * 17 + li) * 4) = m1;
            }
        }
    }
    R1_BAR();
    f32x4 acc[4];
    if (w == 0) {
        float T[16];
        const LAS float* md = (const LAS float*)(lds + R1_MD) + g * 16 * 17;
#pragma unroll
        for (int r = 0; r < 16; ++r) {
            float a = (r == li) ? 1.f : 0.f;
#pragma unroll
            for (int s = 0; s < r; ++s) a += md[r * 17 + s] * T[s];
            T[r] = a;
            *(LAS unsigned short*)(lds + R1_TII + (g * 16 + r) * R1_TIIRSB + li * 2) = (unsigned short)f2bf(a);
        }
    }
    if (w >= 4) {
        const int vb = w - 4;
#pragma unroll
        for (int mb = 0; mb < 4; ++mb) { acc[mb] = z4;
#pragma unroll
            for (int ks = 0; ks < 2; ++ks) acc[mb] = MFMA16(LDF(R1_MAK, R1_RSB, 16 * mb, 32 * ks), LDF(R1_VT, R1_RSB, 16 * vb, 32 * ks), acc[mb]); }
    } else {
#pragma unroll
        for (int mb = 0; mb < 4; ++mb)
#pragma unroll
            for (int r = 0; r < 4; ++r) acc[mb][r] = bf2f(*(const LAS unsigned short*)(lds + R1_AH + (16 * mb + 4 * g + r) * R1_RSB + (16 * w + li) * 2));
    }
    R1_BAR();
    f32x4 X0, X1, X2, X3;
    {
#define LDT(i) mk8(*(const LAS u2v*)(lds + R1_TII + ((i) * 16 + li) * R1_TIIRSB + 8 * g), (u2v){0u, 0u})
#define LDM1(i, j) mk8(*(const LAS u2v*)(lds + R1_MAB + (16 * (i) + li) * R1_RSB + (16 * (j) + 4 * g) * 2), (u2v){0u, 0u})
        X0 = MFMA16(LDT(0), packx(acc[0], z4), z4);
        f32x4 a1 = MFMA16(LDM1(1, 0), packx(X0, z4), acc[1]);
        X1 = MFMA16(LDT(1), packx(a1, z4), z4);
        f32x4 a2 = MFMA16(LDP(R1_MAB, 32, 0), packx(X0, X1), acc[2]);
        X2 = MFMA16(LDT(2), packx(a2, z4), z4);
        f32x4 a3 = MFMA16(LDP(R1_MAB, 48, 0), packx(X0, X1), acc[3]);
        a3 = MFMA16(LDM1(3, 2), packx(X2, z4), a3);
        X3 = MFMA16(LDT(3), packx(a3, z4), z4);
    }
    const bf16x8 x01 = packx(X0, X1), x23 = packx(X2, X3);
#if defined(DBG_RWKV) && (DBG_RWKV == 12 || DBG_RWKV == 13)
    return;
#endif
    const size_t ub = (size_t)unit * 4096;
    if (w < 4) {
        const int kb = w, pos = 32 * (kb >> 1) + 8 * g + 4 * (kb & 1);
#pragma unroll
        for (int nb = 0; nb < 4; ++nb) {
            f32x4 ag = z4;
            if (nb == kb) {
#pragma unroll
                for (int r = 0; r < 4; ++r) if (li == 4 * g + r) ag[r] = *(const LAS float*)(lds + R1_GC + (16 * kb + 4 * g + r) * 4);
            }
            ag = MFMA16(x01, LDP(R1_BTT, 16 * nb, 0), ag); ag = MFMA16(x23, LDP(R1_BTT, 16 * nb, 1), ag);
            *(uint2*)(O.Gp + ub + (size_t)(16 * nb + li) * 64 + pos) = make_uint2(cvtpk(ag[0], ag[1]), cvtpk(ag[2], ag[3]));
            const u2v rq = *(const LAS u2v*)(lds + R1_RH + (16 * nb + li) * R1_RSB + (16 * kb + 4 * g) * 2);
            f32x4 aq = {bf2f(rq.x & 0xffffu), bf2f(rq.x >> 16), bf2f(rq.y & 0xffffu), bf2f(rq.y >> 16)};
            aq = MFMA16(x01, LDP(R1_NRB, 16 * nb, 0), aq); aq = MFMA16(x23, LDP(R1_NRB, 16 * nb, 1), aq);
            *(uint2*)(O.Qp + ub + (size_t)(16 * nb + li) * 64 + pos) = make_uint2(cvtpk(aq[0], aq[1]), cvtpk(aq[2], aq[3]));
        }
    } else {
        const int vb = w - 4;
        const bf16x8 fv0 = LDF(R1_VT, R1_RSB, 16 * vb, 0), fv1 = LDF(R1_VT, R1_RSB, 16 * vb, 32);
#pragma unroll
        for (int mb = 0; mb < 4; ++mb) {
            f32x4 az = z4;
            az = MFMA16(LDP(R1_NRB, 16 * mb, 0), x01, az); az = MFMA16(LDP(R1_NRB, 16 * mb, 1), x23, az);
            az = MFMA16(LDF(R1_NRK, R1_RSB, 16 * mb, 0), fv0, az); az = MFMA16(LDF(R1_NRK, R1_RSB, 16 * mb, 32), fv1, az);
            *(uint2*)(O.ZT + ub + (size_t)(16 * vb + li) * 64 + 16 * mb + 4 * g) = make_uint2(cvtpk(az[0], az[1]), cvtpk(az[2], az[3]));
            f32x4 ah_ = z4;
            ah_ = MFMA16(LDP(R1_BTT, 16 * mb, 0), x01, ah_); ah_ = MFMA16(LDP(R1_BTT, 16 * mb, 1), x23, ah_);
            ah_ = MFMA16(LDF(R1_KTT, R1_RSB, 16 * mb, 0), fv0, ah_); ah_ = MFMA16(LDF(R1_KTT, R1_RSB, 16 * mb, 32), fv1, ah_);
            *(uint2*)(O.HT + ub + (size_t)(16 * vb + li) * 64 + 16 * mb + 4 * g) = make_uint2(cvtpk(ah_[0], ah_[1]), cvtpk(ah_[2], ah_[3]));
        }
    }
#undef LDT
#undef LDM1
#undef LDF
#undef LDP
}
constexpr int R2_YRS = 65;
constexpr int R2_SLOT = 32768;
constexpr int R2_YOFF = 2 * R2_SLOT;
constexpr int R2_LDS = R2_YOFF + 2 * 64 * R2_YRS * 4;
struct RwkvScanIn { const bf16_t *Gp, *Qp, *HT, *ZT, *gate; const float* bonus; const float *mu, *ln_w, *ln_b; };
struct ChunkFrags { bf16x8 G[4][2], Q[4][2]; uint2 H[4], Z[4]; };
__device__ __forceinline__ void r2_load(ChunkFrags& F, const LAS unsigned char* slot, int vb, int li, int g) {
#pragma unroll
    for (int mb = 0; mb < 4; ++mb) {
        const int row = 16 * mb + li, sw = row & 7;
#pragma unroll
        for (int p = 0; p < 2; ++p) { const int ch = (4 * p + g) ^ sw; F.G[mb][p] = *(const LAS bf16x8*)(slot + row * 128 + ch * 16); F.Q[mb][p] = *(const LAS bf16x8*)(slot + 8192 + row * 128 + ch * 16); }
        const int rv = 16 * vb + li, chv = (2 * mb + (g >> 1)) ^ (rv & 7);
        const u2v hh = *(const LAS u2v*)(slot + 16384 + rv * 128 + chv * 16 + 8 * (g & 1)), zz = *(const LAS u2v*)(slot + 24576 + rv * 128 + chv * 16 + 8 * (g & 1));
        F.H[mb] = make_uint2(hh.x, hh.y); F.Z[mb] = make_uint2(zz.x, zz.y);
    }
}
__device__ __forceinline__ void r2_stage_load(uint4 (&st)[8], const RwkvScanIn& I, size_t ub, int lt) {
    const int row = lt >> 3, ch = lt & 7; const size_t eo = ub + (size_t)row * 64 + ch * 8 + (size_t)0;
    st[0] = *(const uint4*)(I.Gp + eo); st[1] = *(const uint4*)(I.Gp + eo + 32 * 64);
    st[2] = *(const uint4*)(I.Qp + eo); st[3] = *(const uint4*)(I.Qp + eo + 32 * 64);
    st[4] = *(const uint4*)(I.HT + eo); st[5] = *(const uint4*)(I.HT + eo + 32 * 64);
    st[6] = *(const uint4*)(I.ZT + eo); st[7] = *(const uint4*)(I.ZT + eo + 32 * 64);
}
__device__ __forceinline__ void r2_stage_write(const uint4 (&st)[8], LAS unsigned char* slot, int lt) {
    const int row = lt >> 3, ch = lt & 7;
#pragma unroll
    for (int i = 0; i < 8; ++i) { const int r = row + 32 * (i & 1), m = i >> 1; *(LAS v4u*)(slot + m * 8192 + r * 128 + ((ch ^ (r & 7)) * 16)) = (v4u){st[i].x, st[i].y, st[i].z, st[i].w}; }
}
__device__ __forceinline__ f32x4 bf4(uint2 u) { return (f32x4){bf2f(u.x & 0xffffu), bf2f(u.x >> 16), bf2f(u.y & 0xffffu), bf2f(u.y >> 16)}; }
__device__ __forceinline__ void r2_step(const ChunkFrags& F, f32x4 (&S)[4], bf16x8& s01, bf16x8& s23, LAS float* ybuf, int vb, int li, int g) {
    f32x4 Sn[4];
#pragma unroll
    for (int mb = 0; mb < 4; ++mb) {
        f32x4 y = bf4(F.Z[mb]);
        y = MFMA16(F.Q[mb][0], s01, y); y = MFMA16(F.Q[mb][1], s23, y);
#pragma unroll
        for (int r = 0; r < 4; ++r) ybuf[(16 * mb + 4 * g + r) * R2_YRS + 16 * vb + li] = y[r];
        f32x4 s = bf4(F.H[mb]);
        s = MFMA16(F.G[mb][0], s01, s); s = MFMA16(F.G[mb][1], s23, s);
        Sn[mb] = s;
    }
#pragma unroll
    for (int mb = 0; mb < 4; ++mb) S[mb] = Sn[mb];
    s01 = packx(S[0], S[1]); s23 = packx(S[2], S[3]);
}
struct EpiIn { uint4 cu[2], pu[2], gu[2]; float bon; };
__device__ __forceinline__ void r2_epi_load(EpiIn& E, int et, size_t row, int h, bool has_prev, const bf16_t* __restrict__ proj, const RwkvScanIn& I) {
    const int q4 = et & 3, c0 = h * 64 + q4 * 16;
    const bf16_t* pr = proj + row * IN_COLS + C_V + c0;
#pragma unroll
    for (int i = 0; i < 2; ++i) { E.cu[i] = *(const uint4*)(pr + 8 * i); E.pu[i] = make_uint4(0, 0, 0, 0); if (has_prev) E.pu[i] = *(const uint4*)(pr - IN_COLS + 8 * i); E.gu[i] = *(const uint4*)(I.gate + row * RW + c0 + 8 * i); }
    E.bon = I.bonus[row * NH + h];
}
__device__ __forceinline__ void r2_epilogue(const EpiIn& E, const LAS float* ybuf, int et, size_t row, int h, const RwkvScanIn& I, bf16_t* ymix) {
    const int t = et >> 2, q4 = et & 3, c0 = h * 64 + q4 * 16;
    float y[16]; float s1 = 0.f;
#pragma unroll
    for (int i = 0; i < 16; ++i) { y[i] = ybuf[t * R2_YRS + q4 * 16 + i]; s1 += y[i]; }
    s1 += __shfl_xor(s1, 1); s1 += __shfl_xor(s1, 2);
    const float mean = s1 * (1.f / 64.f); float s2 = 0.f;
#pragma unroll
    for (int i = 0; i < 16; ++i) { const float d = y[i] - mean; s2 += d * d; }
    s2 += __shfl_xor(s2, 1); s2 += __shfl_xor(s2, 2);
    const float rstd = rsqrtf(s2 * (1.f / 64.f) + GN_EPS);
    unsigned ow[8];
#pragma unroll
    for (int i = 0; i < 2; ++i) {
        const unsigned cw[4] = {E.cu[i].x, E.cu[i].y, E.cu[i].z, E.cu[i].w}, pw[4] = {E.pu[i].x, E.pu[i].y, E.pu[i].z, E.pu[i].w}, gw_[4] = {E.gu[i].x, E.gu[i].y, E.gu[i].z, E.gu[i].w};
#pragma unroll
        for (int j = 0; j < 4; ++j) {
            float o2[2];
#pragma unroll
            for (int u = 0; u < 2; ++u) {
                const int ci = c0 + 8 * i + 2 * j + u, yi = 8 * i + 2 * j + u;
                const float cur = bf2f(u ? (cw[j] >> 16) : (cw[j] & 0xffffu)), prev = bf2f(u ? (pw[j] >> 16) : (pw[j] & 0xffffu)), gt = bf2f(u ? (gw_[j] >> 16) : (gw_[j] & 0xffffu));
                const float vsh = cur + I.mu[C_V + ci] * (prev - cur);
                o2[u] = ((y[yi] - mean) * rstd * I.ln_w[ci] + I.ln_b[ci] + E.bon * vsh) * gt;
            }
            ow[4 * i + j] = pk2(o2[0], o2[1]);
        }
    }
    *(uint4*)(ymix + row * D_MODEL + c0) = make_uint4(ow[0], ow[1], ow[2], ow[3]);
    *(uint4*)(ymix + row * D_MODEL + c0 + 8) = make_uint4(ow[4], ow[5], ow[6], ow[7]);
}
__device__ __forceinline__ void rwkv_scan_unit(LAS unsigned char* lds, int unit  , const bf16_t* __restrict__ proj, const RwkvScanIn& I0, bf16_t* ymix) {
    int tid_ = threadIdx.x; asm volatile("" : "+v"(tid_));
    const int tid = tid_, lane = tid & 63, w = __builtin_amdgcn_readfirstlane(tid >> 6), li = lane & 15, g = lane >> 4;
    const int b = unit >> 3, h = unit & 7;
    RwkvScanIn I = I0;
    asm volatile("" : "+s"(I.Gp), "+s"(I.Qp), "+s"(I.HT), "+s"(I.ZT), "+s"(I.gate), "+s"(I.bonus), "+s"(I.mu), "+s"(I.ln_w), "+s"(I.ln_b));
    LAS float* ybase = (LAS float*)(lds + R2_YOFF);
#define R2_BAR() do { asm volatile("s_waitcnt lgkmcnt(0)" ::: "memory"); __builtin_amdgcn_s_barrier(); asm volatile("" ::: "memory"); } while (0)
    const size_t ub0 = (size_t)unit * NCHUNK * 4096;
    __syncthreads();
    if (w < 4) {
        const int vb = w;
        f32x4 S[4];
#pragma unroll
        for (int mb = 0; mb < 4; ++mb) S[mb] = (f32x4){0.f, 0.f, 0.f, 0.f};
        bf16x8 s01 = packx(S[0], S[1]), s23 = s01;
        ChunkFrags F;
        R2_BAR();
#pragma unroll 1
        for (int c = 0; c < NCHUNK; c += 2) {
            r2_load(F, lds, vb, li, g);
            r2_step(F, S, s01, s23, ybase, vb, li, g);
            R2_BAR();
            r2_load(F, lds + R2_SLOT, vb, li, g);
            r2_step(F, S, s01, s23, ybase + 64 * R2_YRS, vb, li, g);
            R2_BAR();
        }
    } else {
        const int et = tid - 256;
        uint4 st[8];
        EpiIn EA, EB;
        r2_stage_load(st, I, ub0, et);
        r2_epi_load(EA, et, (size_t)b * SEQ + (et >> 2), h, (et >> 2) > 0, proj, I);
        r2_stage_write(st, lds, et);
        r2_stage_load(st, I, ub0 + 4096, et);
        R2_BAR();
#pragma unroll 1
        for (int c = 0; c < NCHUNK; c += 2) {
            const int tl = c * CHUNK + (et >> 2);
            r2_stage_write(st, lds + R2_SLOT, et);
            if (c + 2 < NCHUNK) r2_stage_load(st, I, ub0 + (size_t)(c + 2) * 4096, et);
            r2_epi_load(EB, et, (size_t)b * SEQ + tl + CHUNK, h, true, proj, I);
            R2_BAR();
            r2_epilogue(EA, ybase, et, (size_t)b * SEQ + tl, h, I, ymix);
            if (c + 2 < NCHUNK) { r2_stage_write(st, lds, et); r2_stage_load(st, I, ub0 + (size_t)(c + 3) * 4096, et); r2_epi_load(EA, et, (size_t)b * SEQ + tl + 2 * CHUNK, h, true, proj, I); }
            R2_BAR();
            r2_epilogue(EB, ybase + 64 * R2_YRS, et, (size_t)b * SEQ + tl + CHUNK, h, I, ymix);
        }
    }
    asm volatile("s_waitcnt vmcnt(0)" ::: "memory");
#undef R2_BAR
}
#ifdef DBG_RWKV
struct RwkvParams { const float *mu, *w0, *w2, *a0, *a2, *g2, *k_k, *k_a, *r_k, *ln_w, *ln_b; };
constexpr int RWKV_LDS = (7 * 4096 + 8192 + 64) * 4;
__device__ __forceinline__ void rwkv_naive_unit(float* sm, int unit, const bf16_t* __restrict__ proj, const RwkvParams& P0, bf16_t* ymix) {
    float* sR = sm; float* sDEC = sm + 4096; float* sKP = sm + 2 * 4096; float* sV = sm + 3 * 4096; float* sKK = sm + 4 * 4096; float* sKKA = sm + 5 * 4096; float* sG = sm + 6 * 4096;
    float* sST = sm + 7 * 4096;
    float* sBON = sST + 8192;
    int tid_ = threadIdx.x; asm volatile("" : "+v"(tid_));
    const int tid = tid_, b = unit >> 3, h = unit & 7;
    const int tk = tid >> 3, sub = tid & 7;
    float S[8];
#pragma unroll
    for (int i = 0; i < 8; ++i) S[i] = 0.f;
#pragma unroll 1
    for (int cb = 0; cb < NCHUNK; ++cb) {
        const int t0 = cb * CHUNK;
        RwkvParams P = P0;
        asm volatile("" : "+s"(P.mu), "+s"(P.w0), "+s"(P.w2), "+s"(P.a0), "+s"(P.a2), "+s"(P.g2));
        asm volatile("" : "+s"(P.k_k), "+s"(P.k_a), "+s"(P.r_k), "+s"(P.ln_w), "+s"(P.ln_b));
        const size_t row = (size_t)b * SEQ + t0 + tk;
        const bf16_t* pr = proj + row * IN_COLS;
        const bool has_prev = (t0 + tk) > 0;
        const bf16_t* pp = pr - IN_COLS;
        auto shifted = [&](int col) -> float { const float cur = bf2f(pr[col]); const float prev = has_prev ? bf2f(pp[col]) : 0.f; return cur + P.mu[col] * (prev - cur); };
#pragma unroll
        for (int i = 0; i < 8; ++i) { const int j = sub * 8 + i; sST[tk * 128 + j] = tanhf(shifted(C_WD + j)); }
        __syncthreads();
        float av[8];
        {
            float acc[8];
#pragma unroll
            for (int i = 0; i < 8; ++i) acc[i] = P.w0[h * 64 + sub * 8 + i];
#pragma unroll 2
            for (int j = 0; j < 64; ++j) { const float t = sST[tk * 128 + j]; const float* wr = P.w2 + (size_t)j * RW + h * 64 + sub * 8;
#pragma unroll
                for (int i = 0; i < 8; ++i) acc[i] += t * wr[i]; }
#pragma unroll
            for (int i = 0; i < 8; ++i) { const float xx = -acc[i]; const float sp = (xx > 20.f) ? xx : log1pf(__expf(xx)); const float w = -sp - 0.5f; sDEC[tk * 64 + sub * 8 + i] = __expf(-__expf(w)); }
        }
        __syncthreads();
#pragma unroll
        for (int i = 0; i < 8; ++i) { const int j = sub * 8 + i; sST[tk * 128 + j] = shifted(C_AD + j); }
        __syncthreads();
        {
            float acc[8];
#pragma unroll
            for (int i = 0; i < 8; ++i) acc[i] = P.a0[h * 64 + sub * 8 + i];
#pragma unroll 2
            for (int j = 0; j < 64; ++j) { const float t = sST[tk * 128 + j]; const float* wr = P.a2 + (size_t)j * RW + h * 64 + sub * 8;
#pragma unroll
                for (int i = 0; i < 8; ++i) acc[i] += t * wr[i]; }
#pragma unroll
            for (int i = 0; i < 8; ++i) av[i] = sigmoidf_(acc[i]);
        }
        __syncthreads();
#pragma unroll
        for (int i = 0; i < 16; ++i) { const int j = sub * 16 + i; sST[tk * 128 + j] = sigmoidf_(shifted(C_GD + j)); }
        __syncthreads();
        {
            float acc[8];
#pragma unroll
            for (int i = 0; i < 8; ++i) acc[i] = 0.f;
#pragma unroll 2
            for (int j = 0; j < 128; ++j) { const float t = sST[tk * 128 + j]; const float* wr = P.g2 + (size_t)j * RW + h * 64 + sub * 8;
#pragma unroll
                for (int i = 0; i < 8; ++i) acc[i] += t * wr[i]; }
#pragma unroll
            for (int i = 0; i < 8; ++i) sG[tk * 64 + sub * 8 + i] = acc[i];
        }
        {
            float rr[8], kv[8], vv[8], kk[8], kp[8]; float ss = 0.f, bon = 0.f;
#pragma unroll
            for (int i = 0; i < 8; ++i) {
                const int c = h * 64 + sub * 8 + i;
                rr[i] = shifted(C_R + c); kv[i] = shifted(C_K + c); vv[i] = shifted(C_V + c);
                kk[i] = kv[i] * P.k_k[c]; ss += kk[i] * kk[i];
                kp[i] = kv[i] * (1.f + (av[i] - 1.f) * P.k_a[c]);
                bon += rr[i] * kp[i] * P.r_k[c];
            }
            ss += __shfl_xor(ss, 1); ss += __shfl_xor(ss, 2); ss += __shfl_xor(ss, 4);
            bon += __shfl_xor(bon, 1); bon += __shfl_xor(bon, 2); bon += __shfl_xor(bon, 4);
            const float inv = 1.f / fmaxf(sqrtf(ss), 1e-12f);
#pragma unroll
            for (int i = 0; i < 8; ++i) {
                const int o = tk * 64 + sub * 8 + i; const float kn = kk[i] * inv;
                sR[o] = rr[i]; sKP[o] = kp[i]; sV[o] = vv[i]; sKK[o] = kn; sKKA[o] = kn * av[i];
            }
            if (sub == 0) sBON[tk] = bon;
        }
        __syncthreads();
#pragma unroll 1
        for (int t = 0; t < CHUNK; ++t) {
            const float* dk = sDEC + t * 64 + sub * 8; const float* kkp = sKK + t * 64 + sub * 8; const float* kap = sKKA + t * 64 + sub * 8;
            const float* kpp = sKP + t * 64 + sub * 8; const float* rp = sR + t * 64 + sub * 8;
            float sa = 0.f;
#pragma unroll
            for (int i = 0; i < 8; ++i) sa -= S[i] * kkp[i];
            sa += __shfl_xor(sa, 1); sa += __shfl_xor(sa, 2); sa += __shfl_xor(sa, 4);
            const float vt = sV[t * 64 + tk];
            float y = 0.f;
#pragma unroll
            for (int i = 0; i < 8; ++i) { S[i] = S[i] * dk[i] + sa * kap[i] + vt * kpp[i]; y += S[i] * rp[i]; }
            y += __shfl_xor(y, 1); y += __shfl_xor(y, 2); y += __shfl_xor(y, 4);
            if (sub == 0) sST[t * 64 + tk] = y;
        }
        __syncthreads();
        {
            float yv[8]; float s1 = 0.f;
#pragma unroll
            for (int i = 0; i < 8; ++i) { yv[i] = sST[tk * 64 + sub * 8 + i]; s1 += yv[i]; }
            s1 += __shfl_xor(s1, 1); s1 += __shfl_xor(s1, 2); s1 += __shfl_xor(s1, 4);
            const float mean = s1 * (1.f / 64.f); float s2 = 0.f;
#pragma unroll
            for (int i = 0; i < 8; ++i) { const float d = yv[i] - mean; s2 += d * d; }
            s2 += __shfl_xor(s2, 1); s2 += __shfl_xor(s2, 2); s2 += __shfl_xor(s2, 4);
            const float rstd = rsqrtf(s2 * (1.f / 64.f) + GN_EPS); const float bon = sBON[tk];
            unsigned pk[4];
#pragma unroll
            for (int i = 0; i < 8; i += 2) {
                float o[2];
#pragma unroll
                for (int u = 0; u < 2; ++u) { const int c = h * 64 + sub * 8 + i + u; const int o_ = tk * 64 + sub * 8 + i + u;
                    o[u] = ((yv[i + u] - mean) * rstd * P.ln_w[c] + P.ln_b[c] + bon * sV[o_]) * sG[o_]; }
                pk[i >> 1] = pk2(o[0], o[1]);
            }
            *(uint4*)(ymix + row * D_MODEL + h * 64 + sub * 8) = make_uint4(pk[0], pk[1], pk[2], pk[3]);
        }
        __syncthreads();
    }
}

#endif
constexpr int LDS_PHASE_BYTES = 150 * 1024;
constexpr int LDSCTL_OFF = LDS_PHASE_BYTES;
constexpr int LDS_BYTES = LDS_PHASE_BYTES + 1024;
#ifdef DBG_RWKV
static_assert(RWKV_LDS <= LDS_PHASE_BYTES, "dbg");
#endif
static_assert(R1_LDS <= LDS_PHASE_BYTES && R2_LDS <= LDS_PHASE_BYTES && pg8::STAGE_BYTES <= LDS_PHASE_BYTES && ATT_LDS <= LDS_PHASE_BYTES, "LDS map");

struct Args {
    const float* in[26]; float* out; unsigned char* ws;
};
static_assert(sizeof(Args) == 28 * 8, "Args has no padding");

__global__ void __launch_bounds__(NTHREADS, 2) mega_fwd(Args args) {
    extern __shared__ __attribute__((aligned(16))) unsigned char lds[];
    LAS unsigned char* ldsp = (LAS unsigned char*)lds;
    const int G = gridDim.x, bid = blockIdx.x;
#define IDS() int tid = threadIdx.x; asm volatile("" : "+v"(tid)); const int lane = tid & 63, wave = __builtin_amdgcn_readfirstlane(tid >> 6), gw = bid * NWAVES + wave, ngw = G * NWAVES; (void)lane; (void)gw; (void)ngw
    typedef const __attribute__((address_space(4))) Args* KArgs;
#define KA() ({ KArgs _p = (KArgs)__builtin_amdgcn_kernarg_segment_ptr(); asm volatile("" : "+s"(_p)); _p; })
#define IN(i) (KA()->in[i])
#define WSP(off) (KA()->ws + (off))
#define OUTP() (KA()->out)
    { IDS(); for (int u = tid; u < (LDS_BYTES - LDSCTL_OFF) / 4; u += NTHREADS) ((LAS unsigned*)(ldsp + LDSCTL_OFF))[u] = 0u; }
    __syncthreads();
    XcdBarrier bar = xcd_barrier_post((unsigned*)((gu32*)WSP(WS_CTL) + CW_BAR), (volatile LAS unsigned*)(ldsp + LDSCTL_OFF));
#define GRID_BAR() xcd_barrier(bar)
    constexpr int CW_QUEUE = 8192;
#ifndef PROF_PHASE
#define PROF_PHASE -1
#endif
#define PROF_REP(k) ((PROF_PHASE == (k)) ? 1 + PROF_EXTRA : 1)
#ifndef PROF_EXTRA
#define PROF_EXTRA 1
#endif
    enum { I_X = 0, I_NMG, I_WIN, I_MU, I_W0, I_W2, I_A0, I_A2, I_G2, I_KK, I_KA, I_RK, I_LNW, I_LNB, I_RELB, I_ANG, I_WOUT, I_NFG, I_FWG, I_FWU, I_FWD, I_ROUTER, I_MWG, I_MWU, I_MWD, I_NFINAL };

    for (int rep_ = 0; rep_ < PROF_REP(0); ++rep_) {
    {
        IDS();
        LAS float* scr = (LAS float*)(ldsp + wave * 16384);
        constexpr int I_IN = (D_MODEL / 64) * (IN_COLS / 32), I_OUT = (D_MODEL / 64) * (D_MODEL / 32), I_FG = (D_MODEL / 64) * (D_FF / 32), I_FD = (D_FF / 64) * (D_MODEL / 32);
        constexpr int I_MG = (D_MODEL / 64) * (D_FFE / 32), I_MD = (D_FFE / 64) * (D_MODEL / 32);
        constexpr int NITEMS = 2 * I_IN + 2 * I_OUT + 2 * I_FG + I_FD;
#pragma unroll 1
        for (int it = gw; it < NITEMS; it += ngw) {
            int r = it;
            if (r < 2 * I_IN) { const int l = r / I_IN; p0_transpose_item(IN(I_WIN) + (size_t)l * D_MODEL * IN_COLS, D_MODEL, IN_COLS, (bf16_t*)WSP(WS_WIN) + (size_t)l * IN_COLS * D_MODEL, 0, 1, scr, r % I_IN, lane); continue; } r -= 2 * I_IN;
            if (r < 2 * I_OUT) { const int l = r / I_OUT; p0_transpose_item(IN(I_WOUT) + (size_t)l * D_MODEL * D_MODEL, D_MODEL, D_MODEL, (bf16_t*)WSP(WS_WOUT) + (size_t)l * D_MODEL * D_MODEL, 0, 1, scr, r % I_OUT, lane); continue; } r -= 2 * I_OUT;
            if (r < I_FG) { p0_transpose_item(IN(I_FWG), D_MODEL, D_FF, (bf16_t*)WSP(WS_FGU), 0, 2, scr, r, lane); continue; } r -= I_FG;
            if (r < I_FG) { p0_transpose_item(IN(I_FWU), D_MODEL, D_FF, (bf16_t*)WSP(WS_FGU), 1, 2, scr, r, lane); continue; } r -= I_FG;
            p0_transpose_item(IN(I_FWD), D_FF, D_MODEL, (bf16_t*)WSP(WS_FDN), 0, 1, scr, r, lane);
        }
        {
            const int gt = bid * NTHREADS + tid, ngt = G * NTHREADS;
            const float* w2 = IN(I_W2); const float* a2 = IN(I_A2); const float* g2 = IN(I_G2);
            bf16_t* w2T = (bf16_t*)WSP(WS_LORA + LORA_W2T); bf16_t* a2T = (bf16_t*)WSP(WS_LORA + LORA_A2T); bf16_t* g2T = (bf16_t*)WSP(WS_LORA + LORA_G2T);
            for (int i = gt; i < 2 * 512 * 64; i += ngt) { const int l = i >> 15, r = i & 32767, ch = r >> 6, j = r & 63; w2T[i] = (bf16_t)f2bf(w2[l * 32768 + j * 512 + ch]); a2T[i] = (bf16_t)f2bf(a2[l * 32768 + j * 512 + ch]); }
            for (int i = gt; i < 2 * 512 * 128; i += ngt) { const int l = i >> 16, r = i & 65535, ch = r >> 7, j = r & 127; g2T[i] = (bf16_t)f2bf(g2[l * 65536 + j * 512 + ch]); }
        }
        { IDS(); norm_rows<0>(gw, ngw, lane, IN(I_X), IN(I_NMG), (bf16_t*)WSP(WS_XN), nullptr, nullptr, nullptr, nullptr); }
    }
    }
    for (int rep_ = 1; rep_ < PROF_REP(13); ++rep_) GRID_BAR();
    for (int rep_ = 1; rep_ < PROF_REP(14); ++rep_) cg::this_grid().sync();
    cg::this_grid().sync();

#pragma unroll 1
    for (int l = 0; l < 2; ++l) {
        for (int rep_ = 0; rep_ < ((l == 0) ? PROF_REP(1) : 1); ++rep_) {
        {
            pg8::Gemm g{(bf16_t*)WSP(WS_XN), (bf16_t*)WSP(WS_WIN) + (size_t)l * IN_COLS * D_MODEL, TOK, IN_COLS, D_MODEL}; pg8::StaticOrder S; S.init(TOK, IN_COLS, G, bid);
            pg8::EpiBf16 E{(bf16_t*)WSP(WS_PROJ), IN_COLS};
            pg8::gemm_phase<pg8::EpiBf16, pg8::StaticOrder, true, true>(ldsp, g, S, E);
        }
        GRID_BAR();
        }
        for (int rep_ = 0; rep_ < ((l == 0) ? PROF_REP(2) : 1); ++rep_) {
        {
            RwkvW Wt{IN(I_MU) + l * SHIFT_COLS, IN(I_W0) + l * RW, IN(I_A0) + l * RW, IN(I_KK) + l * RW, IN(I_KA) + l * RW, IN(I_RK) + l * RW,
                     (const bf16_t*)WSP(WS_LORA + LORA_W2T) + (size_t)l * 512 * 64, (const bf16_t*)WSP(WS_LORA + LORA_A2T) + (size_t)l * 512 * 64, (const bf16_t*)WSP(WS_LORA + LORA_G2T) + (size_t)l * 512 * 128};
            RwkvChunkOut Oc{(bf16_t*)WSP(WS_GP), (bf16_t*)WSP(WS_QP), (bf16_t*)WSP(WS_HT), (bf16_t*)WSP(WS_ZT), (bf16_t*)WSP(WS_GATE), (float*)WSP(WS_BONUS), (unsigned*)WSP(WS_CTL)};
#pragma unroll 1
            for (int u = bid; u < BATCH * NH * NCHUNK; u += G) rwkv_chunk_unit(ldsp, u, (const bf16_t*)WSP(WS_PROJ), Wt, Oc);
        }
        GRID_BAR();
        }
#if defined(DBG_RWKV) && DBG_RWKV >= 10 && DBG_RWKV != 14
        if (l == 0) {
            IDS();
            gu32* cw = (gu32*)WSP(WS_CTL);
#if DBG_RWKV == 10 || DBG_RWKV == 12 || DBG_RWKV == 13
            const bf16_t* arr[3] = {(const bf16_t*)WSP(WS_GP), (const bf16_t*)WSP(WS_QP), (const bf16_t*)WSP(WS_HT)};
#else
            const bf16_t* arr[3] = {(const bf16_t*)WSP(WS_ZT), (const bf16_t*)WSP(WS_GATE), (const bf16_t*)WSP(WS_GATE)};
#endif
            for (int k = 0; k < 3; ++k) {
                float n_ = 0.f;
#if DBG_RWKV == 13
                const int k2 = k; const int kk_ = 0;
#define k kk_
#endif
                for (size_t i = (size_t)(bid * NTHREADS + tid) * 8; i < (size_t)2048 * 4096; i += (size_t)G * NTHREADS * 8) {
                    const uint4 u = *(const uint4*)(arr[k] + i); const unsigned w_[4] = {u.x, u.y, u.z, u.w};
#if DBG_RWKV == 13
                    { const int tokrow = (int)(i / 512), tseq = tokrow & (SEQ - 1); const int cat = (tseq == 0) ? 0 : ((tseq & 63) == 0 ? 1 : 2);
                      for (int q = 0; q < 4; ++q) { if (k == 0 && cat == (int)k2) { if ((w_[q] & 0x7f80u) == 0x7f80u) n_ += 1.f; if ((w_[q] & 0x7f800000u) == 0x7f800000u) n_ += 1.f; } } }
#else
                    for (int q = 0; q < 4; ++q) { if ((w_[q] & 0x7f80u) == 0x7f80u) n_ += 1.f; if ((w_[q] & 0x7f800000u) == 0x7f800000u) n_ += 1.f; }
#endif
                }
#if DBG_RWKV == 11
                if (k == 2) { n_ = 0.f; const float* bo = (const float*)WSP(WS_BONUS); for (int i = bid * NTHREADS + tid; i < TOK * NH; i += G * NTHREADS) if (!(fabsf(bo[i]) < 1e30f)) n_ += 1.f; }
#endif
#if DBG_RWKV == 13
#undef k
#endif
                n_ = wave_sum(n_);
                if (lane == 0) atomicAdd((float*)(cw + 528 + k), n_);
            }
        }
#endif
        for (int rep_ = 0; rep_ < ((l == 0) ? PROF_REP(3) : 1); ++rep_) {
        {
            if (bid < BATCH * NH) {
                RwkvScanIn Si{(const bf16_t*)WSP(WS_GP), (const bf16_t*)WSP(WS_QP), (const bf16_t*)WSP(WS_HT), (const bf16_t*)WSP(WS_ZT), (const bf16_t*)WSP(WS_GATE), (const float*)WSP(WS_BONUS),
                              IN(I_MU) + l * SHIFT_COLS, IN(I_LNW) + l * RW, IN(I_LNB) + l * RW};
#pragma unroll 1
                for (int i = bid; i < BATCH * NH; i += G) rwkv_scan_unit(ldsp, i, (const bf16_t*)WSP(WS_PROJ), Si, (bf16_t*)WSP(WS_XN));
            }
            volatile LAS int* tick = (volatile LAS int*)(ldsp + LDSCTL_OFF + 64);
#pragma unroll 1
            for (;;) {
                __syncthreads();
                if (threadIdx.x == 0) *tick = (int)atomicAdd((unsigned*)((gu32*)WSP(WS_CTL) + CW_QUEUE + 64 * l), 1u);
                __syncthreads();
                const int k = *tick;
                if (k >= 2 * BATCH * NCHUNK) break;
                const int n = NCHUNK - 1 - (k >> 4), b = (k & 15) >> 1, qb = k & 1;
                attn_half_unit(ldsp, b, n, qb, (const bf16_t*)WSP(WS_PROJ), IN(I_RELB) + (size_t)l * 257 * 8, IN(I_ANG) + l * AW, (bf16_t*)WSP(WS_XN));
            }
        }
        GRID_BAR();
        }
#ifdef DBG_RWKV
        if (l == 0) {
            IDS();
            const bf16_t* ya = (const bf16_t*)WSP(WS_XN); const bf16_t* yb = (const bf16_t*)OUTP();
            float se[3] = {0.f, 0.f, 0.f}, sy[3] = {0.f, 0.f, 0.f}, nf[3] = {0.f, 0.f, 0.f};
            for (int row = gw; row < TOK; row += ngw) {
                const int t = row & (SEQ - 1); const int rg = t < 64 ? 0 : (t < 128 ? 1 : 2);
                const uint4 ua = *(const uint4*)(ya + (size_t)row * D_MODEL + lane * 8), ub_ = *(const uint4*)(yb + (size_t)row * D_MODEL + lane * 8);
                const unsigned wa_[4] = {ua.x, ua.y, ua.z, ua.w}, wb_[4] = {ub_.x, ub_.y, ub_.z, ub_.w};
                float e = 0.f, y2 = 0.f, n_ = 0.f;
                for (int q = 0; q < 4; ++q) for (int u = 0; u < 2; ++u) {
                    const float a_ = bf2f(u ? wa_[q] >> 16 : wa_[q] & 0xffffu), b_ = bf2f(u ? wb_[q] >> 16 : wb_[q] & 0xffffu);
                    if (!(fabsf(b_) < 1e30f)) n_ += 1.f; else e += (a_ - b_) * (a_ - b_);
                    y2 += a_ * a_;
                }
                for (int k = 0; k < 3; ++k) if (k == rg) { se[k] += e; sy[k] += y2; nf[k] += n_; }
            }
            gu32* cw = (gu32*)WSP(WS_CTL);
            for (int k = 0; k < 3; ++k) { const float a_ = wave_sum(se[k]), b_ = wave_sum(sy[k]), c_ = wave_sum(nf[k]);
                if (lane == 0) { atomicAdd((float*)(cw + 512 + k), a_); atomicAdd((float*)(cw + 520 + k), b_); if (DBG_RWKV < 10) atomicAdd((float*)(cw + 528 + k), c_); } }
            GRID_BAR();
        }
#endif
        for (int rep_ = 0; rep_ < ((l == 0) ? PROF_REP(4) : 1); ++rep_) {
        {
            pg8::Gemm g{(bf16_t*)WSP(WS_XN), (bf16_t*)WSP(WS_WOUT) + (size_t)l * D_MODEL * D_MODEL, TOK, D_MODEL, D_MODEL}; pg8::StaticOrder S; S.init(TOK, D_MODEL, G, bid);
            pg8::EpiRes E{(l == 0) ? IN(I_X) : (const float*)OUTP(), OUTP(), D_MODEL, nullptr, 0};
            pg8::gemm_phase<pg8::EpiRes, pg8::StaticOrder, true, true>(ldsp, g, S, E);
        }
        GRID_BAR();
        }
        if (l == 0) {
            for (int rep_ = 0; rep_ < PROF_REP(5); ++rep_) {
            { IDS(); norm_rows<0>(gw, ngw, lane, OUTP(), IN(I_NFG), (bf16_t*)WSP(WS_XN), nullptr, nullptr, nullptr, nullptr); }
            GRID_BAR();
            }
            for (int rep_ = 0; rep_ < PROF_REP(6); ++rep_) {
            {
                pg8::Gemm g{(bf16_t*)WSP(WS_XN), (bf16_t*)WSP(WS_FGU), TOK, 2 * D_FF, D_MODEL}; pg8::StaticOrder S; S.init(TOK, 2 * D_FF, G, bid);
                pg8::EpiSwiglu E{(bf16_t*)WSP(WS_PROJ), D_FF};
                pg8::gemm_phase<pg8::EpiSwiglu, pg8::StaticOrder, true, true>(ldsp, g, S, E);
            }
            GRID_BAR();
            }
            {
                pg8::Gemm g{(bf16_t*)WSP(WS_PROJ), (bf16_t*)WSP(WS_FDN), TOK, D_MODEL, D_FF}; pg8::StaticOrder S; S.init(TOK, D_MODEL, G, bid);
                pg8::EpiRes E{OUTP(), OUTP(), D_MODEL, nullptr, 0};
                pg8::gemm_phase<pg8::EpiRes, pg8::StaticOrder, true, true>(ldsp, g, S, E);
            }
            GRID_BAR();
            { IDS(); norm_rows<0>(gw, ngw, lane, OUTP(), IN(I_NMG) + D_MODEL, (bf16_t*)WSP(WS_XN), nullptr, nullptr, nullptr, nullptr); }
            GRID_BAR();
        } else {
            for (int rep_ = 0; rep_ < PROF_REP(8); ++rep_) {
            { IDS(); norm_rows<1>(gw, ngw, lane, OUTP(), IN(I_NFG) + D_MODEL, (bf16_t*)WSP(WS_XN), nullptr, IN(I_ROUTER), (int*)WSP(WS_TAB + TAB_ROUTE_E), (float2*)WSP(WS_TAB + TAB_ROUTE_G)); }
            {
                IDS();
                LAS float* scr = (LAS float*)(ldsp + wave * 16384);
                constexpr int I_MG = (D_MODEL / 64) * (D_FFE / 32), I_MD = (D_FFE / 64) * (D_MODEL / 32);
#pragma unroll 1
                for (int it = gw; it < NE * (2 * I_MG + I_MD); it += ngw) {
                    const int e = it / (2 * I_MG + I_MD); int r = it - e * (2 * I_MG + I_MD);
                    if (r < I_MG) { p0_transpose_item(IN(I_MWG) + (size_t)e * D_MODEL * D_FFE, D_MODEL, D_FFE, (bf16_t*)WSP(WS_MGU) + (size_t)e * 2 * D_FFE * D_MODEL, 0, 2, scr, r, lane); continue; } r -= I_MG;
                    if (r < I_MG) { p0_transpose_item(IN(I_MWU) + (size_t)e * D_MODEL * D_FFE, D_MODEL, D_FFE, (bf16_t*)WSP(WS_MGU) + (size_t)e * 2 * D_FFE * D_MODEL, 1, 2, scr, r, lane); continue; } r -= I_MG;
                    p0_transpose_item(IN(I_MWD) + (size_t)e * D_FFE * D_MODEL, D_FFE, D_MODEL, (bf16_t*)WSP(WS_MDN) + (size_t)e * D_MODEL * D_FFE, 0, 1, scr, r, lane);
                }
            }
            GRID_BAR();
            }
            for (int rep_ = 0; rep_ < PROF_REP(9); ++rep_) {
            {
                MoeTabs Tb{(int*)WSP(WS_TAB + TAB_ROUTE_E), (float2*)WSP(WS_TAB + TAB_ROUTE_G), (int2*)WSP(WS_TAB + TAB_POS), (int*)WSP(WS_TAB + TAB_ROWIDX), (float*)WSP(WS_TAB + TAB_GATEPOS), (int*)WSP(WS_TAB + TAB_SEGT)};
                moe_build_lists(ldsp, bid, G, Tb);
            }
            GRID_BAR();
            }
            for (int rep_ = 0; rep_ < PROF_REP(10); ++rep_) {
            {
                pg8::Gemm g{(bf16_t*)WSP(WS_XN), (bf16_t*)WSP(WS_MGU), MOE_MAXROWS, 2 * D_FFE, D_MODEL};
                pg8::MoeOrder S{(const int*)WSP(WS_TAB + TAB_SEGT), 2 * D_FFE / 256, G, bid, SZ_MGU};
                pg8::EpiSwiglu E{(bf16_t*)WSP(WS_ACT2), D_FFE};
                pg8::gemm_phase<pg8::EpiSwiglu, pg8::MoeOrder, true, true, true>(ldsp, g, S, E, (const int*)WSP(WS_TAB + TAB_ROWIDX));
            }
            GRID_BAR();
            }
            for (int rep_ = 0; rep_ < PROF_REP(11); ++rep_) {
            {
                pg8::Gemm g{(bf16_t*)WSP(WS_ACT2), (bf16_t*)WSP(WS_MDN), MOE_MAXROWS, D_MODEL, D_FFE};
                pg8::MoeOrder S{(const int*)WSP(WS_TAB + TAB_SEGT), D_MODEL / 256, G, bid, SZ_MDN};
                pg8::EpiSlot E{(bf16_t*)WSP(WS_SLOT), D_MODEL, (const float*)WSP(WS_TAB + TAB_GATEPOS)};
                pg8::gemm_phase<pg8::EpiSlot, pg8::MoeOrder, true, true>(ldsp, g, S, E);
            }
            GRID_BAR();
            }
        }
    }
    { IDS(); norm_rows<3>(gw, ngw, lane, OUTP(), IN(I_NFINAL), nullptr, OUTP(), nullptr, nullptr, nullptr, (const bf16_t*)WSP(WS_SLOT), (const int2*)WSP(WS_TAB + TAB_POS)); }
#ifdef DBG_RWKV
    {
        IDS();
        const float* cw = (const float*)WSP(WS_CTL);
        const float wts[3] = {0.1f, 0.3f, 0.9f}; float diag = 0.f;
        for (int k = 0; k < 3; ++k) { const float se = __hip_atomic_load(cw + 512 + k, RLX_AGENT), sy = __hip_atomic_load(cw + 520 + k, RLX_AGENT), nf = __hip_atomic_load(cw + 528 + k, RLX_AGENT);
#if DBG_RWKV == 1
            if (nf > 0.f || se > 0.01f * sy) diag += wts[k];
#elif DBG_RWKV == 12
            if (k == 0) diag = sqrtf(nf / (2048.f * 4096.f));
#elif DBG_RWKV == 13 || DBG_RWKV == 14
            if (nf > 0.f) diag += wts[k];
#elif DBG_RWKV >= 10
            if (nf > 0.f) diag += wts[k];
#else
            if (k == DBG_RWKV - 2) diag = (nf > 0.f) ? 7.f : fminf(sqrtf(se / sy), 5.f);
#endif
        }
        __syncthreads();
        float* o = OUTP();
        for (int row = gw; row < TOK; row += ngw) for (int j = 0; j < 4; ++j) { float4 v = *(float4*)(o + (size_t)row * D_MODEL + (lane + 64 * j) * 4); const float sc = 1.f + diag; v.x *= sc; v.y *= sc; v.z *= sc; v.w *= sc; *(float4*)(o + (size_t)row * D_MODEL + (lane + 64 * j) * 4) = v; }
    }
#endif
}

extern "C" void kernel_launch(void* const* d_in, const int* in_sizes, int n_in, void* d_out, int out_size, void* d_ws, size_t ws_size, hipStream_t stream) {
    static int grid = 0;
    if (grid == 0) {
        if (n_in != 26 || in_sizes[0] != TOK * D_MODEL || out_size != TOK * D_MODEL || ws_size < WS_END) {
            fprintf(stderr, "kernel_launch: unexpected problem: n_in %d in0 %d out %d ws %zu (need %zu); nothing launched\n", n_in, n_in > 0 ? in_sizes[0] : -1, out_size, ws_size, (size_t)WS_END); grid = -1; return; }
        int dev = 0, cus = 0, per_cu = 0;
        if (hipGetDevice(&dev) != hipSuccess || hipDeviceGetAttribute(&cus, hipDeviceAttributeMultiprocessorCount, dev) != hipSuccess) { fprintf(stderr, "kernel_launch: device query failed\n"); grid = -1; return; }
        if (hipFuncSetAttribute((const void*)mega_fwd, hipFuncAttributeMaxDynamicSharedMemorySize, LDS_BYTES) != hipSuccess) { fprintf(stderr, "kernel_launch: hipFuncSetAttribute failed\n"); grid = -1; return; }
        if (hipOccupancyMaxActiveBlocksPerMultiprocessor(&per_cu, (const void*)mega_fwd, NTHREADS, LDS_BYTES) != hipSuccess || per_cu < 1) { fprintf(stderr, "kernel_launch: occupancy query says %d blocks per CU; nothing launched\n", per_cu); (void)hipGetLastError(); grid = -1; return; }
        grid = cus;
    }
    if (grid < 0) return;
    if (hipMemsetAsync((char*)d_ws + WS_CTL, 0, CTL_ZERO_BYTES, stream) != hipSuccess) { fprintf(stderr, "kernel_launch: hipMemsetAsync failed\n"); return; }
    Args a{};
    for (int i = 0; i < 26; ++i) a.in[i] = (const float*)d_in[i];
    a.out = (float*)d_out; a.ws = (unsigned char*)d_ws;
    void* kargs[] = {&a};
    const hipError_t le = hipLaunchCooperativeKernel((const void*)mega_fwd, dim3(grid), dim3(NTHREADS), kargs, LDS_BYTES, stream);
    if (le != hipSuccess) fprintf(stderr, "kernel_launch: cooperative launch failed: %s (grid %d x %d threads, %d B LDS)\n", hipGetErrorString(le), grid, NTHREADS, LDS_BYTES);
}
```

```cpp
#include <hip/hip_runtime.h>
#include <hip/hip_cooperative_groups.h>
#include <cstdio>
#include <cstdint>
namespace cg = cooperative_groups;

namespace pg8 {
#define PG8_LAS __attribute__((address_space(3)))
typedef unsigned short bf16_t;
typedef short bf16x8 __attribute__((ext_vector_type(8)));
typedef float f32x4 __attribute__((ext_vector_type(4)));
typedef unsigned u32x4 __attribute__((ext_vector_type(4)));
constexpr int BM = 256, BK = 64, HALF = 128, HTB = HALF * BK * 2  , STAGE_BYTES = 8 * HTB, NXCD = 8, WGM = 8;

__host__ __device__ __forceinline__ int lds_byte(int r, int c) { const int st = (r >> 4) * 2 + (c >> 5), rr = r & 15, cc = c & 31, ob = rr * 64 + cc * 2; return st * 1024 + (ob ^ (((ob >> 9) & 1) << 5)); }
__host__ __device__ __forceinline__ void stage_rc(int b, int& R, int& C) { const int st = b / 1024, sb = b % 1024, swz = sb ^ (((sb >> 9) & 1) << 5); R = (st >> 1) * 16 + swz / 64; C = (st & 1) * 32 + (swz % 64) / 2; }
__host__ __device__ __forceinline__ int perm32(int rho) { const int n = rho >> 4, i = rho & 15; return 8 * (i >> 2) + 4 * n + (i & 3); }

struct Unit { int pm, pn; size_t boff; };
struct Gemm { const bf16_t* A; const bf16_t* Bt; int M, N, K; };

struct StaticOrder {
    int nM, nN, nwg, G, c;
    __host__ __device__ void init(int M, int N, int G_, int c_) { nM = M / BM; nN = N / BM; nwg = nM * nN; G = G_; c = c_; }
    __host__ __device__ bool next(int i, Unit& u) const {
        const long L = (long)i * G + c; if (L >= nwg) return false;
        int wgid = (int)L; { const int q = nwg / NXCD, r = nwg % NXCD, xcd = wgid % NXCD, off = wgid / NXCD; wgid = (xcd < r ? xcd * (q + 1) : r * (q + 1) + (xcd - r) * q) + off; }
        const int nig = WGM * nN, gid = wgid / nig, fm = gid * WGM, gsz = (nM - fm) < WGM ? (nM - fm) : WGM;
        u.pm = fm + ((wgid % nig) % gsz); u.pn = (wgid % nig) / gsz; u.boff = 0; return true;
    }
    __device__ __forceinline__ void a_ready(const Unit&) const {}
    __device__ __forceinline__ void done(const Unit&) const {}
};

__device__ __forceinline__ unsigned cvt_pk_bf16(float lo, float hi) { unsigned r; asm volatile("v_cvt_pk_bf16_f32 %0, %1, %2" : "=v"(r) : "v"(lo), "v"(hi)); return r; }
typedef float f32x2 __attribute__((ext_vector_type(2)));
typedef unsigned u32x2 __attribute__((ext_vector_type(2)));
__device__ __forceinline__ float row_rstd(const float* part, int r) {
    const f32x4 a = *(const f32x4*)(part + (size_t)r * 16), b = *(const f32x4*)(part + (size_t)r * 16 + 4), c = *(const f32x4*)(part + (size_t)r * 16 + 8), d = *(const f32x4*)(part + (size_t)r * 16 + 12);
    const float s = ((a[0] + a[1]) + (a[2] + a[3])) + ((b[0] + b[1]) + (b[2] + b[3])) + (((c[0] + c[1]) + (c[2] + c[3])) + ((d[0] + d[1]) + (d[2] + d[3])));
    return __builtin_amdgcn_rsqf(s * (1.f / 1024.f) + 1e-6f);
}
struct EpiBf16 {
    static constexpr bool PERM = true, AFTER_DRAIN = false, ACC_INIT = false;
    bf16_t* O; int ldc; const float* part;
    __device__ __forceinline__ void operator()(const f32x4 (&acc)[2][2][4][2], const Unit& u, int wr, int wc, int fr, int fq) const {
        const int row0 = u.pm * BM + wr * 64 + fr; const int col0 = u.pn * BM + wc * 32 + 8 * fq;
#pragma unroll
        for (int ai = 0; ai < 2; ++ai) {
            float scs[4] = {1.f, 1.f, 1.f, 1.f};
            if (part) {
#pragma unroll
                for (int m = 0; m < 4; ++m) scs[m] = row_rstd(part, row0 + ai * HALF + m * 16);
            }
#pragma unroll
            for (int m = 0; m < 4; ++m) { const int r = row0 + ai * HALF + m * 16; bf16_t* rowp = O + (size_t)r * ldc + col0; const float sc = scs[m];
#pragma unroll
                for (int bj = 0; bj < 2; ++bj) { const f32x4 v0 = acc[ai][bj][m][0] * sc, v1 = acc[ai][bj][m][1] * sc;
                    u32x4 w; w.x = cvt_pk_bf16(v0[0], v0[1]); w.y = cvt_pk_bf16(v0[2], v0[3]); w.z = cvt_pk_bf16(v1[0], v1[1]); w.w = cvt_pk_bf16(v1[2], v1[3]);
                    *(u32x4*)(rowp + bj * HALF) = w; } }
        }
    }
};
struct EpiSwiglu {
    static constexpr bool PERM = true, AFTER_DRAIN = false, ACC_INIT = false;
    bf16_t* O; int ldc; const float* part;
    __device__ __forceinline__ void operator()(const f32x4 (&acc)[2][2][4][2], const Unit& u, int wr, int wc, int fr, int fq) const {
        const int row0 = u.pm * BM + wr * 64 + fr; const int col0 = (u.pn * BM + wc * 32 + 8 * fq) >> 1;
#pragma unroll
        for (int ai = 0; ai < 2; ++ai) {
            float scs[4] = {1.f, 1.f, 1.f, 1.f};
            if (part) {
#pragma unroll
                for (int m = 0; m < 4; ++m) scs[m] = row_rstd(part, row0 + ai * HALF + m * 16);
            }
#pragma unroll
            for (int m = 0; m < 4; ++m) { const int r = row0 + ai * HALF + m * 16; bf16_t* rowp = O + (size_t)r * ldc + col0; const float sc = scs[m];
#pragma unroll
                for (int bj = 0; bj < 2; ++bj) { const f32x4 v0 = acc[ai][bj][m][0] * sc, v1 = acc[ai][bj][m][1] * sc;
                    const float g0 = v0[0], g1 = v0[2], g2 = v1[0], g3 = v1[2];
                    const float a0 = g0 * __builtin_amdgcn_rcpf(1.f + __expf(-g0)) * v0[1], a1 = g1 * __builtin_amdgcn_rcpf(1.f + __expf(-g1)) * v0[3];
                    const float a2 = g2 * __builtin_amdgcn_rcpf(1.f + __expf(-g2)) * v1[1], a3 = g3 * __builtin_amdgcn_rcpf(1.f + __expf(-g3)) * v1[3];
                    u32x2 w; w.x = cvt_pk_bf16(a0, a1); w.y = cvt_pk_bf16(a2, a3);
                    *(u32x2*)(rowp + bj * (HALF / 2)) = w; } }
        }
    }
};
struct EpiRes {
    static constexpr bool PERM = false, AFTER_DRAIN = false, ACC_INIT = true;
    const float* base; float* out; int ldc; const float* scale; int sstride; bf16_t* XB; float* part;
    __device__ __forceinline__ void init(f32x4 (&acc)[2][2][4][2], const Unit& u, int wr, int wc, int fr, int fq) const {
        const int col0 = u.pn * BM + wc * 32 + 4 * fq;
#pragma unroll
        for (int ai = 0; ai < 2; ++ai)
#pragma unroll
            for (int m = 0; m < 4; ++m) { const int r = u.pm * BM + ai * HALF + wr * 64 + m * 16 + fr; const size_t off = (size_t)r * ldc + col0;
#pragma unroll
                for (int bj = 0; bj < 2; ++bj)
#pragma unroll
                    for (int n = 0; n < 2; ++n) acc[ai][bj][m][n] = *(const f32x4*)(base + off + bj * HALF + n * 16); }
    }
    __device__ __forceinline__ void operator()(const f32x4 (&acc)[2][2][4][2], const Unit& u, int wr, int wc, int fr, int fq) const {
        const int col0 = u.pn * BM + wc * 32 + 4 * fq;
#pragma unroll
        for (int ai = 0; ai < 2; ++ai)
#pragma unroll
            for (int m = 0; m < 4; ++m) { const int r = u.pm * BM + ai * HALF + wr * 64 + m * 16 + fr; const size_t off = (size_t)r * ldc + col0;
#pragma unroll
                for (int bj = 0; bj < 2; ++bj)
#pragma unroll
                    for (int n = 0; n < 2; ++n) *(f32x4*)(out + off + bj * HALF + n * 16) = acc[ai][bj][m][n]; }
    }
};
struct EpiSlot {
    static constexpr bool PERM = true, AFTER_DRAIN = false, ACC_INIT = false;
    bf16_t* O; int ldc; const float* rscale;
    __device__ __forceinline__ void operator()(const f32x4 (&acc)[2][2][4][2], const Unit& u, int wr, int wc, int fr, int fq) const {
        const int row0 = u.pm * BM + wr * 64 + fr; const int col0 = u.pn * BM + wc * 32 + 8 * fq;
#pragma unroll
        for (int ai = 0; ai < 2; ++ai)
#pragma unroll
            for (int m = 0; m < 4; ++m) { const int r = row0 + ai * HALF + m * 16; const float sc = rscale[r]; bf16_t* rowp = O + (size_t)r * ldc + col0;
#pragma unroll
                for (int bj = 0; bj < 2; ++bj) { const f32x4 v0 = acc[ai][bj][m][0] * sc, v1 = acc[ai][bj][m][1] * sc;
                    u32x4 w; w.x = cvt_pk_bf16(v0[0], v0[1]); w.y = cvt_pk_bf16(v0[2], v0[3]); w.z = cvt_pk_bf16(v1[0], v1[1]); w.w = cvt_pk_bf16(v1[2], v1[3]);
                    *(u32x4*)(rowp + bj * HALF) = w; } }
    }
};
struct MoeOrder {
    const int* segt; int NT, G, c; size_t estride;
    __device__ __forceinline__ bool next(int i, Unit& u) const {
        const int Mt = segt[8]; const long L = (long)i * G + c; if (L >= (long)Mt * NT) return false;
        u.pm = (int)(L / NT); u.pn = (int)(L % NT); int e = 0;
#pragma unroll
        for (int k = 1; k < 8; ++k) if (u.pm >= segt[k]) e = k;
        u.boff = (size_t)e * estride; return true;
    }
    __device__ __forceinline__ void a_ready(const Unit&) const {}
    __device__ __forceinline__ void done(const Unit&) const {}
};
template <class Epi, class Sched, bool ALIGN_EPI = false, bool SP2 = false, bool GATHER = false>
__device__ __forceinline__ void gemm_phase(PG8_LAS unsigned char* lds, const Gemm g, const Sched& S, const Epi& E, const int* ridx = nullptr) {
    static_assert(!GATHER || SP2, "row gather is wired into the SP2 loop only");
    int tid_ = threadIdx.x; asm volatile("" : "+v"(tid_));
    const int tid = tid_, wid = __builtin_amdgcn_readfirstlane(tid >> 6), lane = tid & 63, wr = wid >> 2, wc = wid & 3, fr = lane & 15, fq = lane >> 4;
    const int K = g.K, nt = K / BK;
    unsigned voffA[2], voffB[2];
#pragma unroll
    for (int i = 0; i < 2; ++i) { int R, C; stage_rc(tid * 16 + i * 8192, R, C); const int Rb = Epi::PERM ? ((R & ~31) + perm32(R & 31)) : R;
        voffA[i] = (unsigned)(R * K + C) * 2u; voffB[i] = (unsigned)(Rb * K + C) * 2u; }
    unsigned vA0[2] = {0u, 0u}, vA1[2] = {0u, 0u}; int rn[4] = {0, 0, 0, 0};
    auto rows_load = [&](int pm) { _Pragma("unroll") for (int i = 0; i < 2; ++i) { int R, C; stage_rc(tid * 16 + i * 8192, R, C); rn[i] = ridx[pm * BM + R]; rn[2 + i] = ridx[pm * BM + HALF + R]; } };
    auto rows_set = [&]() { _Pragma("unroll") for (int i = 0; i < 2; ++i) { int R, C; stage_rc(tid * 16 + i * 8192, R, C); vA0[i] = (unsigned)(rn[i] * K + C) * 2u; vA1[i] = (unsigned)(rn[2 + i] * K + C) * 2u; } };
    const size_t kstep = (size_t)(BK * 2);
    const size_t hstep = (size_t)HALF * K * 2;
    const size_t tstep = 2 * hstep;
    const unsigned ldsw = (unsigned)wid * 1024u;
    const int aoff = lds_byte(wr * 64 + fr, fq * 8), boff = lds_byte(wc * 32 + fr, fq * 8);
#define PG8_SA(b, h) (((b) * 2 + (h)) * HTB)
#define PG8_SB(b, h) ((4 + (b) * 2 + (h)) * HTB)
#define PG8_STAGE(bufoff, gbase, voff) do { _Pragma("unroll") for (int _i = 0; _i < 2; ++_i) \
        __builtin_amdgcn_global_load_lds((const unsigned*)((const char*)(gbase) + (voff)[_i]), (PG8_LAS unsigned*)(lds + (bufoff) + ldsw + _i * 8192), 16, 0, 0); } while (0)
#define PG8_STAGE_A(bufoff, gptr, half) do { if constexpr (GATHER) { if ((half) == 0) PG8_STAGE(bufoff, gptr, vA0); else PG8_STAGE(bufoff, gptr, vA1); } else { PG8_STAGE(bufoff, (gptr) + (half) * hstep, voffA); } } while (0)
#define PG8_LDA(dst, b, h) do { _Pragma("unroll") for (int m = 0; m < 4; ++m) _Pragma("unroll") for (int k = 0; k < 2; ++k) dst[m][k] = *(const PG8_LAS bf16x8*)(lds + PG8_SA(b, h) + aoff + m * 2048 + k * 1024); } while (0)
#define PG8_LDB(dst, b, h) do { _Pragma("unroll") for (int n = 0; n < 2; ++n) _Pragma("unroll") for (int k = 0; k < 2; ++k) dst[n][k] = *(const PG8_LAS bf16x8*)(lds + PG8_SB(b, h) + boff + n * 2048 + k * 1024); } while (0)
#define PG8_MMA(ai, bj, At, Bt) do { __builtin_amdgcn_s_setprio(1); _Pragma("unroll") for (int m = 0; m < 4; ++m) _Pragma("unroll") for (int n = 0; n < 2; ++n) _Pragma("unroll") for (int k = 0; k < 2; ++k) \
        acc[ai][bj][m][n] = __builtin_amdgcn_mfma_f32_16x16x32_bf16(Bt[n][k], At[m][k], acc[ai][bj][m][n], 0, 0, 0); __builtin_amdgcn_s_setprio(0); } while (0)
#define PG8_WAIT_V(n) asm volatile("s_waitcnt vmcnt(" #n ")" ::: "memory")
#define PG8_WAIT_L(n) asm volatile("s_waitcnt lgkmcnt(" #n ")" ::: "memory")
#define PG8_BAR __builtin_amdgcn_s_barrier()
#define PG8_SCHED __builtin_amdgcn_sched_barrier(0)
    Unit cur, nxt; int ui = 0;
    if (!S.next(0, cur)) return;
    f32x4 acc[2][2][4][2];
#pragma unroll
    for (int a = 0; a < 2; ++a)
#pragma unroll
        for (int b = 0; b < 2; ++b)
#pragma unroll
            for (int m = 0; m < 4; ++m)
#pragma unroll
                for (int n = 0; n < 2; ++n) acc[a][b][m][n] = (f32x4){0.f, 0.f, 0.f, 0.f};
    if constexpr (Epi::ACC_INIT) E.init(acc, cur, wr, wc, fr, fq);
    bf16x8 At[4][2], B0[2][2], B1[2][2];
    const char* cA = (const char*)g.A + (GATHER ? (size_t)0 : (size_t)cur.pm * tstep); const char* cB = (const char*)g.Bt + cur.boff + (size_t)cur.pn * tstep;
    if constexpr (GATHER) { rows_load(cur.pm); rows_set(); }
    S.a_ready(cur);
    if constexpr (SP2) {
        PG8_STAGE(PG8_SB(0, 0), cB, voffB); PG8_STAGE(PG8_SB(0, 1), cB + hstep, voffB); PG8_STAGE_A(PG8_SA(0, 0), cA, 0); PG8_STAGE_A(PG8_SA(0, 1), cA, 1);
        if (wr == 1) PG8_BAR;
        PG8_WAIT_V(2); PG8_BAR;
        PG8_STAGE(PG8_SB(1, 0), cB + kstep, voffB); PG8_STAGE_A(PG8_SA(1, 0), cA + kstep, 0); PG8_STAGE(PG8_SB(1, 1), cB + hstep + kstep, voffB);
        PG8_WAIT_V(6); PG8_BAR;
    } else {
        PG8_STAGE(PG8_SB(0, 0), cB, voffB); PG8_STAGE(PG8_SA(0, 0), cA, voffA); PG8_STAGE(PG8_SB(0, 1), cB + hstep, voffB); PG8_STAGE(PG8_SA(0, 1), cA + hstep, voffA);
        if (wr == 1) PG8_BAR;
        PG8_WAIT_V(4); PG8_BAR;
        PG8_STAGE(PG8_SB(1, 0), cB + kstep, voffB); PG8_STAGE(PG8_SA(1, 0), cA + kstep, voffA); PG8_STAGE(PG8_SB(1, 1), cB + hstep + kstep, voffB);
        PG8_WAIT_V(6); PG8_BAR;
    }
    for (;;) {
        const bool has_next = S.next(ui + 1, nxt);
        const char* nA = (has_next && !GATHER) ? (const char*)g.A + (size_t)nxt.pm * tstep : cA; const char* nB = has_next ? (const char*)g.Bt + nxt.boff + (size_t)nxt.pn * tstep : cB;
        for (int t = 0; t < nt; t += 2) {
            const bool last = (t == nt - 2);
            const char* a1 = cA + (size_t)(t + 1) * kstep;
            const char* a2 = last ? nA : cA + (size_t)(t + 2) * kstep; const char* b2 = last ? nB : cB + (size_t)(t + 2) * kstep;
            const char* a3 = a2 + kstep; const char* b3 = b2 + kstep;
            if (last && has_next) S.a_ready(nxt);
            if constexpr (SP2) {
            if constexpr (GATHER) { if (last && has_next) rows_load(nxt.pm); }
            PG8_LDB(B0, 0, 0); PG8_LDB(B1, 0, 1); PG8_SCHED; PG8_LDA(At, 0, 0); PG8_STAGE_A(PG8_SA(1, 1), a1, 1);
            PG8_WAIT_V(8); PG8_WAIT_L(0); PG8_BAR; PG8_MMA(0, 0, At, B0); PG8_MMA(0, 1, At, B1); PG8_BAR; PG8_SCHED;
            if constexpr (GATHER) { if (last && has_next) rows_set(); }
            PG8_LDA(At, 0, 1); PG8_STAGE(PG8_SB(0, 0), b2, voffB); PG8_STAGE(PG8_SB(0, 1), b2 + hstep, voffB); PG8_STAGE_A(PG8_SA(0, 0), a2, 0);
            PG8_WAIT_V(8); PG8_WAIT_L(0); PG8_BAR; PG8_MMA(1, 0, At, B0); PG8_MMA(1, 1, At, B1); PG8_BAR; PG8_SCHED;
            PG8_LDB(B0, 1, 0); PG8_LDB(B1, 1, 1); PG8_SCHED; PG8_LDA(At, 1, 0); PG8_STAGE_A(PG8_SA(0, 1), a2, 1);
            PG8_WAIT_V(8); PG8_WAIT_L(0); PG8_BAR; PG8_MMA(0, 0, At, B0); PG8_MMA(0, 1, At, B1); PG8_BAR; PG8_SCHED;
            PG8_LDA(At, 1, 1); PG8_STAGE(PG8_SB(1, 0), b3, voffB); PG8_STAGE(PG8_SB(1, 1), b3 + hstep, voffB); PG8_STAGE_A(PG8_SA(1, 0), a3, 0);
            PG8_WAIT_V(8); PG8_WAIT_L(0); PG8_BAR; PG8_MMA(1, 0, At, B0); PG8_MMA(1, 1, At, B1); PG8_BAR; PG8_SCHED;
            } else {
            PG8_LDB(B0, 0, 0); PG8_SCHED; PG8_LDA(At, 0, 0); PG8_STAGE(PG8_SA(1, 1), a1 + hstep, voffA);
            PG8_WAIT_L(8); PG8_BAR; PG8_WAIT_L(0); PG8_MMA(0, 0, At, B0); PG8_BAR; PG8_SCHED;
            PG8_LDB(B1, 0, 1); PG8_STAGE(PG8_SB(0, 0), b2, voffB);
            PG8_BAR; PG8_WAIT_L(0); PG8_MMA(0, 1, At, B1); PG8_BAR;
            PG8_LDA(At, 0, 1); PG8_STAGE(PG8_SA(0, 0), a2, voffA);
            PG8_BAR; PG8_WAIT_L(0); PG8_MMA(1, 0, At, B0); PG8_BAR; PG8_SCHED;
            PG8_STAGE(PG8_SB(0, 1), b2 + hstep, voffB);
            PG8_WAIT_V(6); PG8_BAR; PG8_MMA(1, 1, At, B1); PG8_BAR;
            PG8_LDB(B0, 1, 0); PG8_SCHED; PG8_LDA(At, 1, 0); PG8_STAGE(PG8_SA(0, 1), a2 + hstep, voffA);
            PG8_WAIT_L(8); PG8_BAR; PG8_WAIT_L(0); PG8_MMA(0, 0, At, B0); PG8_BAR; PG8_SCHED;
            PG8_LDB(B1, 1, 1); PG8_STAGE(PG8_SB(1, 0), b3, voffB);
            PG8_BAR; PG8_WAIT_L(0); PG8_MMA(0, 1, At, B1); PG8_BAR;
            PG8_LDA(At, 1, 1); PG8_STAGE(PG8_SA(1, 0), a3, voffA);
            PG8_BAR; PG8_WAIT_L(0); PG8_MMA(1, 0, At, B0); PG8_BAR; PG8_SCHED;
            PG8_STAGE(PG8_SB(1, 1), b3 + hstep, voffB);
            PG8_WAIT_V(6); PG8_BAR; PG8_MMA(1, 1, At, B1); PG8_BAR;
            }
        }
        if constexpr (ALIGN_EPI) { if (wr == 0) PG8_BAR; }
        if constexpr (!Epi::AFTER_DRAIN) { E(acc, cur, wr, wc, fr, fq); S.done(cur); }
        if (!has_next) break;
#pragma unroll
        for (int a = 0; a < 2; ++a)
#pragma unroll
            for (int b = 0; b < 2; ++b)
#pragma unroll
                for (int m = 0; m < 4; ++m)
#pragma unroll
                    for (int n = 0; n < 2; ++n) acc[a][b][m][n] = (f32x4){0.f, 0.f, 0.f, 0.f};
        if constexpr (Epi::ACC_INIT) E.init(acc, nxt, wr, wc, fr, fq);
        cur = nxt; cA = nA; cB = nB; ++ui;
        if constexpr (ALIGN_EPI) { if (wr == 1) PG8_BAR; }
    }
    PG8_WAIT_V(0);
    if constexpr (!ALIGN_EPI) { if (wr == 0) PG8_BAR; }
    PG8_BAR;
    if constexpr (Epi::AFTER_DRAIN) { E.fused(acc, cur, wr, wc, fr, fq, lds, wid, lane); S.done(cur); }
#undef PG8_SA
#undef PG8_SB
#undef PG8_STAGE
#undef PG8_STAGE_A
#undef PG8_LDA
#undef PG8_LDB
#undef PG8_MMA
#undef PG8_WAIT_V
#undef PG8_WAIT_L
#undef PG8_BAR
#undef PG8_SCHED
}
}
typedef unsigned short bf16_t;
constexpr int D_MODEL = 1024, BATCH = 8, SEQ = 2048, TOK = BATCH * SEQ;
constexpr int CHUNK = 64, NCHUNK = SEQ / CHUNK;
constexpr int RW = 512, AW = 512, NH = 8;
constexpr int IN_COLS = 3328, SHIFT_COLS = 1792;
constexpr int C_R = 0, C_K = 512, C_V = 1024, C_WD = 1536, C_AD = 1600, C_GD = 1664, C_QA = 1792, C_KA = 2304, C_VA = 2816;
constexpr int D_FF = 2816, NE = 8, D_FFE = 1408;
constexpr float RMS_EPS = 1e-6f, GN_EPS = 64e-5f;
constexpr int NWAVES = 8, NTHREADS = 512;

constexpr size_t MiB = 1u << 20;
constexpr size_t WS_CTL = 0, CTL_ZERO_BYTES = 64 * 1024;
constexpr size_t SZ_WIN = (size_t)IN_COLS * D_MODEL * 2, SZ_WOUT = (size_t)D_MODEL * D_MODEL * 2, SZ_FGU = (size_t)2 * D_FF * D_MODEL * 2, SZ_FDN = (size_t)D_MODEL * D_FF * 2;
constexpr size_t SZ_MGU = (size_t)2 * D_FFE * D_MODEL * 2, SZ_MDN = (size_t)D_MODEL * D_FFE * 2;
constexpr size_t WS_WIN = 1 * MiB, WS_WOUT = WS_WIN + 2 * SZ_WIN, WS_FGU = WS_WOUT + 2 * SZ_WOUT, WS_FDN = WS_FGU + SZ_FGU, WS_LORA = WS_FDN + SZ_FDN, WS_WEND = WS_LORA + 512 * 1024;
constexpr size_t LORA_W2T = 0, LORA_A2T = 2 * 512 * 64 * 2, LORA_G2T = 4 * 512 * 64 * 2;
constexpr size_t WS_XN = 35 * MiB;
constexpr size_t WS_PROJ = 67 * MiB;
constexpr size_t WS_CHUNK = 171 * MiB;
constexpr size_t WS_GP = WS_CHUNK, WS_QP = WS_CHUNK + 16 * MiB, WS_HT = WS_CHUNK + 32 * MiB, WS_ZT = WS_CHUNK + 48 * MiB, WS_GATE = WS_CHUNK + 64 * MiB;
constexpr size_t WS_BONUS = 251 * MiB;
constexpr size_t WS_TAB = 252 * MiB;
constexpr int MOE_MAXROWS = 2 * TOK + NE * 256;
constexpr size_t TAB_ROUTE_E = 0, TAB_ROUTE_G = 64 * 1024, TAB_POS = 192 * 1024, TAB_ROWIDX = 320 * 1024, TAB_GATEPOS = 464 * 1024, TAB_SEGT = 608 * 1024;
constexpr size_t WS_SLOT = 1 * MiB;
constexpr size_t WS_ACT2 = 69 * MiB;
static_assert(WS_SLOT + (size_t)MOE_MAXROWS * D_MODEL * 2 <= WS_ACT2 && WS_ACT2 + (size_t)MOE_MAXROWS * D_FFE * 2 <= 171 * MiB && TAB_ROWIDX + MOE_MAXROWS * 4 <= TAB_GATEPOS && TAB_GATEPOS + MOE_MAXROWS * 4 <= TAB_SEGT, "moe map");
constexpr size_t WS_MGU = WS_CHUNK, WS_MDN = WS_MGU + NE * SZ_MGU;
constexpr size_t WS_PART1 = 253 * MiB, WS_PART2 = 254 * MiB;
constexpr size_t WS_XB1 = WS_CHUNK;
constexpr size_t WS_END = 255 * MiB;
static_assert(WS_MDN + NE * SZ_MDN <= WS_BONUS && WS_GATE + 16 * MiB <= WS_BONUS, "map");
static_assert(WS_WEND <= WS_XN, "weights fit below XN");

#define GAS __attribute__((address_space(1)))
#define LAS __attribute__((address_space(3)))
typedef unsigned short bf16;
typedef unsigned v4u __attribute__((ext_vector_type(4)));
typedef float f32x4 __attribute__((ext_vector_type(4)));
typedef short bf16x8 __attribute__((ext_vector_type(8)));
typedef GAS unsigned gu32;
typedef GAS unsigned long long gu64;
#define RLX_AGENT __ATOMIC_RELAXED, __HIP_MEMORY_SCOPE_AGENT
#define LDS_WAIT() asm volatile("s_waitcnt lgkmcnt(0)" ::: "memory")
#define VM_WAIT() asm volatile("s_waitcnt vmcnt(0)" ::: "memory")
__device__ __forceinline__ unsigned long long rt() { return __builtin_amdgcn_s_memrealtime(); }
__device__ __forceinline__ unsigned f2bf(float f) { unsigned u = __builtin_bit_cast(unsigned, f); return (u + 0x7fffu + ((u >> 16) & 1u)) >> 16; }
__device__ __forceinline__ unsigned pk2(float lo, float hi) { return f2bf(lo) | (f2bf(hi) << 16); }
constexpr int CW_BAR = 1024;
#define XB_TMO      128
#define XB_XCNT(j)  (256  + 64 * (j))
#define XB_XSUB(j)  (1280 + 64 * (j))
#define XB_XGEN(j)  (2304 + 64 * (j))
#define XB_TOP      3328
#define XB_TOPGEN   3392
#define XCD_BAR_WORDS 3456
#define XB_SPIN_CAP (1u << 18)

__device__ __forceinline__ unsigned xb_ld(unsigned* p)              { return __hip_atomic_load(p, __ATOMIC_RELAXED, __HIP_MEMORY_SCOPE_AGENT); }
__device__ __forceinline__ unsigned xb_add(unsigned* p, unsigned v) { return __hip_atomic_fetch_add(p, v, __ATOMIC_RELAXED, __HIP_MEMORY_SCOPE_AGENT); }
__device__ __forceinline__ unsigned xb_xcc_id() { return (unsigned)__builtin_amdgcn_s_getreg((3 << 11) | 20) & 0xFu; }
#define XB_SPIN(cond, bar) do { unsigned _sp = 0; while (cond) { __builtin_amdgcn_s_sleep(1); \
    if ((++_sp & 255u) == 0u) { if (xb_ld(&(bar)[XB_TMO])) break; if (_sp > XB_SPIN_CAP) { atomicAdd(&(bar)[XB_TMO], 1u); break; } } } } while (0)

struct XcdBarrier {
    unsigned* bar; unsigned x;
    volatile LAS unsigned* st;
};

__device__ __forceinline__ XcdBarrier xcd_barrier_post(unsigned* bar, volatile LAS unsigned* st) {
    XcdBarrier b; b.bar = bar; b.x = xb_xcc_id(); b.st = st;
    if (threadIdx.x == 0) (void)xb_add(&bar[XB_XCNT(b.x)], 1u);
    return b;
}
__device__ __forceinline__ void xcd_barrier_complete(unsigned* bar, unsigned x, unsigned& nloc, unsigned& nx) {
    const unsigned G = gridDim.x * gridDim.y * gridDim.z;
    unsigned sum, cnt, mine, sp = 0u;
    for (;;) {
        sum = 0u; cnt = 0u; mine = 0u;
#pragma unroll
        for (unsigned j = 0; j < 16; ++j) { const unsigned c = xb_ld(&bar[XB_XCNT(j)]); sum += c; cnt += (c > 0u) ? 1u : 0u; mine = (j == x) ? c : mine; }
        if (sum == G) break;
        __builtin_amdgcn_s_sleep(1);
        if ((++sp & 255u) == 0u) { if (xb_ld(&bar[XB_TMO])) break; if (sp > XB_SPIN_CAP) { atomicAdd(&bar[XB_TMO], 1u); break; } }
    }
    nloc = mine > 0u ? mine : 1u; nx = cnt > 0u ? cnt : 1u;
}

__device__ __forceinline__ void xcd_barrier(const XcdBarrier& b) {
    asm volatile("s_waitcnt vmcnt(0)" ::: "memory");
    __syncthreads();
    if (threadIdx.x == 0) {
        unsigned* bar = b.bar;
        __builtin_amdgcn_s_waitcnt(0);
        unsigned nloc = b.st[0], nx = b.st[1];
        if (nloc == 0u) { xcd_barrier_complete(bar, b.x, nloc, nx); b.st[0] = nloc; b.st[1] = nx; }
        const unsigned old = xb_add(&bar[XB_XSUB(b.x)], 1u);
        const unsigned gen = old / nloc;
        if (old + 1u == (gen + 1u) * nloc) {
            __builtin_amdgcn_fence(__ATOMIC_RELEASE, "agent");
            asm volatile("s_waitcnt vmcnt(0)" ::: "memory");
            const unsigned og = xb_add(&bar[XB_TOP], 1u);
            const unsigned tg = og / nx;
            if (og + 1u == (tg + 1u) * nx) xb_add(&bar[XB_TOPGEN], 1u);
            else XB_SPIN(xb_ld(&bar[XB_TOPGEN]) == tg, bar);
            __builtin_amdgcn_fence(__ATOMIC_ACQUIRE, "agent");
            xb_add(&bar[XB_XGEN(b.x)], 1u);
            asm volatile("s_waitcnt vmcnt(0)" ::: "memory");
        } else {
            XB_SPIN(xb_ld(&bar[XB_XGEN(b.x)]) == gen, bar);
            __builtin_amdgcn_fence(__ATOMIC_ACQUIRE, "agent");
            asm volatile("s_waitcnt vmcnt(0)" ::: "memory");
        }
    }
    __syncthreads();
}
__device__ __forceinline__ float bf2f(unsigned h) { return __builtin_bit_cast(float, h << 16); }
__device__ __forceinline__ float wave_sum(float v) {
#pragma unroll
    for (int o = 1; o < 64; o <<= 1) v += __shfl_xor(v, o);
    return v;
}
typedef float f32x2_t __attribute__((ext_vector_type(2))); typedef __bf16 bf16x2_t __attribute__((ext_vector_type(2)));
__device__ __forceinline__ unsigned cvtpk(float lo, float hi) { const f32x2_t v = {lo, hi}; const bf16x2_t b = __builtin_convertvector(v, bf16x2_t); return __builtin_bit_cast(unsigned, b); }
__device__ __forceinline__ float sigmoidf_(float x) { return 1.f / (1.f + __expf(-x)); }

constexpr int P0_SCR_BYTES = 64 * 68 * 4;
__device__ __forceinline__ void p0_transpose_item(const float* W, int K, int N, bf16_t* WT, int row_off, int rmul, LAS float* scr, int item, int lane, const float* gk = nullptr) {
    const int nblk = N / 64, kb = item / nblk, nb = item % nblk, k0 = 64 * kb, n0 = 64 * nb;
    const int r4 = lane >> 4, c4 = (lane & 15) * 4;
    f32x4 t[16];
#pragma unroll
    for (int i = 0; i < 16; ++i) t[i] = *(const GAS f32x4*)(W + (size_t)(k0 + 4 * i + r4) * N + n0 + c4);
#pragma unroll
    for (int i = 0; i < 16; ++i) *(LAS f32x4*)(scr + (4 * i + r4) * 68 + c4) = t[i];
    LDS_WAIT(); asm volatile("" ::: "memory");
    bf16_t* orow = WT + (size_t)(row_off + (n0 + lane) * rmul) * K + k0;
#pragma unroll
    for (int j = 0; j < 8; ++j) { const LAS float* s_ = scr + (8 * j) * 68 + lane;
        f32x4 g0 = {1.f, 1.f, 1.f, 1.f}, g1 = g0; if (gk) { g0 = *(const GAS f32x4*)(gk + k0 + 8 * j); g1 = *(const GAS f32x4*)(gk + k0 + 8 * j + 4); }
        v4u o; o.x = pk2(s_[0 * 68] * g0[0], s_[1 * 68] * g0[1]); o.y = pk2(s_[2 * 68] * g0[2], s_[3 * 68] * g0[3]); o.z = pk2(s_[4 * 68] * g1[0], s_[5 * 68] * g1[1]); o.w = pk2(s_[6 * 68] * g1[2], s_[7 * 68] * g1[3]);
        *(GAS v4u*)(orow + 8 * j) = o; }
    LDS_WAIT(); asm volatile("" ::: "memory");
}

template <int MODE>
__device__ __forceinline__ void norm_rows(int gw, int ngw, int lane, const float* x, const float* __restrict__ g, bf16_t* xn, float* outf, const float* __restrict__ router, int* route_e, float2* route_g,
                                          const bf16_t* slot = nullptr, const int2* pos = nullptr) {
    for (int row = gw; row < TOK; row += ngw) {
        const float4* xr = (const float4*)(x + (size_t)row * D_MODEL);
        float4 v[4]; float s = 0.f;
        int2 pp = make_int2(0, 0); if (MODE == 3) pp = pos[row];
#pragma unroll
        for (int j = 0; j < 4; ++j) { v[j] = xr[lane + 64 * j];
            if (MODE == 3) {
                const uint2 s0 = *(const uint2*)(slot + (size_t)pp.x * D_MODEL + (lane + 64 * j) * 4), s1 = *(const uint2*)(slot + (size_t)pp.y * D_MODEL + (lane + 64 * j) * 4);
                v[j].x += bf2f(s0.x & 0xffffu) + bf2f(s1.x & 0xffffu); v[j].y += bf2f(s0.x >> 16) + bf2f(s1.x >> 16); v[j].z += bf2f(s0.y & 0xffffu) + bf2f(s1.y & 0xffffu); v[j].w += bf2f(s0.y >> 16) + bf2f(s1.y >> 16);
            }
#ifdef DBG_SANITIZE
            if (MODE >= 2) { if (!(fabsf(v[j].x) < 1e30f)) v[j].x = 0.f; if (!(fabsf(v[j].y) < 1e30f)) v[j].y = 0.f; if (!(fabsf(v[j].z) < 1e30f)) v[j].z = 0.f; if (!(fabsf(v[j].w) < 1e30f)) v[j].w = 0.f; }
#endif
            s += v[j].x * v[j].x + v[j].y * v[j].y + v[j].z * v[j].z + v[j].w * v[j].w; }
        s = wave_sum(s);
        const float rstd = rsqrtf(s * (1.f / D_MODEL) + RMS_EPS);
        float lg[8];
#pragma unroll
        for (int e = 0; e < 8; ++e) lg[e] = 0.f;
#pragma unroll
        for (int j = 0; j < 4; ++j) {
            const int c0 = (lane + 64 * j) * 4;
            const float4 gg = *(const float4*)(g + c0);
            const float h0 = v[j].x * rstd * gg.x, h1 = v[j].y * rstd * gg.y, h2 = v[j].z * rstd * gg.z, h3 = v[j].w * rstd * gg.w;
            if (MODE >= 2) { *(float4*)(outf + (size_t)row * D_MODEL + c0) = make_float4(h0, h1, h2, h3); }
            else { uint2 o; o.x = pk2(h0, h1); o.y = pk2(h2, h3); *(uint2*)(xn + (size_t)row * D_MODEL + c0) = o; }
            if (MODE == 1) {
                const float hh[4] = {h0, h1, h2, h3};
#pragma unroll
                for (int i = 0; i < 4; ++i) {
                    const float4 r0 = *(const float4*)(router + (size_t)(c0 + i) * 8), r1 = *(const float4*)(router + (size_t)(c0 + i) * 8 + 4);
                    lg[0] += hh[i] * r0.x; lg[1] += hh[i] * r0.y; lg[2] += hh[i] * r0.z; lg[3] += hh[i] * r0.w;
                    lg[4] += hh[i] * r1.x; lg[5] += hh[i] * r1.y; lg[6] += hh[i] * r1.z; lg[7] += hh[i] * r1.w;
                }
            }
        }
        if (MODE == 1) {
#pragma unroll
            for (int e = 0; e < 8; ++e) lg[e] = wave_sum(lg[e]);
            if (lane == 0) {
                int i0 = 0; float v0 = lg[0];
#pragma unroll
                for (int e = 1; e < 8; ++e) if (lg[e] > v0) { v0 = lg[e]; i0 = e; }
                int i1 = -1; float v1 = -3.0e38f;
#pragma unroll
                for (int e = 0; e < 8; ++e) if (e != i0 && lg[e] > v1) { v1 = lg[e]; i1 = e; }
                const float e1 = __expf(v1 - v0), inv = 1.f / (1.f + e1);
                if (i1 < 0) i1 = (i0 + 1) & 7;
                route_e[row] = i0 | (i1 << 8); route_g[row] = make_float2(inv, e1 * inv);
            }
        }
    }
}


struct MoeTabs { int* route_e; float2* route_g; int2* pos; int* rowidx; float* gatepos; int* segt; };
__device__ __forceinline__ int wave_sum_i(int v) {
#pragma unroll
    for (int o = 1; o < 64; o <<= 1) v += __shfl_xor(v, o);
    return v;
}
__device__ __forceinline__ void moe_build_lists(LAS unsigned char* lds, int bid, int G, const MoeTabs& T) {
    int tid_ = threadIdx.x; asm volatile("" : "+v"(tid_));
    const int tid = tid_, lane = tid & 63, wave = __builtin_amdgcn_readfirstlane(tid >> 6);
    LAS int* cnt = (LAS int*)lds;
#pragma unroll 1
    for (int tb = bid; tb < TOK / 64; tb += G) {
        __syncthreads();
        if (tid < 32) cnt[tid] = 0;
        __syncthreads();
        int ct[8], cp[8];
#pragma unroll
        for (int k = 0; k < 8; ++k) { ct[k] = 0; cp[k] = 0; }
        for (int tok = tid; tok < TOK; tok += NTHREADS) {
            const int e = T.route_e[tok], e0 = e & 0xff, e1 = (e >> 8) & 0xff; const bool before = tok < 64 * tb;
#pragma unroll
            for (int k = 0; k < 8; ++k) { const int c = (e0 == k ? 1 : 0) + (e1 == k ? 1 : 0); ct[k] += c; cp[k] += before ? c : 0; }
        }
#pragma unroll
        for (int k = 0; k < 8; ++k) { const int a = wave_sum_i(ct[k]), b = wave_sum_i(cp[k]); if (lane == 0) { atomicAdd((int*)&cnt[k], a); atomicAdd((int*)&cnt[8 + k], b); } }
        __syncthreads();
        if (tid == 0) { int s = 0; for (int k = 0; k < 8; ++k) { cnt[16 + k] = s; s += (cnt[k] + 255) & ~255; } cnt[24] = s; }
        __syncthreads();
        if (wave == 0) {
            const int tok = 64 * tb + lane; const int e = T.route_e[tok], e0 = e & 0xff, e1 = (e >> 8) & 0xff; const float2 gg = T.route_g[tok];
            const unsigned long long below = (1ull << lane) - 1ull; int p0 = 0, p1 = 0;
#pragma unroll
            for (int k = 0; k < 8; ++k) {
                const unsigned long long m0 = __ballot(e0 == k), m1 = __ballot(e1 == k);
                const int r = __popcll(m0 & below) + __popcll(m1 & below) + cnt[16 + k] + cnt[8 + k];
                if (e0 == k) p0 = r; if (e1 == k) p1 = r;
            }
            T.pos[tok] = make_int2(p0, p1); T.rowidx[p0] = tok; T.rowidx[p1] = tok; T.gatepos[p0] = gg.x; T.gatepos[p1] = gg.y;
        }
        if (tb == 0) {
            for (int k = 0; k < 8; ++k) for (int p = cnt[16 + k] + cnt[k] + tid; p < cnt[17 + k]; p += NTHREADS) { T.rowidx[p] = 0; T.gatepos[p] = 0.f; }
            if (tid < 9) T.segt[tid] = cnt[16 + tid] >> 8;
        }
    }
}
typedef float f32x16 __attribute__((ext_vector_type(16)));
typedef short s16x4 __attribute__((ext_vector_type(4)));
constexpr int ATT_OSTRSB = 144;
constexpr int ATT_WAVE_BYTES = 8192 + 64 * ATT_OSTRSB, ATT_TBL = 8 * ATT_WAVE_BYTES, ATT_SCR = ATT_TBL + 8 * 260 * 4, ATT_SSQ = ATT_SCR + 8 * 64 * 4, ATT_LDS = ATT_SSQ + 8 * 64 * 4;
constexpr float LOG2E = 1.4426950408889634f;
__device__ __forceinline__ int crow(int r, int hi) { return (r & 3) + 8 * (r >> 2) + 4 * hi; }
__device__ __forceinline__ s16x4 vtr(const LAS unsigned char* p) { return __builtin_bit_cast(s16x4, __builtin_amdgcn_ds_read_tr16_b64_v4i16((LAS s16x4*)p)); }
__device__ __forceinline__ bf16x8 scale_q(uint4 u) {
    const unsigned w[4] = {u.x, u.y, u.z, u.w}; unsigned o[4];
#pragma unroll
    for (int i = 0; i < 4; ++i) o[i] = pk2(bf2f(w[i] & 0xffffu) * 0.125f, bf2f(w[i] >> 16) * 0.125f);
    return __builtin_bit_cast(bf16x8, make_uint4(o[0], o[1], o[2], o[3]));
}
__device__ __forceinline__ void attn_qblock(int qb, int b, int n, int h, int lane, LAS unsigned char* vt, LAS float* scr, const LAS float* mytbl, const bf16_t* __restrict__ proj) {
    const int r32 = lane & 31, hi = lane >> 5;
    const size_t row0 = (size_t)b * SEQ + n * CHUNK;
    bf16x8 qr[4];
    {
        const bf16_t* qp = proj + (row0 + qb * 32 + r32) * IN_COLS + C_QA + h * 64 + 8 * hi;
#pragma unroll
        for (int ds = 0; ds < 4; ++ds) qr[ds] = scale_q(*(const uint4*)(qp + 16 * ds));
    }
    float m = -1.0e30f, l = 0.f; f32x16 o0, o1;
#pragma unroll
    for (int r = 0; r < 16; ++r) { o0[r] = 0.f; o1[r] = 0.f; }
    const int iq = qb * 32 + r32;
    const int j_lo = (n >= 8) ? 0 : 2 * (8 - n);
    const int trow = (4 * hi + ((lane & 15) >> 2)) * 128 + ((lane >> 4) & 1) * 32 + (lane & 3) * 8;
    uint4 vv[4]; bf16x8 kf[4];
    auto load_tile = [&](int j, uint4 (&v_)[4], bf16x8 (&k_)[4]) {
        const size_t krow0 = (size_t)b * SEQ + (size_t)(n - 8) * CHUNK + (size_t)j * 32;
        const bf16_t* vp = proj + (krow0 + (lane >> 1)) * IN_COLS + C_VA + h * 64 + (lane & 1) * 32;
#pragma unroll
        for (int i = 0; i < 4; ++i) v_[i] = *(const uint4*)(vp + 8 * i);
        const bf16_t* kp = proj + (krow0 + r32) * IN_COLS + C_KA + h * 64 + 8 * hi;
#pragma unroll
        for (int ds = 0; ds < 4; ++ds) k_[ds] = *(const bf16x8*)(kp + 16 * ds);
    };
    load_tile(j_lo, vv, kf);
#pragma unroll
    for (int i = 0; i < 4; ++i) *(LAS v4u*)(vt + (lane >> 1) * 128 + (lane & 1) * 64 + i * 16) = (v4u){vv[i].x, vv[i].y, vv[i].z, vv[i].w};
#pragma unroll 1
    for (int j = j_lo; j < 18; ++j) {
        f32x16 p0;
#pragma unroll
        for (int r = 0; r < 16; ++r) p0[r] = 0.f;
#pragma unroll
        for (int ds = 0; ds < 4; ++ds) p0 = __builtin_amdgcn_mfma_f32_32x32x16_bf16(kf[ds], qr[ds], p0, 0, 0, 0);
        __builtin_amdgcn_sched_barrier(0);
        if (j < 17) load_tile(j + 1, vv, kf);
        if (j < 12) {
            const float bc = mytbl[256];
#pragma unroll
            for (int r = 0; r < 16; ++r) p0[r] = p0[r] * LOG2E + bc;
        } else {
            const int base = iq + 512 - 32 * j;
#pragma unroll
            for (int r = 0; r < 16; ++r) { int i0 = base - crow(r, hi); i0 = (i0 > 128 ? 128 : i0) + 128; p0[r] = p0[r] * LOG2E + mytbl[i0]; }
        }
        float mt = p0[0];
#pragma unroll
        for (int r = 1; r < 16; ++r) mt = fmaxf(mt, p0[r]);
        mt = fmaxf(mt, __shfl_xor(mt, 32));
        if (__any(mt > m + 8.f)) {
            const float mn = fmaxf(m, mt), alpha = __builtin_amdgcn_exp2f(m - mn);
            m = mn; l *= alpha;
            if (hi == 0) scr[r32] = alpha;
#pragma unroll
            for (int r = 0; r < 16; ++r) { const float a = scr[crow(r, hi)]; o0[r] *= a; o1[r] *= a; }
        }
        float rs = 0.f;
#pragma unroll
        for (int r = 0; r < 16; ++r) { p0[r] = __builtin_amdgcn_exp2f(p0[r] - m); rs += p0[r]; }
        rs += __shfl_xor(rs, 32);
        l += rs;
        bf16x8 pa[2];
#pragma unroll
        for (int s = 0; s < 2; ++s)
            pa[s] = __builtin_bit_cast(bf16x8, make_uint4(cvtpk(p0[8 * s + 0], p0[8 * s + 1]), cvtpk(p0[8 * s + 2], p0[8 * s + 3]), cvtpk(p0[8 * s + 4], p0[8 * s + 5]), cvtpk(p0[8 * s + 6], p0[8 * s + 7])));
#pragma unroll
        for (int ks = 0; ks < 2; ++ks) {
            const LAS unsigned char* vb = vt + ks * 16 * 128 + trow;
            const s16x4 a0 = vtr(vb), a1 = vtr(vb + 8 * 128), b0 = vtr(vb + 64), b1 = vtr(vb + 8 * 128 + 64);
            const bf16x8 v0 = (bf16x8){a0[0], a0[1], a0[2], a0[3], a1[0], a1[1], a1[2], a1[3]}, v1 = (bf16x8){b0[0], b0[1], b0[2], b0[3], b1[0], b1[1], b1[2], b1[3]};
            o0 = __builtin_amdgcn_mfma_f32_32x32x16_bf16(pa[ks], v0, o0, 0, 0, 0);
            o1 = __builtin_amdgcn_mfma_f32_32x32x16_bf16(pa[ks], v1, o1, 0, 0, 0);
        }
        if (j < 17) {
#pragma unroll
            for (int i = 0; i < 4; ++i) *(LAS v4u*)(vt + (lane >> 1) * 128 + (lane & 1) * 64 + i * 16) = (v4u){vv[i].x, vv[i].y, vv[i].z, vv[i].w};
        }
    }
    if (hi == 0) scr[r32] = 1.f / l;
    LAS unsigned char* ost = vt + 8192;
#pragma unroll
    for (int r = 0; r < 16; ++r) {
        const int q = crow(r, hi); const float il = scr[q];
        *(LAS unsigned short*)(ost + (qb * 32 + q) * ATT_OSTRSB + r32 * 2) = (unsigned short)f2bf(o0[r] * il);
        *(LAS unsigned short*)(ost + (qb * 32 + q) * ATT_OSTRSB + (32 + r32) * 2) = (unsigned short)f2bf(o1[r] * il);
    }
}
__device__ __forceinline__ void attn_half_unit(LAS unsigned char* ldsp, int b, int n, int qb, const bf16_t* __restrict__ proj, const float* __restrict__ rel_bias, const float* __restrict__ gnorm, bf16_t* ymix) {
    int tid_ = threadIdx.x; asm volatile("" : "+v"(tid_));
    const int tid = tid_, lane = tid & 63, h = __builtin_amdgcn_readfirstlane(tid >> 6), r32 = lane & 31, hi = lane >> 5;
    LAS float* tbl = (LAS float*)(ldsp + ATT_TBL);
    __syncthreads();
    for (int i = tid; i < 8 * 257; i += NTHREADS) { const int e = i / 257, k = i - e * 257; tbl[e * 260 + k] = rel_bias[k * 8 + e] * LOG2E; }
    __syncthreads();
    LAS unsigned char* vt = ldsp + h * ATT_WAVE_BYTES;
    LAS float* scr = (LAS float*)(ldsp + ATT_SCR) + h * 64;
    LAS float* ssq = (LAS float*)(ldsp + ATT_SSQ);
    attn_qblock(qb, b, n, h, lane, vt, scr, tbl + h * 260, proj);
    float v[32]; float s = 0.f;
    {
        const LAS unsigned char* orow = vt + 8192 + (qb * 32 + r32) * ATT_OSTRSB + hi * 64;
#pragma unroll
        for (int d = 0; d < 32; d += 8) { const v4u u = *(const LAS v4u*)(orow + d * 2); const unsigned w_[4] = {u.x, u.y, u.z, u.w};
#pragma unroll
            for (int i = 0; i < 4; ++i) { v[d + 2 * i] = bf2f(w_[i] & 0xffffu); v[d + 2 * i + 1] = bf2f(w_[i] >> 16); s += v[d + 2 * i] * v[d + 2 * i] + v[d + 2 * i + 1] * v[d + 2 * i + 1]; } }
    }
    s += __shfl_xor(s, 32);
    if (hi == 0) ssq[h * 64 + r32] = s;
    __syncthreads();
    float tot = 0.f;
#pragma unroll
    for (int e = 0; e < 8; ++e) tot += ssq[e * 64 + r32];
    const float rstd = rsqrtf(tot * (1.f / AW) + RMS_EPS);
    const float* gp = gnorm + h * 64 + hi * 32;
    bf16_t* op = ymix + ((size_t)b * SEQ + n * CHUNK + qb * 32 + r32) * D_MODEL + RW + h * 64 + hi * 32;
#pragma unroll
    for (int d = 0; d < 32; d += 8) {
        const float4 g0 = *(const float4*)(gp + d), g1 = *(const float4*)(gp + d + 4);
        uint4 o; o.x = pk2(v[d] * rstd * g0.x, v[d + 1] * rstd * g0.y); o.y = pk2(v[d + 2] * rstd * g0.z, v[d + 3] * rstd * g0.w);
        o.z = pk2(v[d + 4] * rstd * g1.x, v[d + 5] * rstd * g1.y); o.w = pk2(v[d + 6] * rstd * g1.z, v[d + 7] * rstd * g1.w);
        *(uint4*)(op + d) = o;
    }
}
constexpr int R1_RS = 72, R1_RSB = R1_RS * 2;
constexpr int R1_MAT = 64 * R1_RSB;
constexpr int R1_SGRSB = 136 * 2;
constexpr int R1_X = 0;
constexpr int R1_TW = R1_X, R1_AD = R1_X + R1_MAT, R1_SG = R1_X + 2 * R1_MAT;
constexpr int R1_MAB = R1_X, R1_MAK = R1_X + R1_MAT, R1_NRB = R1_X + 2 * R1_MAT, R1_NRK = R1_X + 3 * R1_MAT;
constexpr int R1_Y = R1_X + 4 * R1_MAT;
constexpr int R1_FRS = 68;
constexpr int R1_WL = R1_Y, R1_AL = R1_Y + 64 * R1_FRS * 4;
constexpr int R1_Z = R1_Y + 2 * 64 * R1_FRS * 4;
constexpr int R1_AH = R1_Z, R1_BH = R1_Z + R1_MAT, R1_KH = R1_Z + 2 * R1_MAT, R1_RH = R1_Z + 3 * R1_MAT, R1_BTT = R1_Z + 4 * R1_MAT, R1_KTT = R1_Z + 5 * R1_MAT, R1_VT = R1_Z + 6 * R1_MAT;
constexpr int R1_TII = R1_Z + 7 * R1_MAT;
constexpr int R1_TIIRSB = 48;
constexpr int R1_MD = R1_TII + 4 * 16 * R1_TIIRSB;
constexpr int R1_TOT = R1_MD + 4 * 16 * 17 * 4;
constexpr int R1_GC = R1_TOT + 8 * 64 * 4;
constexpr int R1_LDS = R1_GC + 256;
__device__ __forceinline__ float fexp(float x) { return __builtin_amdgcn_exp2f(x * 1.4426950408889634f); }
__device__ __forceinline__ float fsigmoid(float x) { return __builtin_amdgcn_rcpf(1.f + __builtin_amdgcn_exp2f(-1.4426950408889634f * x)); }
__device__ __forceinline__ float ftanh(float x) { return 1.f - 2.f * __builtin_amdgcn_rcpf(1.f + __builtin_amdgcn_exp2f(2.8853900817779268f * x)); }
#define R1_BAR() do { asm volatile("s_waitcnt lgkmcnt(0)" ::: "memory"); __builtin_amdgcn_s_barrier(); asm volatile("" ::: "memory"); } while (0)
#ifndef PROF_PHASE
#define R1REP(k) 1
#else
#define R1REP(k) ((PROF_PHASE == (k)) ? 2 : 1)
#endif
struct RwkvW { const float *mu, *w0, *a0, *k_k, *k_a, *r_k; const bf16_t *w2T, *a2T, *g2T; };
struct RwkvChunkOut { bf16_t *Gp, *Qp, *HT, *ZT, *gate; float* bonus; unsigned* dbg; };
typedef unsigned u2v __attribute__((ext_vector_type(2)));
__device__ __forceinline__ bf16x8 mk8(u2v a, u2v b) { return __builtin_bit_cast(bf16x8, (v4u){a.x, a.y, b.x, b.y}); }
__device__ __forceinline__ bf16x8 packx(const f32x4& a, const f32x4& b) { return __builtin_bit_cast(bf16x8, (v4u){cvtpk(a[0], a[1]), cvtpk(a[2], a[3]), cvtpk(b[0], b[1]), cvtpk(b[2], b[3])}); }
#define MFMA16(a, b, c) __builtin_amdgcn_mfma_f32_16x16x32_bf16((a), (b), (c), 0, 0, 0)
struct RawIn { uint4 cu[7], pu[7]; };
__device__ __forceinline__ void r1_raw_load(RawIn& R, int unit, const bf16_t* __restrict__ proj, int tk, int sub) {
    const int c = unit & 31, h = (unit >> 5) & 7, b = unit >> 8;
    const bf16_t* pr = proj + ((size_t)b * SEQ + c * CHUNK + tk) * IN_COLS; const bool has_prev = (c * CHUNK + tk) > 0;
    const int cols[7] = {C_WD + sub * 8, C_AD + sub * 8, C_GD + sub * 16, C_GD + sub * 16 + 8, C_R + h * 64 + sub * 8, C_K + h * 64 + sub * 8, C_V + h * 64 + sub * 8};
#pragma unroll
    for (int i = 0; i < 7; ++i) { R.cu[i] = *(const uint4*)(pr + cols[i]); R.pu[i] = make_uint4(0, 0, 0, 0); if (has_prev) R.pu[i] = *(const uint4*)(pr - IN_COLS + cols[i]); }
}
__device__ __forceinline__ void rwkv_chunk_unit(LAS unsigned char* lds, int unit, int next_unit, RawIn& raw, const bf16_t* __restrict__ proj, const RwkvW& W0, const RwkvChunkOut& O) {
    int tid_ = threadIdx.x; asm volatile("" : "+v"(tid_));
    const int tid = tid_, lane = tid & 63, w = __builtin_amdgcn_readfirstlane(tid >> 6), li = lane & 15, g = lane >> 4;
    const int c = unit & 31, h = (unit >> 5) & 7, b = unit >> 8;
    const int tk = tid >> 3, sub = tid & 7;
    RwkvW W = W0;
    asm volatile("" : "+s"(W.mu), "+s"(W.w0), "+s"(W.a0), "+s"(W.k_k), "+s"(W.k_a), "+s"(W.r_k), "+s"(W.w2T), "+s"(W.a2T), "+s"(W.g2T));
    const size_t row = (size_t)b * SEQ + c * CHUNK + tk;
    const f32x4 z4 = {0.f, 0.f, 0.f, 0.f};
#define LDF(base, rsb, row0, k0) (*(const LAS bf16x8*)(lds + (base) + ((row0) + li) * (rsb) + ((k0) + 8 * g) * 2))
#define LDP(base, row0, pair) mk8(*(const LAS u2v*)(lds + (base) + ((row0) + li) * R1_RSB + (32 * (pair) + 4 * g) * 2), *(const LAS u2v*)(lds + (base) + ((row0) + li) * R1_RSB + (32 * (pair) + 16 + 4 * g) * 2))
    float rr[8], kv[8], vv[8];
    for (int r1_ = 0; r1_ < R1REP(101); ++r1_) {
    R1_BAR();

    {
        r1_raw_load(raw, unit, proj, tk, sub);
        auto ld8 = [&](int gi, int col, float (&o)[8]) {
            const uint4 cu = raw.cu[gi], pu = raw.pu[gi];
            const float4 m0 = *(const float4*)(W.mu + col), m1 = *(const float4*)(W.mu + col + 4);
            const unsigned cw[4] = {cu.x, cu.y, cu.z, cu.w}, pw[4] = {pu.x, pu.y, pu.z, pu.w}; const float mm[8] = {m0.x, m0.y, m0.z, m0.w, m1.x, m1.y, m1.z, m1.w};
#pragma unroll
            for (int i = 0; i < 4; ++i) { const float c0 = bf2f(cw[i] & 0xffffu), c1 = bf2f(cw[i] >> 16), p0 = bf2f(pw[i] & 0xffffu), p1 = bf2f(pw[i] >> 16);
                o[2 * i] = c0 + mm[2 * i] * (p0 - c0); o[2 * i + 1] = c1 + mm[2 * i + 1] * (p1 - c1); }
        };
        float t8[8];
        ld8(0, C_WD + sub * 8, t8);
        *(LAS v4u*)(lds + R1_TW + tk * R1_RSB + sub * 16) = (v4u){cvtpk(ftanh(t8[0]), ftanh(t8[1])), cvtpk(ftanh(t8[2]), ftanh(t8[3])), cvtpk(ftanh(t8[4]), ftanh(t8[5])), cvtpk(ftanh(t8[6]), ftanh(t8[7]))};
        ld8(1, C_AD + sub * 8, t8);
        *(LAS v4u*)(lds + R1_AD + tk * R1_RSB + sub * 16) = (v4u){cvtpk(t8[0], t8[1]), cvtpk(t8[2], t8[3]), cvtpk(t8[4], t8[5]), cvtpk(t8[6], t8[7])};
#pragma unroll
        for (int q = 0; q < 2; ++q) {
            ld8(2 + q, C_GD + sub * 16 + q * 8, t8);
            *(LAS v4u*)(lds + R1_SG + tk * R1_SGRSB + sub * 32 + q * 16) = (v4u){cvtpk(fsigmoid(t8[0]), fsigmoid(t8[1])), cvtpk(fsigmoid(t8[2]), fsigmoid(t8[3])), cvtpk(fsigmoid(t8[4]), fsigmoid(t8[5])), cvtpk(fsigmoid(t8[6]), fsigmoid(t8[7]))};
        }
        ld8(4, C_R + h * 64 + sub * 8, rr); ld8(5, C_K + h * 64 + sub * 8, kv); ld8(6, C_V + h * 64 + sub * 8, vv);
    }
    R1_BAR();
    {
        const int mb = w >> 1, nb0 = 2 * (w & 1);
        const bf16_t* w2r = W.w2T + (size_t)(h * 64 + 16 * mb + li) * 64 + 8 * g; const bf16_t* a2r = W.a2T + (size_t)(h * 64 + 16 * mb + li) * 64 + 8 * g;
        const bf16_t* g2r = W.g2T + (size_t)(h * 64 + 16 * mb + li) * 128 + 8 * g;
        bf16x8 wa[2], aa[2], ga[4];
#pragma unroll
        for (int ks = 0; ks < 2; ++ks) { wa[ks] = *(const bf16x8*)(w2r + 32 * ks); aa[ks] = *(const bf16x8*)(a2r + 32 * ks); }
#pragma unroll
        for (int ks = 0; ks < 4; ++ks) ga[ks] = *(const bf16x8*)(g2r + 32 * ks);
#pragma unroll
        for (int q = 0; q < 2; ++q) {
            const int nb = nb0 + q;
            f32x4 aw = z4, a_ = z4, ag = z4;
#pragma unroll
            for (int ks = 0; ks < 2; ++ks) { aw = MFMA16(wa[ks], LDF(R1_TW, R1_RSB, 16 * nb, 32 * ks), aw); a_ = MFMA16(aa[ks], LDF(R1_AD, R1_RSB, 16 * nb, 32 * ks), a_); }
#pragma unroll
            for (int ks = 0; ks < 4; ++ks) ag = MFMA16(ga[ks], LDF(R1_SG, R1_SGRSB, 16 * nb, 32 * ks), ag);
            const int t = 16 * nb + li, ch = 16 * mb + 4 * g;
            *(LAS f32x4*)(lds + R1_WL + (t * R1_FRS + ch) * 4) = aw;
            *(LAS f32x4*)(lds + R1_AL + (t * R1_FRS + ch) * 4) = a_;
            *(uint2*)(O.gate + ((size_t)b * SEQ + c * CHUNK + t) * RW + h * 64 + ch) = make_uint2(cvtpk(ag[0], ag[1]), cvtpk(ag[2], ag[3]));
#if defined(DBG_RWKV) && (DBG_RWKV == 12 || DBG_RWKV == 13)
            {
                const bf16x8 ones = __builtin_bit_cast(bf16x8, (v4u){0x3f803f80u, 0x3f803f80u, 0x3f803f80u, 0x3f803f80u});
                f32x4 t1 = z4, t2 = z4;
                for (int ks = 0; ks < 4; ++ks) { t1 = MFMA16(ones, LDF(R1_SG, R1_SGRSB, 16 * nb, 32 * ks), t1); t2 = MFMA16(ga[ks], ones, t2); }
                const size_t eo = ((size_t)b * SEQ + c * CHUNK + t) * RW + h * 64 + ch;
                *(uint2*)(O.Gp + eo) = make_uint2(cvtpk(t1[0], t1[1]), cvtpk(t1[2], t1[3]));
                *(uint2*)(O.Qp + eo) = make_uint2(cvtpk(t2[0], t2[1]), cvtpk(t2[2], t2[3]));
                *(uint2*)(O.HT + eo) = make_uint2(cvtpk(aw[0], aw[1]), cvtpk(aw[2], aw[3]));
            }
#endif
        }
    }
    }
    R1_BAR();
    float ld_[8], av[8], kk[8], kp[8], Lc[8];
    for (int r2_ = 0; r2_ < R1REP(102); ++r2_) {

    {
        const int c0 = h * 64 + sub * 8;
        const f32x4 wl0 = *(const LAS f32x4*)(lds + R1_WL + (tk * R1_FRS + sub * 8) * 4), wl1 = *(const LAS f32x4*)(lds + R1_WL + (tk * R1_FRS + sub * 8 + 4) * 4);
        const f32x4 al0 = *(const LAS f32x4*)(lds + R1_AL + (tk * R1_FRS + sub * 8) * 4), al1 = *(const LAS f32x4*)(lds + R1_AL + (tk * R1_FRS + sub * 8 + 4) * 4);
        const float wl[8] = {wl0[0], wl0[1], wl0[2], wl0[3], wl1[0], wl1[1], wl1[2], wl1[3]}, al[8] = {al0[0], al0[1], al0[2], al0[3], al1[0], al1[1], al1[2], al1[3]};
        float ss = 0.f, bon = 0.f;
#pragma unroll
        for (int i = 0; i < 8; ++i) {
            ld_[i] = -0.6065306597126334f * fsigmoid(wl[i] + W.w0[c0 + i]);
            av[i] = fsigmoid(al[i] + W.a0[c0 + i]);
            kk[i] = kv[i] * W.k_k[c0 + i]; ss += kk[i] * kk[i];
            kp[i] = kv[i] * (1.f + (av[i] - 1.f) * W.k_a[c0 + i]);
            bon += rr[i] * kp[i] * W.r_k[c0 + i];
        }
        ss += __shfl_xor(ss, 1); ss += __shfl_xor(ss, 2); ss += __shfl_xor(ss, 4);
        bon += __shfl_xor(bon, 1); bon += __shfl_xor(bon, 2); bon += __shfl_xor(bon, 4);
        const float inv = __builtin_amdgcn_rsqf(fmaxf(ss, 1e-24f));
#pragma unroll
        for (int i = 0; i < 8; ++i) kk[i] *= inv;
        if (sub == 0) O.bonus[row * NH + h] = bon;
        const int tl = lane >> 3;
#pragma unroll
        for (int i = 0; i < 8; ++i) {
            float x = ld_[i];
            float y = __shfl_up(x, 8); if (tl >= 1) x += y;
            y = __shfl_up(x, 16); if (tl >= 2) x += y;
            y = __shfl_up(x, 32); if (tl >= 4) x += y;
            Lc[i] = x;
        }
        if (tl == 7) { *(LAS f32x4*)(lds + R1_TOT + (w * 64 + sub * 8) * 4) = (f32x4){Lc[0], Lc[1], Lc[2], Lc[3]}; *(LAS f32x4*)(lds + R1_TOT + (w * 64 + sub * 8 + 4) * 4) = (f32x4){Lc[4], Lc[5], Lc[6], Lc[7]}; }
    }
    R1_BAR();
    {
        float off[8], tot[8];
#pragma unroll
        for (int i = 0; i < 8; ++i) { off[i] = 0.f; tot[i] = 0.f; }
#pragma unroll
        for (int ww = 0; ww < 8; ++ww) {
            const f32x4 t0 = *(const LAS f32x4*)(lds + R1_TOT + (ww * 64 + sub * 8) * 4), t1 = *(const LAS f32x4*)(lds + R1_TOT + (ww * 64 + sub * 8 + 4) * 4);
            const float tt[8] = {t0[0], t0[1], t0[2], t0[3], t1[0], t1[1], t1[2], t1[3]};
#pragma unroll
            for (int i = 0; i < 8; ++i) { tot[i] += tt[i]; if (ww < w) off[i] += tt[i]; }
        }
        float ah[8], bh[8], kh[8], rh[8], bt[8], kt[8];
#pragma unroll
        for (int i = 0; i < 8; ++i) {
            const float L = Lc[i] + off[i];
            const float eL = fexp(L), eLx = fexp(L - ld_[i]), enL = fexp(-L), eCL = fexp(tot[i] - L);
            const float bb = kk[i] * av[i];
            ah[i] = -kk[i] * eLx; bh[i] = bb * enL; kh[i] = kp[i] * enL; rh[i] = rr[i] * eL; bt[i] = bb * eCL; kt[i] = kp[i] * eCL;
        }
        *(LAS v4u*)(lds + R1_AH + tk * R1_RSB + sub * 16) = (v4u){cvtpk(ah[0], ah[1]), cvtpk(ah[2], ah[3]), cvtpk(ah[4], ah[5]), cvtpk(ah[6], ah[7])};
        *(LAS v4u*)(lds + R1_BH + tk * R1_RSB + sub * 16) = (v4u){cvtpk(bh[0], bh[1]), cvtpk(bh[2], bh[3]), cvtpk(bh[4], bh[5]), cvtpk(bh[6], bh[7])};
        *(LAS v4u*)(lds + R1_KH + tk * R1_RSB + sub * 16) = (v4u){cvtpk(kh[0], kh[1]), cvtpk(kh[2], kh[3]), cvtpk(kh[4], kh[5]), cvtpk(kh[6], kh[7])};
        *(LAS v4u*)(lds + R1_RH + tk * R1_RSB + sub * 16) = (v4u){cvtpk(rh[0], rh[1]), cvtpk(rh[2], rh[3]), cvtpk(rh[4], rh[5]), cvtpk(rh[6], rh[7])};
#pragma unroll
        for (int i = 0; i < 8; ++i) {
            const int chn = sub * 8 + i;
            *(LAS unsigned short*)(lds + R1_BTT + chn * R1_RSB + tk * 2) = (unsigned short)f2bf(bt[i]);
            *(LAS unsigned short*)(lds + R1_KTT + chn * R1_RSB + tk * 2) = (unsigned short)f2bf(kt[i]);
            *(LAS unsigned short*)(lds + R1_VT + chn * R1_RSB + tk * 2) = (unsigned short)f2bf(vv[i]);
        }
        if (tk == 63) {
#pragma unroll
            for (int i = 0; i < 8; ++i) *(LAS float*)(lds + R1_GC + (sub * 8 + i) * 4) = fexp(tot[i]);
        }
    }
    R1_BAR();
    }
    for (int r3_ = 0; r3_ < R1REP(103); ++r3_) {
    {
        const int mb = w >> 1, nb0 = 2 * (w & 1);
        const bf16x8 fa0 = LDF(R1_AH, R1_RSB, 16 * mb, 0), fa1 = LDF(R1_AH, R1_RSB, 16 * mb, 32), fr0 = LDF(R1_RH, R1_RSB, 16 * mb, 0), fr1 = LDF(R1_RH, R1_RSB, 16 * mb, 32);
#pragma unroll
        for (int q = 0; q < 2; ++q) {
            const int nb = nb0 + q;
            f32x4 mab = z4, mak = z4, nrb = z4, nrk = z4;
            if (nb <= mb) {
                const bf16x8 fb0 = LDF(R1_BH, R1_RSB, 16 * nb, 0), fb1 = LDF(R1_BH, R1_RSB, 16 * nb, 32), fk0 = LDF(R1_KH, R1_RSB, 16 * nb, 0), fk1 = LDF(R1_KH, R1_RSB, 16 * nb, 32);
                mab = MFMA16(fa0, fb0, mab); mab = MFMA16(fa1, fb1, mab); mak = MFMA16(fa0, fk0, mak); mak = MFMA16(fa1, fk1, mak);
                nrb = MFMA16(fr0, fb0, nrb); nrb = MFMA16(fr1, fb1, nrb); nrk = MFMA16(fr0, fk0, nrk); nrk = MFMA16(fr1, fk1, nrk);
            }
            const int s = 16 * nb + li;
#pragma unroll
            for (int r = 0; r < 4; ++r) {
                const int t = 16 * mb + 4 * g + r; const bool lo = s < t, le = s <= t;
                const float m1 = lo ? mab[r] : 0.f, m2 = lo ? mak[r] : 0.f, n1 = le ? nrb[r] : 0.f, n2 = le ? nrk[r] : 0.f;
                *(LAS unsigned short*)(lds + R1_MAB + t * R1_RSB + s * 2) = (unsigned short)f2bf(m1);
                *(LAS unsigned short*)(lds + R1_MAK + t * R1_RSB + s * 2) = (unsigned short)f2bf(m2);
                *(LAS unsigned short*)(lds + R1_NRB + t * R1_RSB + s * 2) = (unsigned short)f2bf(n1);
                *(LAS unsigned short*)(lds + R1_NRK + t * R1_RSB + s * 2) = (unsigned short)f2bf(n2);
                if (nb == mb) *(LAS float*)(lds + R1_MD + ((mb * 16 + 4 * g + r) * 17 + li) * 4) = m1;
            }
        }
    }
    R1_BAR();
    }
    f32x4 acc[4]; f32x4 X0, X1, X2, X3;
    for (int r4_ = 0; r4_ < R1REP(104); ++r4_) { if (r4_) R1_BAR();

    if (w == 0) {
        float T[16];
        const LAS float* md = (const LAS float*)(lds + R1_MD) + g * 16 * 17;
#pragma unroll
        for (int r = 0; r < 16; ++r) {
            float a = (r == li) ? 1.f : 0.f;
#pragma unroll
            for (int s = 0; s < r; ++s) a += md[r * 17 + s] * T[s];
            T[r] = a;
            *(LAS unsigned short*)(lds + R1_TII + (g * 16 + r) * R1_TIIRSB + li * 2) = (unsigned short)f2bf(a);
        }
    }
    if (w >= 4) {
        const int vb = w - 4;
#pragma unroll
        for (int mb = 0; mb < 4; ++mb) { acc[mb] = z4;
#pragma unroll
            for (int ks = 0; ks < 2; ++ks) acc[mb] = MFMA16(LDF(R1_MAK, R1_RSB, 16 * mb, 32 * ks), LDF(R1_VT, R1_RSB, 16 * vb, 32 * ks), acc[mb]); }
    } else {
#pragma unroll
        for (int mb = 0; mb < 4; ++mb)
#pragma unroll
            for (int r = 0; r < 4; ++r) acc[mb][r] = bf2f(*(const LAS unsigned short*)(lds + R1_AH + (16 * mb + 4 * g + r) * R1_RSB + (16 * w + li) * 2));
    }
    R1_BAR();

    {
#define LDT(i) mk8(*(const LAS u2v*)(lds + R1_TII + ((i) * 16 + li) * R1_TIIRSB + 8 * g), (u2v){0u, 0u})
#define LDM1(i, j) mk8(*(const LAS u2v*)(lds + R1_MAB + (16 * (i) + li) * R1_RSB + (16 * (j) + 4 * g) * 2), (u2v){0u, 0u})
        X0 = MFMA16(LDT(0), packx(acc[0], z4), z4);
        f32x4 a1 = MFMA16(LDM1(1, 0), packx(X0, z4), acc[1]);
        X1 = MFMA16(LDT(1), packx(a1, z4), z4);
        f32x4 a2 = MFMA16(LDP(R1_MAB, 32, 0), packx(X0, X1), acc[2]);
        X2 = MFMA16(LDT(2), packx(a2, z4), z4);
        f32x4 a3 = MFMA16(LDP(R1_MAB, 48, 0), packx(X0, X1), acc[3]);
        a3 = MFMA16(LDM1(3, 2), packx(X2, z4), a3);
        X3 = MFMA16(LDT(3), packx(a3, z4), z4);
    }
    }
    const bf16x8 x01 = packx(X0, X1), x23 = packx(X2, X3);
    for (int r5_ = 0; r5_ < R1REP(105); ++r5_) {
#if defined(DBG_RWKV) && (DBG_RWKV == 12 || DBG_RWKV == 13)
    return;
#endif
    const size_t ub = (size_t)unit * 4096;
    if (w < 4) {
        const int kb = w, pos = 32 * (kb >> 1) + 8 * g + 4 * (kb & 1);
#pragma unroll
        for (int nb = 0; nb < 4; ++nb) {
            f32x4 ag = z4;
            if (nb == kb) {
#pragma unroll
                for (int r = 0; r < 4; ++r) if (li == 4 * g + r) ag[r] = *(const LAS float*)(lds + R1_GC + (16 * kb + 4 * g + r) * 4);
            }
            ag = MFMA16(x01, LDP(R1_BTT, 16 * nb, 0), ag); ag = MFMA16(x23, LDP(R1_BTT, 16 * nb, 1), ag);
            *(uint2*)(O.Gp + ub + (size_t)(16 * nb + li) * 64 + pos) = make_uint2(cvtpk(ag[0], ag[1]), cvtpk(ag[2], ag[3]));
            const u2v rq = *(const LAS u2v*)(lds + R1_RH + (16 * nb + li) * R1_RSB + (16 * kb + 4 * g) * 2);
            f32x4 aq = {bf2f(rq.x & 0xffffu), bf2f(rq.x >> 16), bf2f(rq.y & 0xffffu), bf2f(rq.y >> 16)};
            aq = MFMA16(x01, LDP(R1_NRB, 16 * nb, 0), aq); aq = MFMA16(x23, LDP(R1_NRB, 16 * nb, 1), aq);
            *(uint2*)(O.Qp + ub + (size_t)(16 * nb + li) * 64 + pos) = make_uint2(cvtpk(aq[0], aq[1]), cvtpk(aq[2], aq[3]));
        }
    } else {
        const int vb = w - 4;
        const bf16x8 fv0 = LDF(R1_VT, R1_RSB, 16 * vb, 0), fv1 = LDF(R1_VT, R1_RSB, 16 * vb, 32);
#pragma unroll
        for (int mb = 0; mb < 4; ++mb) {
            f32x4 az = z4;
            az = MFMA16(LDP(R1_NRB, 16 * mb, 0), x01, az); az = MFMA16(LDP(R1_NRB, 16 * mb, 1), x23, az);
            az = MFMA16(LDF(R1_NRK, R1_RSB, 16 * mb, 0), fv0, az); az = MFMA16(LDF(R1_NRK, R1_RSB, 16 * mb, 32), fv1, az);
            *(uint2*)(O.ZT + ub + (size_t)(16 * vb + li) * 64 + 16 * mb + 4 * g) = make_uint2(cvtpk(az[0], az[1]), cvtpk(az[2], az[3]));
            f32x4 ah_ = z4;
            ah_ = MFMA16(LDP(R1_BTT, 16 * mb, 0), x01, ah_); ah_ = MFMA16(LDP(R1_BTT, 16 * mb, 1), x23, ah_);
            ah_ = MFMA16(LDF(R1_KTT, R1_RSB, 16 * mb, 0), fv0, ah_); ah_ = MFMA16(LDF(R1_KTT, R1_RSB, 16 * mb, 32), fv1, ah_);
            *(uint2*)(O.HT + ub + (size_t)(16 * vb + li) * 64 + 16 * mb + 4 * g) = make_uint2(cvtpk(ah_[0], ah_[1]), cvtpk(ah_[2], ah_[3]));
        }
    }
    }
#undef LDT
#undef LDM1
#undef LDF
#undef LDP
}
constexpr int R2_YRS = 65;
constexpr int R2_SLOT = 32768;
constexpr int R2_YOFF = 2 * R2_SLOT;
constexpr int R2_LDS = R2_YOFF + 2 * 64 * R2_YRS * 4;
struct RwkvScanIn { const bf16_t *Gp, *Qp, *HT, *ZT, *gate; const float* bonus; const float *mu, *ln_w, *ln_b; };
struct ChunkFrags { bf16x8 G[4][2], Q[4][2]; uint2 H[4], Z[4]; };
__device__ __forceinline__ void r2_load(ChunkFrags& F, const LAS unsigned char* slot, int vb, int li, int g) {
#pragma unroll
    for (int mb = 0; mb < 4; ++mb) {
        const int row = 16 * mb + li, sw = row & 7;
#pragma unroll
        for (int p = 0; p < 2; ++p) { const int ch = (4 * p + g) ^ sw; F.G[mb][p] = *(const LAS bf16x8*)(slot + row * 128 + ch * 16); F.Q[mb][p] = *(const LAS bf16x8*)(slot + 8192 + row * 128 + ch * 16); }
        const int rv = 16 * vb + li, chv = (2 * mb + (g >> 1)) ^ (rv & 7);
        const u2v hh = *(const LAS u2v*)(slot + 16384 + rv * 128 + chv * 16 + 8 * (g & 1)), zz = *(const LAS u2v*)(slot + 24576 + rv * 128 + chv * 16 + 8 * (g & 1));
        F.H[mb] = make_uint2(hh.x, hh.y); F.Z[mb] = make_uint2(zz.x, zz.y);
    }
}
__device__ __forceinline__ void r2_stage_load(uint4 (&st)[8], const RwkvScanIn& I, size_t ub, int lt) {
    const int row = lt >> 3, ch = lt & 7; const size_t eo = ub + (size_t)row * 64 + ch * 8 + (size_t)0;
    st[0] = *(const uint4*)(I.Gp + eo); st[1] = *(const uint4*)(I.Gp + eo + 32 * 64);
    st[2] = *(const uint4*)(I.Qp + eo); st[3] = *(const uint4*)(I.Qp + eo + 32 * 64);
    st[4] = *(const uint4*)(I.HT + eo); st[5] = *(const uint4*)(I.HT + eo + 32 * 64);
    st[6] = *(const uint4*)(I.ZT + eo); st[7] = *(const uint4*)(I.ZT + eo + 32 * 64);
}
__device__ __forceinline__ void r2_stage_write(const uint4 (&st)[8], LAS unsigned char* slot, int lt) {
    const int row = lt >> 3, ch = lt & 7;
#pragma unroll
    for (int i = 0; i < 8; ++i) { const int r = row + 32 * (i & 1), m = i >> 1; *(LAS v4u*)(slot + m * 8192 + r * 128 + ((ch ^ (r & 7)) * 16)) = (v4u){st[i].x, st[i].y, st[i].z, st[i].w}; }
}
__device__ __forceinline__ f32x4 bf4(uint2 u) { return (f32x4){bf2f(u.x & 0xffffu), bf2f(u.x >> 16), bf2f(u.y & 0xffffu), bf2f(u.y >> 16)}; }
__device__ __forceinline__ void r2_step(const ChunkFrags& F, f32x4 (&S)[4], bf16x8& s01, bf16x8& s23, LAS float* ybuf, int vb, int li, int g) {
    f32x4 Sn[4];
#pragma unroll
    for (int mb = 0; mb < 4; ++mb) {
        f32x4 y = bf4(F.Z[mb]);
        y = MFMA16(F.Q[mb][0], s01, y); y = MFMA16(F.Q[mb][1], s23, y);
#pragma unroll
        for (int r = 0; r < 4; ++r) ybuf[(16 * mb + 4 * g + r) * R2_YRS + 16 * vb + li] = y[r];
        f32x4 s = bf4(F.H[mb]);
        s = MFMA16(F.G[mb][0], s01, s); s = MFMA16(F.G[mb][1], s23, s);
        Sn[mb] = s;
    }
#pragma unroll
    for (int mb = 0; mb < 4; ++mb) S[mb] = Sn[mb];
    s01 = packx(S[0], S[1]); s23 = packx(S[2], S[3]);
}
struct EpiIn { uint4 cu[2], pu[2], gu[2]; float bon; };
__device__ __forceinline__ void r2_epi_load(EpiIn& E, int et, size_t row, int h, bool has_prev, const bf16_t* __restrict__ proj, const RwkvScanIn& I) {
    const int q4 = et & 3, c0 = h * 64 + q4 * 16;
    const bf16_t* pr = proj + row * IN_COLS + C_V + c0;
#pragma unroll
    for (int i = 0; i < 2; ++i) { E.cu[i] = *(const uint4*)(pr + 8 * i); E.pu[i] = make_uint4(0, 0, 0, 0); if (has_prev) E.pu[i] = *(const uint4*)(pr - IN_COLS + 8 * i); E.gu[i] = *(const uint4*)(I.gate + row * RW + c0 + 8 * i); }
    E.bon = I.bonus[row * NH + h];
}
__device__ __forceinline__ void r2_epilogue(const EpiIn& E, const LAS float* ybuf, int et, size_t row, int h, const RwkvScanIn& I, bf16_t* ymix) {
    const int t = et >> 2, q4 = et & 3, c0 = h * 64 + q4 * 16;
    float y[16]; float s1 = 0.f;
#pragma unroll
    for (int i = 0; i < 16; ++i) { y[i] = ybuf[t * R2_YRS + q4 * 16 + i]; s1 += y[i]; }
    s1 += __shfl_xor(s1, 1); s1 += __shfl_xor(s1, 2);
    const float mean = s1 * (1.f / 64.f); float s2 = 0.f;
#pragma unroll
    for (int i = 0; i < 16; ++i) { const float d = y[i] - mean; s2 += d * d; }
    s2 += __shfl_xor(s2, 1); s2 += __shfl_xor(s2, 2);
    const float rstd = rsqrtf(s2 * (1.f / 64.f) + GN_EPS);
    unsigned ow[8];
#pragma unroll
    for (int i = 0; i < 2; ++i) {
        const unsigned cw[4] = {E.cu[i].x, E.cu[i].y, E.cu[i].z, E.cu[i].w}, pw[4] = {E.pu[i].x, E.pu[i].y, E.pu[i].z, E.pu[i].w}, gw_[4] = {E.gu[i].x, E.gu[i].y, E.gu[i].z, E.gu[i].w};
#pragma unroll
        for (int j = 0; j < 4; ++j) {
            float o2[2];
#pragma unroll
            for (int u = 0; u < 2; ++u) {
                const int ci = c0 + 8 * i + 2 * j + u, yi = 8 * i + 2 * j + u;
                const float cur = bf2f(u ? (cw[j] >> 16) : (cw[j] & 0xffffu)), prev = bf2f(u ? (pw[j] >> 16) : (pw[j] & 0xffffu)), gt = bf2f(u ? (gw_[j] >> 16) : (gw_[j] & 0xffffu));
                const float vsh = cur + I.mu[C_V + ci] * (prev - cur);
                o2[u] = ((y[yi] - mean) * rstd * I.ln_w[ci] + I.ln_b[ci] + E.bon * vsh) * gt;
            }
            ow[4 * i + j] = pk2(o2[0], o2[1]);
        }
    }
    *(uint4*)(ymix + row * D_MODEL + c0) = make_uint4(ow[0], ow[1], ow[2], ow[3]);
    *(uint4*)(ymix + row * D_MODEL + c0 + 8) = make_uint4(ow[4], ow[5], ow[6], ow[7]);
}
__device__ __forceinline__ void rwkv_scan_unit(LAS unsigned char* lds, int unit  , const bf16_t* __restrict__ proj, const RwkvScanIn& I0, bf16_t* ymix) {
    int tid_ = threadIdx.x; asm volatile("" : "+v"(tid_));
    const int tid = tid_, lane = tid & 63, w = __builtin_amdgcn_readfirstlane(tid >> 6), li = lane & 15, g = lane >> 4;
    const int b = unit >> 3, h = unit & 7;
    RwkvScanIn I = I0;
    asm volatile("" : "+s"(I.Gp), "+s"(I.Qp), "+s"(I.HT), "+s"(I.ZT), "+s"(I.gate), "+s"(I.bonus), "+s"(I.mu), "+s"(I.ln_w), "+s"(I.ln_b));
    LAS float* ybase = (LAS float*)(lds + R2_YOFF);
#define R2_BAR() do { asm volatile("s_waitcnt lgkmcnt(0)" ::: "memory"); __builtin_amdgcn_s_barrier(); asm volatile("" ::: "memory"); } while (0)
    const size_t ub0 = (size_t)unit * NCHUNK * 4096;
    __syncthreads();
    if (w < 4) {
        const int vb = w;
        f32x4 S[4];
#pragma unroll
        for (int mb = 0; mb < 4; ++mb) S[mb] = (f32x4){0.f, 0.f, 0.f, 0.f};
        bf16x8 s01 = packx(S[0], S[1]), s23 = s01;
        ChunkFrags F;
        R2_BAR();
#pragma unroll 1
        for (int c = 0; c < NCHUNK; c += 2) {
            r2_load(F, lds, vb, li, g);
            r2_step(F, S, s01, s23, ybase, vb, li, g);
            R2_BAR();
            r2_load(F, lds + R2_SLOT, vb, li, g);
            r2_step(F, S, s01, s23, ybase + 64 * R2_YRS, vb, li, g);
            R2_BAR();
        }
    } else {
        const int et = tid - 256;
        uint4 st[8];
        EpiIn EA, EB;
        r2_stage_load(st, I, ub0, et);
        r2_epi_load(EA, et, (size_t)b * SEQ + (et >> 2), h, (et >> 2) > 0, proj, I);
        r2_stage_write(st, lds, et);
        r2_stage_load(st, I, ub0 + 4096, et);
        R2_BAR();
#pragma unroll 1
        for (int c = 0; c < NCHUNK; c += 2) {
            const int tl = c * CHUNK + (et >> 2);
            r2_stage_write(st, lds + R2_SLOT, et);
            if (c + 2 < NCHUNK) r2_stage_load(st, I, ub0 + (size_t)(c + 2) * 4096, et);
            r2_epi_load(EB, et, (size_t)b * SEQ + tl + CHUNK, h, true, proj, I);
            R2_BAR();
            r2_epilogue(EA, ybase, et, (size_t)b * SEQ + tl, h, I, ymix);
            if (c + 2 < NCHUNK) { r2_stage_write(st, lds, et); r2_stage_load(st, I, ub0 + (size_t)(c + 3) * 4096, et); r2_epi_load(EA, et, (size_t)b * SEQ + tl + 2 * CHUNK, h, true, proj, I); }
            R2_BAR();
            r2_epilogue(EB, ybase + 64 * R2_YRS, et, (size_t)b * SEQ + tl + CHUNK, h, I, ymix);
        }
    }
    asm volatile("s_waitcnt vmcnt(0)" ::: "memory");
#undef R2_BAR
}
#ifdef DBG_RWKV
struct RwkvParams { const float *mu, *w0, *w2, *a0, *a2, *g2, *k_k, *k_a, *r_k, *ln_w, *ln_b; };
constexpr int RWKV_LDS = (7 * 4096 + 8192 + 64) * 4;
__device__ __forceinline__ void rwkv_naive_unit(float* sm, int unit, const bf16_t* __restrict__ proj, const RwkvParams& P0, bf16_t* ymix) {
    float* sR = sm; float* sDEC = sm + 4096; float* sKP = sm + 2 * 4096; float* sV = sm + 3 * 4096; float* sKK = sm + 4 * 4096; float* sKKA = sm + 5 * 4096; float* sG = sm + 6 * 4096;
    float* sST = sm + 7 * 4096;
    float* sBON = sST + 8192;
    int tid_ = threadIdx.x; asm volatile("" : "+v"(tid_));
    const int tid = tid_, b = unit >> 3, h = unit & 7;
    const int tk = tid >> 3, sub = tid & 7;
    float S[8];
#pragma unroll
    for (int i = 0; i < 8; ++i) S[i] = 0.f;
#pragma unroll 1
    for (int cb = 0; cb < NCHUNK; ++cb) {
        const int t0 = cb * CHUNK;
        RwkvParams P = P0;
        asm volatile("" : "+s"(P.mu), "+s"(P.w0), "+s"(P.w2), "+s"(P.a0), "+s"(P.a2), "+s"(P.g2));
        asm volatile("" : "+s"(P.k_k), "+s"(P.k_a), "+s"(P.r_k), "+s"(P.ln_w), "+s"(P.ln_b));
        const size_t row = (size_t)b * SEQ + t0 + tk;
        const bf16_t* pr = proj + row * IN_COLS;
        const bool has_prev = (t0 + tk) > 0;
        const bf16_t* pp = pr - IN_COLS;
        auto shifted = [&](int col) -> float { const float cur = bf2f(pr[col]); const float prev = has_prev ? bf2f(pp[col]) : 0.f; return cur + P.mu[col] * (prev - cur); };
#pragma unroll
        for (int i = 0; i < 8; ++i) { const int j = sub * 8 + i; sST[tk * 128 + j] = tanhf(shifted(C_WD + j)); }
        __syncthreads();
        float av[8];
        {
            float acc[8];
#pragma unroll
            for (int i = 0; i < 8; ++i) acc[i] = P.w0[h * 64 + sub * 8 + i];
#pragma unroll 2
            for (int j = 0; j < 64; ++j) { const float t = sST[tk * 128 + j]; const float* wr = P.w2 + (size_t)j * RW + h * 64 + sub * 8;
#pragma unroll
                for (int i = 0; i < 8; ++i) acc[i] += t * wr[i]; }
#pragma unroll
            for (int i = 0; i < 8; ++i) { const float xx = -acc[i]; const float sp = (xx > 20.f) ? xx : log1pf(__expf(xx)); const float w = -sp - 0.5f; sDEC[tk * 64 + sub * 8 + i] = __expf(-__expf(w)); }
        }
        __syncthreads();
#pragma unroll
        for (int i = 0; i < 8; ++i) { const int j = sub * 8 + i; sST[tk * 128 + j] = shifted(C_AD + j); }
        __syncthreads();
        {
            float acc[8];
#pragma unroll
            for (int i = 0; i < 8; ++i) acc[i] = P.a0[h * 64 + sub * 8 + i];
#pragma unroll 2
            for (int j = 0; j < 64; ++j) { const float t = sST[tk * 128 + j]; const float* wr = P.a2 + (size_t)j * RW + h * 64 + sub * 8;
#pragma unroll
                for (int i = 0; i < 8; ++i) acc[i] += t * wr[i]; }
#pragma unroll
            for (int i = 0; i < 8; ++i) av[i] = sigmoidf_(acc[i]);
        }
        __syncthreads();
#pragma unroll
        for (int i = 0; i < 16; ++i) { const int j = sub * 16 + i; sST[tk * 128 + j] = sigmoidf_(shifted(C_GD + j)); }
        __syncthreads();
        {
            float acc[8];
#pragma unroll
            for (int i = 0; i < 8; ++i) acc[i] = 0.f;
#pragma unroll 2
            for (int j = 0; j < 128; ++j) { const float t = sST[tk * 128 + j]; const float* wr = P.g2 + (size_t)j * RW + h * 64 + sub * 8;
#pragma unroll
                for (int i = 0; i < 8; ++i) acc[i] += t * wr[i]; }
#pragma unroll
            for (int i = 0; i < 8; ++i) sG[tk * 64 + sub * 8 + i] = acc[i];
        }
        {
            float rr[8], kv[8], vv[8], kk[8], kp[8]; float ss = 0.f, bon = 0.f;
#pragma unroll
            for (int i = 0; i < 8; ++i) {
                const int c = h * 64 + sub * 8 + i;
                rr[i] = shifted(C_R + c); kv[i] = shifted(C_K + c); vv[i] = shifted(C_V + c);
                kk[i] = kv[i] * P.k_k[c]; ss += kk[i] * kk[i];
                kp[i] = kv[i] * (1.f + (av[i] - 1.f) * P.k_a[c]);
                bon += rr[i] * kp[i] * P.r_k[c];
            }
            ss += __shfl_xor(ss, 1); ss += __shfl_xor(ss, 2); ss += __shfl_xor(ss, 4);
            bon += __shfl_xor(bon, 1); bon += __shfl_xor(bon, 2); bon += __shfl_xor(bon, 4);
            const float inv = 1.f / fmaxf(sqrtf(ss), 1e-12f);
#pragma unroll
            for (int i = 0; i < 8; ++i) {
                const int o = tk * 64 + sub * 8 + i; const float kn = kk[i] * inv;
                sR[o] = rr[i]; sKP[o] = kp[i]; sV[o] = vv[i]; sKK[o] = kn; sKKA[o] = kn * av[i];
            }
            if (sub == 0) sBON[tk] = bon;
        }
        __syncthreads();
#pragma unroll 1
        for (int t = 0; t < CHUNK; ++t) {
            const float* dk = sDEC + t * 64 + sub * 8; const float* kkp = sKK + t * 64 + sub * 8; const float* kap = sKKA + t * 64 + sub * 8;
            const float* kpp = sKP + t * 64 + sub * 8; const float* rp = sR + t * 64 + sub * 8;
            float sa = 0.f;
#pragma unroll
            for (int i = 0; i < 8; ++i) sa -= S[i] * kkp[i];
            sa += __shfl_xor(sa, 1); sa += __shfl_xor(sa, 2); sa += __shfl_xor(sa, 4);
            const float vt = sV[t * 64 + tk];
            float y = 0.f;
#pragma unroll
            for (int i = 0; i < 8; ++i) { S[i] = S[i] * dk[i] + sa * kap[i] + vt * kpp[i]; y += S[i] * rp[i]; }
            y += __shfl_xor(y, 1); y += __shfl_xor(y, 2); y += __shfl_xor(y, 4);
            if (sub == 0) sST[t * 64 + tk] = y;
        }
        __syncthreads();
        {
            float yv[8]; float s1 = 0.f;
#pragma unroll
            for (int i = 0; i < 8; ++i) { yv[i] = sST[tk * 64 + sub * 8 + i]; s1 += yv[i]; }
            s1 += __shfl_xor(s1, 1); s1 += __shfl_xor(s1, 2); s1 += __shfl_xor(s1, 4);
            const float mean = s1 * (1.f / 64.f); float s2 = 0.f;
#pragma unroll
            for (int i = 0; i < 8; ++i) { const float d = yv[i] - mean; s2 += d * d; }
            s2 += __shfl_xor(s2, 1); s2 += __shfl_xor(s2, 2); s2 += __shfl_xor(s2, 4);
            const float rstd = rsqrtf(s2 * (1.f / 64.f) + GN_EPS); const float bon = sBON[tk];
            unsigned pk[4];
#pragma unroll
            for (int i = 0; i < 8; i += 2) {
                float o[2];
#pragma unroll
                for (int u = 0; u < 2; ++u) { const int c = h * 64 + sub * 8 + i + u; const int o_ = tk * 64 + sub * 8 + i + u;
                    o[u] = ((yv[i + u] - mean) * rstd * P.ln_w[c] + P.ln_b[c] + bon * sV[o_]) * sG[o_]; }
                pk[i >> 1] = pk2(o[0], o[1]);
            }
            *(uint4*)(ymix + row * D_MODEL + h * 64 + sub * 8) = make_uint4(pk[0], pk[1], pk[2], pk[3]);
        }
        __syncthreads();
    }
}

#endif
constexpr int LDS_PHASE_BYTES = 150 * 1024;
constexpr int LDSCTL_OFF = LDS_PHASE_BYTES;
constexpr int LDS_BYTES = LDS_PHASE_BYTES + 1024;
#ifdef DBG_RWKV
static_assert(RWKV_LDS <= LDS_PHASE_BYTES, "dbg");
#endif
static_assert(R1_LDS <= LDS_PHASE_BYTES && R2_LDS <= LDS_PHASE_BYTES && pg8::STAGE_BYTES <= LDS_PHASE_BYTES && ATT_LDS <= LDS_PHASE_BYTES, "LDS map");

struct Args {
    const float* in[26]; float* out; unsigned char* ws;
};
static_assert(sizeof(Args) == 28 * 8, "Args has no padding");

__global__ void __launch_bounds__(NTHREADS, 2) mega_fwd(Args args) {
    extern __shared__ __attribute__((aligned(16))) unsigned char lds[];
    LAS unsigned char* ldsp = (LAS unsigned char*)lds;
    const int G = gridDim.x, bid = blockIdx.x;
#define IDS() int tid = threadIdx.x; asm volatile("" : "+v"(tid)); const int lane = tid & 63, wave = __builtin_amdgcn_readfirstlane(tid >> 6), gw = bid * NWAVES + wave, ngw = G * NWAVES; (void)lane; (void)gw; (void)ngw
    typedef const __attribute__((address_space(4))) Args* KArgs;
#define KA() ({ KArgs _p = (KArgs)__builtin_amdgcn_kernarg_segment_ptr(); asm volatile("" : "+s"(_p)); _p; })
#define IN(i) (KA()->in[i])
#define WSP(off) (KA()->ws + (off))
#define OUTP() (KA()->out)
    { IDS(); for (int u = tid; u < (LDS_BYTES - LDSCTL_OFF) / 4; u += NTHREADS) ((LAS unsigned*)(ldsp + LDSCTL_OFF))[u] = 0u; }
    __syncthreads();
    XcdBarrier bar = xcd_barrier_post((unsigned*)((gu32*)WSP(WS_CTL) + CW_BAR), (volatile LAS unsigned*)(ldsp + LDSCTL_OFF));
#define GRID_BAR() xcd_barrier(bar)
    constexpr int CW_QUEUE = 8192;
#ifndef PROF_PHASE
#define PROF_PHASE -1
#endif
#define PROF_REP(k) ((PROF_PHASE == (k)) ? 1 + PROF_EXTRA : 1)
#ifndef PROF_EXTRA
#define PROF_EXTRA 1
#endif
    enum { I_X = 0, I_NMG, I_WIN, I_MU, I_W0, I_W2, I_A0, I_A2, I_G2, I_KK, I_KA, I_RK, I_LNW, I_LNB, I_RELB, I_ANG, I_WOUT, I_NFG, I_FWG, I_FWU, I_FWD, I_ROUTER, I_MWG, I_MWU, I_MWD, I_NFINAL };

    for (int rep_ = 0; rep_ < PROF_REP(0); ++rep_) {
    {
        IDS();
        LAS float* scr = (LAS float*)(ldsp + wave * P0_SCR_BYTES);
        constexpr int I_IN = (D_MODEL / 64) * (IN_COLS / 64), I_OUT = (D_MODEL / 64) * (D_MODEL / 64), I_FG = (D_MODEL / 64) * (D_FF / 64), I_FD = (D_FF / 64) * (D_MODEL / 64);
        constexpr int I_MG = (D_MODEL / 64) * (D_FFE / 64), I_MD = (D_FFE / 64) * (D_MODEL / 64);
        constexpr int NITEMS = 2 * I_IN + 2 * I_OUT + 2 * I_FG + I_FD;
#pragma unroll 1
        for (int it = gw; it < NITEMS; it += ngw) {
            int r = it;
            if (r < 2 * I_IN) { const int l = r / I_IN; p0_transpose_item(IN(I_WIN) + (size_t)l * D_MODEL * IN_COLS, D_MODEL, IN_COLS, (bf16_t*)WSP(WS_WIN) + (size_t)l * IN_COLS * D_MODEL, 0, 1, scr, r % I_IN, lane); continue; } r -= 2 * I_IN;
            if (r < 2 * I_OUT) { const int l = r / I_OUT; p0_transpose_item(IN(I_WOUT) + (size_t)l * D_MODEL * D_MODEL, D_MODEL, D_MODEL, (bf16_t*)WSP(WS_WOUT) + (size_t)l * D_MODEL * D_MODEL, 0, 1, scr, r % I_OUT, lane); continue; } r -= 2 * I_OUT;
            if (r < I_FG) { p0_transpose_item(IN(I_FWG), D_MODEL, D_FF, (bf16_t*)WSP(WS_FGU), 0, 2, scr, r, lane); continue; } r -= I_FG;
            if (r < I_FG) { p0_transpose_item(IN(I_FWU), D_MODEL, D_FF, (bf16_t*)WSP(WS_FGU), 1, 2, scr, r, lane); continue; } r -= I_FG;
            p0_transpose_item(IN(I_FWD), D_FF, D_MODEL, (bf16_t*)WSP(WS_FDN), 0, 1, scr, r, lane);
        }
        {
            const int gt = bid * NTHREADS + tid, ngt = G * NTHREADS;
            const float* w2 = IN(I_W2); const float* a2 = IN(I_A2); const float* g2 = IN(I_G2);
            bf16_t* w2T = (bf16_t*)WSP(WS_LORA + LORA_W2T); bf16_t* a2T = (bf16_t*)WSP(WS_LORA + LORA_A2T); bf16_t* g2T = (bf16_t*)WSP(WS_LORA + LORA_G2T);
            for (int i = gt; i < 2 * 512 * 64; i += ngt) { const int l = i >> 15, r = i & 32767, ch = r >> 6, j = r & 63; w2T[i] = (bf16_t)f2bf(w2[l * 32768 + j * 512 + ch]); a2T[i] = (bf16_t)f2bf(a2[l * 32768 + j * 512 + ch]); }
            for (int i = gt; i < 2 * 512 * 128; i += ngt) { const int l = i >> 16, r = i & 65535, ch = r >> 7, j = r & 127; g2T[i] = (bf16_t)f2bf(g2[l * 65536 + j * 512 + ch]); }
        }
        { IDS(); norm_rows<0>(gw, ngw, lane, IN(I_X), IN(I_NMG), (bf16_t*)WSP(WS_XN), nullptr, nullptr, nullptr, nullptr); }
    }
    }
    for (int rep_ = 1; rep_ < PROF_REP(13); ++rep_) GRID_BAR();
    for (int rep_ = 1; rep_ < PROF_REP(14); ++rep_) cg::this_grid().sync();
    cg::this_grid().sync();

#pragma unroll 1
    for (int l = 0; l < 2; ++l) {
        for (int rep_ = 0; rep_ < ((l == 0) ? PROF_REP(1) : 1); ++rep_) {
        {
            pg8::Gemm g{(bf16_t*)WSP(WS_XN), (bf16_t*)WSP(WS_WIN) + (size_t)l * IN_COLS * D_MODEL, TOK, IN_COLS, D_MODEL}; pg8::StaticOrder S; S.init(TOK, IN_COLS, G, bid);
            pg8::EpiBf16 E{(bf16_t*)WSP(WS_PROJ), IN_COLS, nullptr};
            pg8::gemm_phase<pg8::EpiBf16, pg8::StaticOrder, true, true>(ldsp, g, S, E);
        }
        GRID_BAR();
        }
        for (int rep_ = 0; rep_ < ((l == 0) ? PROF_REP(2) : 1); ++rep_) {
        {
            RwkvW Wt{IN(I_MU) + l * SHIFT_COLS, IN(I_W0) + l * RW, IN(I_A0) + l * RW, IN(I_KK) + l * RW, IN(I_KA) + l * RW, IN(I_RK) + l * RW,
                     (const bf16_t*)WSP(WS_LORA + LORA_W2T) + (size_t)l * 512 * 64, (const bf16_t*)WSP(WS_LORA + LORA_A2T) + (size_t)l * 512 * 64, (const bf16_t*)WSP(WS_LORA + LORA_G2T) + (size_t)l * 512 * 128};
            RwkvChunkOut Oc{(bf16_t*)WSP(WS_GP), (bf16_t*)WSP(WS_QP), (bf16_t*)WSP(WS_HT), (bf16_t*)WSP(WS_ZT), (bf16_t*)WSP(WS_GATE), (float*)WSP(WS_BONUS), (unsigned*)WSP(WS_CTL)};
            RawIn raw;
#pragma unroll 1
            for (int u = bid; u < BATCH * NH * NCHUNK; u += G) rwkv_chunk_unit(ldsp, u, (u + G < BATCH * NH * NCHUNK) ? u + G : -1, raw, (const bf16_t*)WSP(WS_PROJ), Wt, Oc);
        }
        GRID_BAR();
        }
#if defined(DBG_RWKV) && DBG_RWKV >= 10 && DBG_RWKV != 14
        if (l == 0) {
            IDS();
            gu32* cw = (gu32*)WSP(WS_CTL);
#if DBG_RWKV == 10 || DBG_RWKV == 12 || DBG_RWKV == 13
            const bf16_t* arr[3] = {(const bf16_t*)WSP(WS_GP), (const bf16_t*)WSP(WS_QP), (const bf16_t*)WSP(WS_HT)};
#else
            const bf16_t* arr[3] = {(const bf16_t*)WSP(WS_ZT), (const bf16_t*)WSP(WS_GATE), (const bf16_t*)WSP(WS_GATE)};
#endif
            for (int k = 0; k < 3; ++k) {
                float n_ = 0.f;
#if DBG_RWKV == 13
                const int k2 = k; const int kk_ = 0;
#define k kk_
#endif
                for (size_t i = (size_t)(bid * NTHREADS + tid) * 8; i < (size_t)2048 * 4096; i += (size_t)G * NTHREADS * 8) {
                    const uint4 u = *(const uint4*)(arr[k] + i); const unsigned w_[4] = {u.x, u.y, u.z, u.w};
#if DBG_RWKV == 13
                    { const int tokrow = (int)(i / 512), tseq = tokrow & (SEQ - 1); const int cat = (tseq == 0) ? 0 : ((tseq & 63) == 0 ? 1 : 2);
                      for (int q = 0; q < 4; ++q) { if (k == 0 && cat == (int)k2) { if ((w_[q] & 0x7f80u) == 0x7f80u) n_ += 1.f; if ((w_[q] & 0x7f800000u) == 0x7f800000u) n_ += 1.f; } } }
#else
                    for (int q = 0; q < 4; ++q) { if ((w_[q] & 0x7f80u) == 0x7f80u) n_ += 1.f; if ((w_[q] & 0x7f800000u) == 0x7f800000u) n_ += 1.f; }
#endif
                }
#if DBG_RWKV == 11
                if (k == 2) { n_ = 0.f; const float* bo = (const float*)WSP(WS_BONUS); for (int i = bid * NTHREADS + tid; i < TOK * NH; i += G * NTHREADS) if (!(fabsf(bo[i]) < 1e30f)) n_ += 1.f; }
#endif
#if DBG_RWKV == 13
#undef k
#endif
                n_ = wave_sum(n_);
                if (lane == 0) atomicAdd((float*)(cw + 528 + k), n_);
            }
        }
#endif
        for (int rep_ = 0; rep_ < ((l == 0) ? PROF_REP(3) : 1); ++rep_) {
        {
            if (bid < BATCH * NH) {
                RwkvScanIn Si{(const bf16_t*)WSP(WS_GP), (const bf16_t*)WSP(WS_QP), (const bf16_t*)WSP(WS_HT), (const bf16_t*)WSP(WS_ZT), (const bf16_t*)WSP(WS_GATE), (const float*)WSP(WS_BONUS),
                              IN(I_MU) + l * SHIFT_COLS, IN(I_LNW) + l * RW, IN(I_LNB) + l * RW};
#pragma unroll 1
                for (int i = bid; i < BATCH * NH; i += G) rwkv_scan_unit(ldsp, i, (const bf16_t*)WSP(WS_PROJ), Si, (bf16_t*)WSP(WS_XN));
            }
            volatile LAS int* tick = (volatile LAS int*)(ldsp + LDSCTL_OFF + 64);
#pragma unroll 1
            for (;;) {
                __syncthreads();
                if (threadIdx.x == 0) *tick = (int)atomicAdd((unsigned*)((gu32*)WSP(WS_CTL) + CW_QUEUE + 64 * l), 1u);
                __syncthreads();
                const int k = *tick;
                if (k >= 2 * BATCH * NCHUNK) break;
                const int n = NCHUNK - 1 - (k >> 4), b = (k & 15) >> 1, qb = k & 1;
                attn_half_unit(ldsp, b, n, qb, (const bf16_t*)WSP(WS_PROJ), IN(I_RELB) + (size_t)l * 257 * 8, IN(I_ANG) + l * AW, (bf16_t*)WSP(WS_XN));
            }
        }
        GRID_BAR();
        }
#ifdef DBG_RWKV
        if (l == 0) {
            IDS();
            const bf16_t* ya = (const bf16_t*)WSP(WS_XN); const bf16_t* yb = (const bf16_t*)OUTP();
            float se[3] = {0.f, 0.f, 0.f}, sy[3] = {0.f, 0.f, 0.f}, nf[3] = {0.f, 0.f, 0.f};
            for (int row = gw; row < TOK; row += ngw) {
                const int t = row & (SEQ - 1); const int rg = t < 64 ? 0 : (t < 128 ? 1 : 2);
                const uint4 ua = *(const uint4*)(ya + (size_t)row * D_MODEL + lane * 8), ub_ = *(const uint4*)(yb + (size_t)row * D_MODEL + lane * 8);
                const unsigned wa_[4] = {ua.x, ua.y, ua.z, ua.w}, wb_[4] = {ub_.x, ub_.y, ub_.z, ub_.w};
                float e = 0.f, y2 = 0.f, n_ = 0.f;
                for (int q = 0; q < 4; ++q) for (int u = 0; u < 2; ++u) {
                    const float a_ = bf2f(u ? wa_[q] >> 16 : wa_[q] & 0xffffu), b_ = bf2f(u ? wb_[q] >> 16 : wb_[q] & 0xffffu);
                    if (!(fabsf(b_) < 1e30f)) n_ += 1.f; else e += (a_ - b_) * (a_ - b_);
                    y2 += a_ * a_;
                }
                for (int k = 0; k < 3; ++k) if (k == rg) { se[k] += e; sy[k] += y2; nf[k] += n_; }
            }
            gu32* cw = (gu32*)WSP(WS_CTL);
            for (int k = 0; k < 3; ++k) { const float a_ = wave_sum(se[k]), b_ = wave_sum(sy[k]), c_ = wave_sum(nf[k]);
                if (lane == 0) { atomicAdd((float*)(cw + 512 + k), a_); atomicAdd((float*)(cw + 520 + k), b_); if (DBG_RWKV < 10) atomicAdd((float*)(cw + 528 + k), c_); } }
            GRID_BAR();
        }
#endif
        for (int rep_ = 0; rep_ < ((l == 0) ? PROF_REP(4) : 1); ++rep_) {
        {
            pg8::Gemm g{(bf16_t*)WSP(WS_XN), (bf16_t*)WSP(WS_WOUT) + (size_t)l * D_MODEL * D_MODEL, TOK, D_MODEL, D_MODEL}; pg8::StaticOrder S; S.init(TOK, D_MODEL, G, bid);
            pg8::EpiRes E{(l == 0) ? IN(I_X) : (const float*)OUTP(), OUTP(), D_MODEL, nullptr, 0, (bf16_t*)nullptr, (float*)nullptr};
            pg8::gemm_phase<pg8::EpiRes, pg8::StaticOrder, true, true>(ldsp, g, S, E);
        }
        GRID_BAR();
        }
        if (l == 0) {
            for (int rep_ = 0; rep_ < PROF_REP(5); ++rep_) {
            { IDS(); norm_rows<0>(gw, ngw, lane, OUTP(), IN(I_NFG), (bf16_t*)WSP(WS_XN), nullptr, nullptr, nullptr, nullptr); }
            GRID_BAR();
            }
            for (int rep_ = 0; rep_ < PROF_REP(6); ++rep_) {
            {
                pg8::Gemm g{(bf16_t*)WSP(WS_XN), (bf16_t*)WSP(WS_FGU), TOK, 2 * D_FF, D_MODEL}; pg8::StaticOrder S; S.init(TOK, 2 * D_FF, G, bid);
                pg8::EpiSwiglu E{(bf16_t*)WSP(WS_PROJ), D_FF, nullptr};
                pg8::gemm_phase<pg8::EpiSwiglu, pg8::StaticOrder, true, true>(ldsp, g, S, E);
            }
            GRID_BAR();
            }
            {
                pg8::Gemm g{(bf16_t*)WSP(WS_PROJ), (bf16_t*)WSP(WS_FDN), TOK, D_MODEL, D_FF}; pg8::StaticOrder S; S.init(TOK, D_MODEL, G, bid);
                pg8::EpiRes E{OUTP(), OUTP(), D_MODEL, nullptr, 0, (bf16_t*)nullptr, (float*)nullptr};
                pg8::gemm_phase<pg8::EpiRes, pg8::StaticOrder, true, true>(ldsp, g, S, E);
            }
            GRID_BAR();
            { IDS(); norm_rows<0>(gw, ngw, lane, OUTP(), IN(I_NMG) + D_MODEL, (bf16_t*)WSP(WS_XN), nullptr, nullptr, nullptr, nullptr); }
            GRID_BAR();
        } else {
            for (int rep_ = 0; rep_ < PROF_REP(8); ++rep_) {
            for (int r2_ = 0; r2_ < PROF_REP(81); ++r2_)
            { IDS(); norm_rows<1>(gw, ngw, lane, OUTP(), IN(I_NFG) + D_MODEL, (bf16_t*)WSP(WS_XN), nullptr, IN(I_ROUTER), (int*)WSP(WS_TAB + TAB_ROUTE_E), (float2*)WSP(WS_TAB + TAB_ROUTE_G)); }
            for (int r2_ = 0; r2_ < PROF_REP(82); ++r2_)
            {
                IDS();
                LAS float* scr = (LAS float*)(ldsp + wave * P0_SCR_BYTES);
                constexpr int I_MG = (D_MODEL / 64) * (D_FFE / 64), I_MD = (D_FFE / 64) * (D_MODEL / 64);
#pragma unroll 1
                for (int it = gw; it < NE * (2 * I_MG + I_MD); it += ngw) {
                    const int e = it / (2 * I_MG + I_MD); int r = it - e * (2 * I_MG + I_MD);
                    if (r < I_MG) { p0_transpose_item(IN(I_MWG) + (size_t)e * D_MODEL * D_FFE, D_MODEL, D_FFE, (bf16_t*)WSP(WS_MGU) + (size_t)e * 2 * D_FFE * D_MODEL, 0, 2, scr, r, lane); continue; } r -= I_MG;
                    if (r < I_MG) { p0_transpose_item(IN(I_MWU) + (size_t)e * D_MODEL * D_FFE, D_MODEL, D_FFE, (bf16_t*)WSP(WS_MGU) + (size_t)e * 2 * D_FFE * D_MODEL, 1, 2, scr, r, lane); continue; } r -= I_MG;
                    p0_transpose_item(IN(I_MWD) + (size_t)e * D_FFE * D_MODEL, D_FFE, D_MODEL, (bf16_t*)WSP(WS_MDN) + (size_t)e * D_MODEL * D_FFE, 0, 1, scr, r, lane);
                }
            }
            GRID_BAR();
            }
            for (int rep_ = 0; rep_ < PROF_REP(9); ++rep_) {
            {
                MoeTabs Tb{(int*)WSP(WS_TAB + TAB_ROUTE_E), (float2*)WSP(WS_TAB + TAB_ROUTE_G), (int2*)WSP(WS_TAB + TAB_POS), (int*)WSP(WS_TAB + TAB_ROWIDX), (float*)WSP(WS_TAB + TAB_GATEPOS), (int*)WSP(WS_TAB + TAB_SEGT)};
                moe_build_lists(ldsp, bid, G, Tb);
            }
            GRID_BAR();
            }
            for (int rep_ = 0; rep_ < PROF_REP(10); ++rep_) {
            {
                pg8::Gemm g{(bf16_t*)WSP(WS_XN), (bf16_t*)WSP(WS_MGU), MOE_MAXROWS, 2 * D_FFE, D_MODEL};
                pg8::MoeOrder S{(const int*)WSP(WS_TAB + TAB_SEGT), 2 * D_FFE / 256, G, bid, SZ_MGU};
                pg8::EpiSwiglu E{(bf16_t*)WSP(WS_ACT2), D_FFE, nullptr};
                pg8::gemm_phase<pg8::EpiSwiglu, pg8::MoeOrder, true, true, true>(ldsp, g, S, E, (const int*)WSP(WS_TAB + TAB_ROWIDX));
            }
            GRID_BAR();
            }
            for (int rep_ = 0; rep_ < PROF_REP(11); ++rep_) {
            {
                pg8::Gemm g{(bf16_t*)WSP(WS_ACT2), (bf16_t*)WSP(WS_MDN), MOE_MAXROWS, D_MODEL, D_FFE};
                pg8::MoeOrder S{(const int*)WSP(WS_TAB + TAB_SEGT), D_MODEL / 256, G, bid, SZ_MDN};
                pg8::EpiSlot E{(bf16_t*)WSP(WS_SLOT), D_MODEL, (const float*)WSP(WS_TAB + TAB_GATEPOS)};
                pg8::gemm_phase<pg8::EpiSlot, pg8::MoeOrder, true, true>(ldsp, g, S, E);
            }
            GRID_BAR();
            }
        }
    }
    { IDS(); norm_rows<3>(gw, ngw, lane, OUTP(), IN(I_NFINAL), nullptr, OUTP(), nullptr, nullptr, nullptr, (const bf16_t*)WSP(WS_SLOT), (const int2*)WSP(WS_TAB + TAB_POS)); }
#ifdef DBG_RWKV
    {
        IDS();
        const float* cw = (const float*)WSP(WS_CTL);
        const float wts[3] = {0.1f, 0.3f, 0.9f}; float diag = 0.f;
        for (int k = 0; k < 3; ++k) { const float se = __hip_atomic_load(cw + 512 + k, RLX_AGENT), sy = __hip_atomic_load(cw + 520 + k, RLX_AGENT), nf = __hip_atomic_load(cw + 528 + k, RLX_AGENT);
#if DBG_RWKV == 1
            if (nf > 0.f || se > 0.01f * sy) diag += wts[k];
#elif DBG_RWKV == 12
            if (k == 0) diag = sqrtf(nf / (2048.f * 4096.f));
#elif DBG_RWKV == 13 || DBG_RWKV == 14
            if (nf > 0.f) diag += wts[k];
#elif DBG_RWKV >= 10
            if (nf > 0.f) diag += wts[k];
#else
            if (k == DBG_RWKV - 2) diag = (nf > 0.f) ? 7.f : fminf(sqrtf(se / sy), 5.f);
#endif
        }
        __syncthreads();
        float* o = OUTP();
        for (int row = gw; row < TOK; row += ngw) for (int j = 0; j < 4; ++j) { float4 v = *(float4*)(o + (size_t)row * D_MODEL + (lane + 64 * j) * 4); const float sc = 1.f + diag; v.x *= sc; v.y *= sc; v.z *= sc; v.w *= sc; *(float4*)(o + (size_t)row * D_MODEL + (lane + 64 * j) * 4) = v; }
    }
#endif
}

extern "C" void kernel_launch(void* const* d_in, const int* in_sizes, int n_in, void* d_out, int out_size, void* d_ws, size_t ws_size, hipStream_t stream) {
    static int grid = 0;
    if (grid == 0) {
        if (n_in != 26 || in_sizes[0] != TOK * D_MODEL || out_size != TOK * D_MODEL || ws_size < WS_END) {
            fprintf(stderr, "kernel_launch: unexpected problem: n_in %d in0 %d out %d ws %zu (need %zu); nothing launched\n", n_in, n_in > 0 ? in_sizes[0] : -1, out_size, ws_size, (size_t)WS_END); grid = -1; return; }
        int dev = 0, cus = 0, per_cu = 0;
        if (hipGetDevice(&dev) != hipSuccess || hipDeviceGetAttribute(&cus, hipDeviceAttributeMultiprocessorCount, dev) != hipSuccess) { fprintf(stderr, "kernel_launch: device query failed\n"); grid = -1; return; }
        if (hipFuncSetAttribute((const void*)mega_fwd, hipFuncAttributeMaxDynamicSharedMemorySize, LDS_BYTES) != hipSuccess) { fprintf(stderr, "kernel_launch: hipFuncSetAttribute failed\n"); grid = -1; return; }
        if (hipOccupancyMaxActiveBlocksPerMultiprocessor(&per_cu, (const void*)mega_fwd, NTHREADS, LDS_BYTES) != hipSuccess || per_cu < 1) { fprintf(stderr, "kernel_launch: occupancy query says %d blocks per CU; nothing launched\n", per_cu); (void)hipGetLastError(); grid = -1; return; }
        grid = cus;
    }
    if (grid < 0) return;
    if (hipMemsetAsync((char*)d_ws + WS_CTL, 0, CTL_ZERO_BYTES, stream) != hipSuccess) { fprintf(stderr, "kernel_launch: hipMemsetAsync failed\n"); return; }
    Args a{};
    for (int i = 0; i < 26; ++i) a.in[i] = (const float*)d_in[i];
    a.out = (float*)d_out; a.ws = (unsigned char*)d_ws;
    void* kargs[] = {&a};
    const hipError_t le = hipLaunchCooperativeKernel((const void*)mega_fwd, dim3(grid), dim3(NTHREADS), kargs, LDS_BYTES, stream);
    if (le != hipSuccess) fprintf(stderr, "kernel_launch: cooperative launch failed: %s (grid %d x %d threads, %d B LDS)\n", hipGetErrorString(le), grid, NTHREADS, LDS_BYTES);
}
```
